# Optimizing an MI355X kernel written in HIP

```python
import jax, jax.numpy as jnp
from jax import lax
import numpy as np

D_MODEL = 1024
BATCH = 32
SEQ = 2048
DEPTH = 1

N_MEM = 256
DIL_PATTERNS = ((128, 1), (512, 4), (2048, 16))
N_DIL_GROUPS = len(DIL_PATTERNS)
DIL_HEADS = 8
DIL_HEAD_DIM = D_MODEL // 16
DIL_WIDTH = DIL_HEADS * DIL_HEAD_DIM
RET_HEADS = 4
RET_QK_DIM = D_MODEL // 16
RET_V_DIM = 2 * RET_QK_DIM
RET_QK_WIDTH = RET_HEADS * RET_QK_DIM
RET_V_WIDTH = RET_HEADS * RET_V_DIM
RET_CHUNK = 128
MEM_HEADS = 4
MEM_HEAD_DIM = D_MODEL // 8
MEM_WIDTH = MEM_HEADS * MEM_HEAD_DIM
N_BRANCHES = 3
D_FF = 2816
CONV_WIDTH = 3
NORM_EPS = 1e-6
MASK_VALUE = -1e30
DIL_COLS = N_DIL_GROUPS * 3 * DIL_WIDTH
RET_COLS = 2 * RET_QK_WIDTH + 2 * RET_V_WIDTH
IN_COLS = DIL_COLS + RET_COLS + MEM_WIDTH + N_BRANCHES * D_MODEL

kernel_name = "hybrid_dilated_retention_memory_block"


def rms_norm(x, g):
    xf = x.astype(jnp.float32)
    y = xf * lax.rsqrt(jnp.mean(xf * xf, axis=-1, keepdims=True) + NORM_EPS)
    return (y * g.astype(jnp.float32)).astype(x.dtype)


def alibi_slopes(n_heads):
    exps = jnp.arange(1, n_heads + 1, dtype=jnp.float32) * (8.0 / n_heads)
    return jnp.exp2(-exps)


def dilated_window_attention(q, k, v, dilation, half, slopes):
    b, s, h, dh = q.shape
    r = dilation
    n_sub = s // r
    nb = -(-n_sub // half)
    lp = nb * half

    def residue_split(t):
        t = t.reshape(b, n_sub, r, h, dh).transpose(0, 2, 3, 1, 4)
        return jnp.pad(t, ((0, 0), (0, 0), (0, 0), (0, lp - n_sub), (0, 0)))

    def band(t):
        tp = jnp.pad(t, ((0, 0), (0, 0), (0, 0), (half, half), (0, 0))).reshape(b, r, h, nb + 2, half, dh)
        return jnp.concatenate([tp[:, :, :, :-2], tp[:, :, :, 1:-1], tp[:, :, :, 2:]], axis=4)

    qb = residue_split(q).reshape(b, r, h, nb, half, dh)
    kb = band(residue_split(k))
    vb = band(residue_split(v))
    scores = jnp.einsum('brhnqd,brhnkd->brhnqk', qb, kb) * (dh ** -0.5)
    q_idx = jnp.arange(nb)[:, None] * half + jnp.arange(half)[None, :]
    k_idx = jnp.arange(nb)[:, None] * half - half + jnp.arange(3 * half)[None, :]
    rel = k_idx[:, None, :] - q_idx[:, :, None]
    valid = (jnp.abs(rel) <= half) & (k_idx[:, None, :] >= 0) & (k_idx[:, None, :] < n_sub)
    dist = (jnp.abs(rel) * r).astype(jnp.float32)
    scores = scores - slopes[:, None, None, None] * dist[None]
    scores = jnp.where(valid, scores, MASK_VALUE)
    m = jnp.max(scores, axis=-1, keepdims=True)
    p = jnp.exp(scores - m)
    denom = jnp.sum(p, axis=-1)
    o = jnp.einsum('brhnqk,brhnkd->brhnqd', p, vb) / denom[..., None]
    lse = m[..., 0] + jnp.log(denom)
    o = o.reshape(b, r, h, lp, dh)[:, :, :, :n_sub].transpose(0, 3, 1, 2, 4).reshape(b, s, h, dh)
    lse = lse.reshape(b, r, h, lp)[:, :, :, :n_sub].transpose(0, 3, 1, 2).reshape(b, s, h)
    return o, lse


def dilated_mixture_attention(p, q_norm_g, k_norm_g, slopes):
    b, s, _ = p.shape
    p = p.reshape(b, s, N_DIL_GROUPS, 3, DIL_HEADS, DIL_HEAD_DIM)
    outs, lses = [], []
    for g, (window, dilation) in enumerate(DIL_PATTERNS):
        q = rms_norm(p[:, :, g, 0], q_norm_g[g]).astype(jnp.float32)
        k = rms_norm(p[:, :, g, 1], k_norm_g[g]).astype(jnp.float32)
        v = p[:, :, g, 2].astype(jnp.float32)
        o, lse = dilated_window_attention(q, k, v, dilation, window // (2 * dilation), slopes)
        outs.append(o)
        lses.append(lse)
    weights = jax.nn.softmax(jnp.stack(lses), axis=0)
    o = jnp.einsum('gbsh,gbshd->bshd', weights, jnp.stack(outs))
    return o.reshape(b, s, DIL_WIDTH).astype(p.dtype)


def chunkwise_retention(q, k, v, log_gamma, strict):
    b, h, s, dk = q.shape
    dv = v.shape[-1]
    c = RET_CHUNK
    n = s // c
    qc = q.reshape(b, h, n, c, dk)
    kc = k.reshape(b, h, n, c, dk)
    vc = v.reshape(b, h, n, c, dv)
    idx = jnp.arange(c)
    diff = idx[:, None] - idx[None, :]
    mask = (diff > 0) if strict else (diff >= 0)
    decay = jnp.where(mask[None], jnp.exp(log_gamma[:, None, None] * jnp.maximum(diff, 0).astype(jnp.float32)[None]), 0.0)
    inner = jnp.einsum('bhnid,bhnjd->bhnij', qc, kc) * decay[:, None]
    y_inner = jnp.einsum('bhnij,bhnjv->bhniv', inner, vc)
    zeta = jnp.exp(log_gamma[:, None] * (c - 1 - idx).astype(jnp.float32))
    xi = jnp.exp(log_gamma[:, None] * (idx + 1).astype(jnp.float32))
    chunk_decay = jnp.exp(log_gamma * c)[None, :, None, None]
    u = jnp.einsum('bhnjd,bhnjv->nbhdv', kc * zeta[:, None, :, None], vc)

    def step(state, u_i):
        return state * chunk_decay + u_i, state

    _, prev = lax.scan(step, jnp.zeros((b, h, dk, dv), jnp.float32), u)
    y_cross = jnp.einsum('bhnid,nbhdv->bhniv', qc * xi[:, None, :, None], prev)
    return (y_inner + y_cross).reshape(b, h, s, dv)


def bidirectional_retention(p, decay_logit, gn_g):
    b, s, _ = p.shape
    q, k, v, gate = jnp.split(p, [RET_QK_WIDTH, 2 * RET_QK_WIDTH, 2 * RET_QK_WIDTH + RET_V_WIDTH], axis=-1)

    def heads(t, d):
        return t.reshape(b, s, RET_HEADS, d).transpose(0, 2, 1, 3).astype(jnp.float32)

    q = heads(q, RET_QK_DIM)
    k = heads(k, RET_QK_DIM) * (RET_QK_DIM ** -0.5)
    v = heads(v, RET_V_DIM)
    log_gamma = jax.nn.log_sigmoid(decay_logit.astype(jnp.float32))
    fwd = chunkwise_retention(q, k, v, log_gamma[0], strict=False)
    bwd = jnp.flip(chunkwise_retention(jnp.flip(q, 2), jnp.flip(k, 2), jnp.flip(v, 2), log_gamma[1], strict=True), 2)
    y = fwd + bwd
    mu = jnp.mean(y, axis=-1, keepdims=True)
    var = jnp.mean(jnp.square(y - mu), axis=-1, keepdims=True)
    y = (y - mu) * lax.rsqrt(var + NORM_EPS)
    y = y.transpose(0, 2, 1, 3).reshape(b, s, RET_V_WIDTH) * gn_g.astype(jnp.float32)
    return (jax.nn.silu(gate.astype(jnp.float32)) * y).astype(p.dtype)


def memory_cross_attention(q_p, mem, mem_norm_g, w_mem_kv, q_norm_g, k_norm_g):
    b, s, _ = q_p.shape
    m = mem.shape[1]
    q = rms_norm(q_p.reshape(b, s, MEM_HEADS, MEM_HEAD_DIM), q_norm_g).astype(jnp.float32)
    kv = (rms_norm(mem, mem_norm_g) @ w_mem_kv).reshape(b, m, 2, MEM_HEADS, MEM_HEAD_DIM)
    k = rms_norm(kv[:, :, 0], k_norm_g).astype(jnp.float32)
    v = kv[:, :, 1].astype(jnp.float32)
    scores = jnp.einsum('bshd,bmhd->bhsm', q, k) * (MEM_HEAD_DIM ** -0.5)
    attn = jax.nn.softmax(scores, axis=-1)
    o = jnp.einsum('bhsm,bmhd->bshd', attn, v)
    return o.reshape(b, s, MEM_WIDTH).astype(q_p.dtype)


def conv_glu_ffn(h, w_ffn_in, conv_w, conv_b, w_ffn_out):
    u, gate = jnp.split(h @ w_ffn_in, 2, axis=-1)
    s = u.shape[1]
    pad = CONV_WIDTH // 2
    up = jnp.pad(u, ((0, 0), (pad, pad), (0, 0)))
    c = conv_b
    for i in range(CONV_WIDTH):
        c = c + up[:, i:i + s] * conv_w[i]
    y = jax.nn.gelu(c, approximate=False) * gate
    return y @ w_ffn_out


def setup_inputs(seed: int = 0) -> dict:
    key = jax.random.key(seed)
    ks = jax.random.split(key, 24)
    f32 = jnp.float32

    def normal(k, shape, scale):
        return jax.random.normal(k, shape, f32) * scale

    def gain(k, shape):
        return 1.0 + 0.02 * jax.random.normal(k, shape, f32)

    base_logit = jnp.log(jnp.exp2(5.0 + jnp.arange(RET_HEADS, dtype=f32)) - 1.0)
    ret_decay_logit = base_logit[None, None, :] + 0.1 * jax.random.normal(ks[6], (DEPTH, 2, RET_HEADS), f32)
    return {
        'x': normal(ks[0], (BATCH, SEQ, D_MODEL), 1.0),
        'mem': normal(ks[1], (BATCH, N_MEM, D_MODEL), 1.0),
        'norm1_g': gain(ks[2], (DEPTH, D_MODEL)),
        'w_in': normal(ks[3], (DEPTH, D_MODEL, IN_COLS), D_MODEL ** -0.5),
        'dil_q_norm_g': gain(ks[4], (DEPTH, N_DIL_GROUPS, DIL_HEAD_DIM)),
        'dil_k_norm_g': gain(ks[5], (DEPTH, N_DIL_GROUPS, DIL_HEAD_DIM)),
        'ret_decay_logit': ret_decay_logit,
        'ret_gn_g': gain(ks[7], (DEPTH, RET_V_WIDTH)),
        'mem_norm_g': gain(ks[8], (DEPTH, D_MODEL)),
        'w_mem_kv': normal(ks[9], (DEPTH, D_MODEL, 2 * MEM_WIDTH), D_MODEL ** -0.5),
        'mem_q_norm_g': gain(ks[10], (DEPTH, MEM_HEAD_DIM)),
        'mem_k_norm_g': gain(ks[11], (DEPTH, MEM_HEAD_DIM)),
        'w_branch_dil': normal(ks[12], (DEPTH, DIL_WIDTH, D_MODEL), DIL_WIDTH ** -0.5),
        'w_branch_ret': normal(ks[13], (DEPTH, RET_V_WIDTH, D_MODEL), RET_V_WIDTH ** -0.5),
        'w_branch_mem': normal(ks[14], (DEPTH, MEM_WIDTH, D_MODEL), MEM_WIDTH ** -0.5),
        'w_out': normal(ks[15], (DEPTH, D_MODEL, D_MODEL), D_MODEL ** -0.5),
        'norm2_g': gain(ks[16], (DEPTH, D_MODEL)),
        'w_ffn_in': normal(ks[17], (DEPTH, D_MODEL, 2 * D_FF), D_MODEL ** -0.5),
        'ffn_conv_w': normal(ks[18], (DEPTH, CONV_WIDTH, D_FF), CONV_WIDTH ** -0.5),
        'ffn_conv_b': normal(ks[19], (DEPTH, D_FF), 0.01),
        'w_ffn_out': normal(ks[20], (DEPTH, D_FF, D_MODEL), D_FF ** -0.5),
    }


def reference(x, mem, norm1_g, w_in, dil_q_norm_g, dil_k_norm_g, ret_decay_logit, ret_gn_g,
              mem_norm_g, w_mem_kv, mem_q_norm_g, mem_k_norm_g, w_branch_dil, w_branch_ret,
              w_branch_mem, w_out, norm2_g, w_ffn_in, ffn_conv_w, ffn_conv_b, w_ffn_out):
    b, s, d = x.shape
    dt = x.dtype
    slopes = alibi_slopes(DIL_HEADS)
    split_at = [DIL_COLS, DIL_COLS + RET_COLS, DIL_COLS + RET_COLS + MEM_WIDTH]
    for l in range(DEPTH):
        h = rms_norm(x, norm1_g[l])
        proj = h @ w_in[l]
        dil_p, ret_p, memq_p, gate_p = jnp.split(proj, split_at, axis=-1)
        y_dil = dilated_mixture_attention(dil_p, dil_q_norm_g[l], dil_k_norm_g[l], slopes)
        y_ret = bidirectional_retention(ret_p, ret_decay_logit[l], ret_gn_g[l])
        y_mem = memory_cross_attention(memq_p, mem, mem_norm_g[l], w_mem_kv[l], mem_q_norm_g[l], mem_k_norm_g[l])
        gates = jax.nn.sigmoid(gate_p.astype(jnp.float32)).reshape(b, s, N_BRANCHES, d)
        merged = (gates[:, :, 0] * (y_dil @ w_branch_dil[l]).astype(jnp.float32)
                  + gates[:, :, 1] * (y_ret @ w_branch_ret[l]).astype(jnp.float32)
                  + gates[:, :, 2] * (y_mem @ w_branch_mem[l]).astype(jnp.float32))
        x = x + merged.astype(dt) @ w_out[l]
        h2 = rms_norm(x, norm2_g[l])
        x = x + conv_glu_ffn(h2, w_ffn_in[l], ffn_conv_w[l], ffn_conv_b[l], w_ffn_out[l]).astype(dt)
    return x
```

```cpp
#include <hip/hip_runtime.h>
#include <hip/hip_cooperative_groups.h>
#include <cstdio>
namespace cg = cooperative_groups;

#ifndef MK_MULTI_LAUNCH
#define MK_MULTI_LAUNCH 0
#endif

#define LAS __attribute__((address_space(3)))
typedef unsigned short bf16_t;
typedef short bf16x8 __attribute__((ext_vector_type(8)));
typedef short s16x4 __attribute__((ext_vector_type(4)));
typedef float f32x2 __attribute__((ext_vector_type(2)));
typedef float f32x4 __attribute__((ext_vector_type(4)));
typedef float f32x16 __attribute__((ext_vector_type(16)));
typedef unsigned u32x2 __attribute__((ext_vector_type(2)));
typedef unsigned u32x4 __attribute__((ext_vector_type(4)));
typedef __bf16 bf16x2_t __attribute__((ext_vector_type(2)));

constexpr int D_MODEL = 1024, BATCH = 32, SEQ = 2048, N_MEM = 256;
constexpr int HB = 16, HTOK = HB * SEQ;
constexpr int IN_COLS = 9728, RET_OFF = 4608, MEMQ_OFF = 6144, GATE_OFF = 6656;
constexpr int D_FF = 2816, FF2 = 5632;
constexpr float NORM_EPS = 1e-6f;
constexpr float LOG2E = 1.4426950408889634f;
constexpr int NPHASE = 14;

constexpr size_t MiB = 1u << 20;
constexpr size_t WS_WIN = 0;
constexpr size_t WS_WKV = 19 * MiB;
constexpr size_t WS_WBR = 21 * MiB;
constexpr size_t WS_WOUT = 24 * MiB;
constexpr size_t WS_WFI = 26 * MiB;
constexpr size_t WS_WFO = 37 * MiB;
constexpr size_t WS_MEMKV = 43 * MiB;
constexpr size_t WS_XB = 60 * MiB;
constexpr size_t WS_R1 = 188 * MiB;
constexpr size_t WS_MEMB = WS_R1;
constexpr size_t WS_ODIL = WS_R1;
constexpr size_t WS_LSE = WS_R1 + 96 * MiB;
constexpr size_t WS_MERGED = WS_XB;
constexpr size_t WS_A2 = 412 * MiB;
constexpr size_t WS_Y3 = 316 * MiB;
constexpr size_t WS_SSQ = WS_Y3;
constexpr size_t WS_HALO = WS_Y3 + 4 * MiB;
constexpr size_t WS_PROJ = 412 * MiB;
constexpr size_t WS_YF = WS_PROJ + 128 * MiB;
constexpr size_t WS_CTL = 1020 * MiB;
constexpr size_t CTL_BYTES = 16384;
constexpr size_t WS_END = WS_CTL + CTL_BYTES;

constexpr int LDS_BYTES = 147456;

__device__ __forceinline__ unsigned pk2(float a, float b) { f32x2 f = {a, b}; bf16x2_t r = __builtin_convertvector(f, bf16x2_t); return __builtin_bit_cast(unsigned, r); }
__device__ __forceinline__ float bflo(unsigned w) { return __uint_as_float(w << 16); }
__device__ __forceinline__ float bfhi(unsigned w) { return __uint_as_float(w & 0xffff0000u); }
__device__ __forceinline__ float wave_sum(float v) {
#pragma unroll
    for (int o = 1; o < 64; o <<= 1) v += __shfl_xor(v, o);
    return v;
}
__device__ __forceinline__ bf16x8 pack8(float a0, float a1, float a2, float a3, float a4, float a5, float a6, float a7) {
    u32x4 p; p.x = pk2(a0, a1); p.y = pk2(a2, a3); p.z = pk2(a4, a5); p.w = pk2(a6, a7); return __builtin_bit_cast(bf16x8, p);
}
#define MFMA32(a, b, c) __builtin_amdgcn_mfma_f32_32x32x16_bf16((a), (b), (c), 0, 0, 0)
__device__ __forceinline__ s16x4 tr_read(LAS char* p) { return __builtin_amdgcn_ds_read_tr16_b64_v4i16((LAS s16x4*)p); }
__device__ __forceinline__ bf16x8 cat4(s16x4 lo, s16x4 hi) { return __builtin_shufflevector(lo, hi, 0, 1, 2, 3, 4, 5, 6, 7); }
__device__ __forceinline__ int slot_of(int c) { return 128 * ((c >> 5) & 1) + 32 * (c >> 6) + 16 * ((c >> 2) & 1) + 4 * ((c >> 3) & 3) + (c & 3); }

namespace pg8 {
constexpr int BM = 256, BK = 64, HALF = 128, HTB = HALF * BK * 2, NXCD = 8, WGM = 8;
__device__ __forceinline__ int lds_byte(int r, int c) { const int st = (r >> 4) * 2 + (c >> 5), rr = r & 15, cc = c & 31, ob = rr * 64 + cc * 2; return st * 1024 + (ob ^ (((ob >> 9) & 1) << 5)); }
__device__ __forceinline__ void stage_rc(int b, int& R, int& C) { const int st = b / 1024, sb = b % 1024, swz = sb ^ (((sb >> 9) & 1) << 5); R = (st >> 1) * 16 + swz / 64; C = (st & 1) * 32 + (swz % 64) / 2; }
struct Unit { int pm, pn; };
struct Gemm { const bf16_t* A; const bf16_t* Bt; int M, N, K; };
struct StaticOrder {
    int nM, nN, nwg, G, c;
    __device__ void init(int M, int N, int G_, int c_) { nM = M / BM; nN = N / BM; nwg = nM * nN; G = G_; c = c_; }
    __device__ bool next(int i, Unit& u) const {
        const long L = (long)i * G + c; if (L >= nwg) return false;
        int wgid = (int)L; { const int q = nwg / NXCD, r = nwg % NXCD, xcd = wgid % NXCD, off = wgid / NXCD; wgid = (xcd < r ? xcd * (q + 1) : r * (q + 1) + (xcd - r) * q) + off; }
        const int nig = WGM * nN, gid = wgid / nig, fm = gid * WGM, gsz = (nM - fm) < WGM ? (nM - fm) : WGM;
        u.pm = fm + ((wgid % nig) % gsz); u.pn = (wgid % nig) / gsz; return true;
    }
};
struct BranchOrder {
    StaticOrder so;
    __device__ void init(int M, int N, int G_, int c_) { so.init(M, N, G_, c_); }
    __device__ bool next(int i, Unit& u) const { Unit t; if (!so.next(i / 3, t)) return false; const int b = i % 3; u.pm = b * (HTOK / BM) + t.pm; u.pn = b * (D_MODEL / BM) + t.pn; return true; }
};

template <class Epi, class Sched>
__device__ __forceinline__ void gemm_phase(LAS unsigned char* lds, const Gemm g, const Sched& S, const Epi& E) {
    int tid = threadIdx.x; asm volatile("" : "+v"(tid));
    const int wid = __builtin_amdgcn_readfirstlane(tid >> 6), lane = tid & 63, wr = wid >> 2, wc = wid & 3, fr = lane & 15, fq = lane >> 4;
    const int K = g.K, nt = K / BK;
    unsigned voffA[2];
#pragma unroll
    for (int i = 0; i < 2; ++i) { int R, C; stage_rc(tid * 16 + i * 8192, R, C); voffA[i] = (unsigned)(R * K + C) * 2u; }
    const size_t kstep = (size_t)(BK * 2);
    const size_t hstep = (size_t)HALF * K * 2;
    const size_t tstep = 2 * hstep;
    const unsigned ldsw = (unsigned)wid * 1024u;
    const int aoff = lds_byte(wr * 64 + fr, fq * 8), boff = lds_byte(wc * 32 + fr, fq * 8);
#define PG8_SA(b, h) (((b) * 2 + (h)) * HTB)
#define PG8_SB(b, h) ((4 + (b) * 2 + (h)) * HTB)
#define PG8_STAGE(bufoff, gbase) do { _Pragma("unroll") for (int _i = 0; _i < 2; ++_i) \
        __builtin_amdgcn_global_load_lds((const unsigned*)((const char*)(gbase) + voffA[_i]), (LAS unsigned*)(lds + (bufoff) + ldsw + _i * 8192), 16, 0, 0); } while (0)
#define PG8_LDA(dst, b, h) do { _Pragma("unroll") for (int m = 0; m < 4; ++m) _Pragma("unroll") for (int k = 0; k < 2; ++k) dst[m][k] = *(const LAS bf16x8*)(lds + PG8_SA(b, h) + aoff + m * 2048 + k * 1024); } while (0)
#define PG8_LDB(dst, b, h) do { _Pragma("unroll") for (int n = 0; n < 2; ++n) _Pragma("unroll") for (int k = 0; k < 2; ++k) dst[n][k] = *(const LAS bf16x8*)(lds + PG8_SB(b, h) + boff + n * 2048 + k * 1024); } while (0)
#define PG8_MMA(ai, bj, At, Bt) do { __builtin_amdgcn_s_setprio(1); _Pragma("unroll") for (int m = 0; m < 4; ++m) _Pragma("unroll") for (int n = 0; n < 2; ++n) _Pragma("unroll") for (int k = 0; k < 2; ++k) \
        acc[ai][bj][m][n] = __builtin_amdgcn_mfma_f32_16x16x32_bf16(Bt[n][k], At[m][k], acc[ai][bj][m][n], 0, 0, 0); __builtin_amdgcn_s_setprio(0); } while (0)
#define PG8_WAIT_V(n) asm volatile("s_waitcnt vmcnt(" #n ")" ::: "memory")
#define PG8_WAIT_L(n) asm volatile("s_waitcnt lgkmcnt(" #n ")" ::: "memory")
#define PG8_BAR __builtin_amdgcn_s_barrier()
#define PG8_SCHED __builtin_amdgcn_sched_barrier(0)
    Unit cur, nxt; int ui = 0;
    if (!S.next(0, cur)) return;
    f32x4 acc[2][2][4][2];
#pragma unroll
    for (int a = 0; a < 2; ++a)
#pragma unroll
        for (int b = 0; b < 2; ++b)
#pragma unroll
            for (int m = 0; m < 4; ++m)
#pragma unroll
                for (int n = 0; n < 2; ++n) acc[a][b][m][n] = (f32x4){0.f, 0.f, 0.f, 0.f};
    bf16x8 At[4][2], B0[2][2], B1[2][2];
    const char* cA = (const char*)g.A + (size_t)cur.pm * tstep; const char* cB = (const char*)g.Bt + (size_t)cur.pn * tstep;
    PG8_STAGE(PG8_SB(0, 0), cB); PG8_STAGE(PG8_SA(0, 0), cA); PG8_STAGE(PG8_SB(0, 1), cB + hstep); PG8_STAGE(PG8_SA(0, 1), cA + hstep);
    if (wr == 1) PG8_BAR;
    PG8_WAIT_V(4); PG8_BAR;
    PG8_STAGE(PG8_SB(1, 0), cB + kstep); PG8_STAGE(PG8_SA(1, 0), cA + kstep); PG8_STAGE(PG8_SB(1, 1), cB + hstep + kstep);
    PG8_WAIT_V(6); PG8_BAR;
    for (;;) {
        const bool has_next = S.next(ui + 1, nxt);
        const char* nA = has_next ? (const char*)g.A + (size_t)nxt.pm * tstep : cA; const char* nB = has_next ? (const char*)g.Bt + (size_t)nxt.pn * tstep : cB;
        for (int t = 0; t < nt; t += 2) {
            const bool last = (t == nt - 2);
            const char* a1 = cA + (size_t)(t + 1) * kstep;
            const char* a2 = last ? nA : cA + (size_t)(t + 2) * kstep; const char* b2 = last ? nB : cB + (size_t)(t + 2) * kstep;
            const char* a3 = a2 + kstep; const char* b3 = b2 + kstep;
            PG8_LDB(B0, 0, 0); PG8_SCHED; PG8_LDA(At, 0, 0); PG8_STAGE(PG8_SA(1, 1), a1 + hstep);
            PG8_WAIT_L(8); PG8_BAR; PG8_WAIT_L(0); PG8_MMA(0, 0, At, B0); PG8_BAR; PG8_SCHED;
            PG8_LDB(B1, 0, 1); PG8_STAGE(PG8_SB(0, 0), b2);
            PG8_BAR; PG8_WAIT_L(0); PG8_MMA(0, 1, At, B1); PG8_BAR;
            PG8_LDA(At, 0, 1); PG8_STAGE(PG8_SA(0, 0), a2);
            PG8_BAR; PG8_WAIT_L(0); PG8_MMA(1, 0, At, B0); PG8_BAR; PG8_SCHED;
            PG8_STAGE(PG8_SB(0, 1), b2 + hstep);
            PG8_WAIT_V(6); PG8_BAR; PG8_MMA(1, 1, At, B1); PG8_BAR;
            PG8_LDB(B0, 1, 0); PG8_SCHED; PG8_LDA(At, 1, 0); PG8_STAGE(PG8_SA(0, 1), a2 + hstep);
            PG8_WAIT_L(8); PG8_BAR; PG8_WAIT_L(0); PG8_MMA(0, 0, At, B0); PG8_BAR; PG8_SCHED;
            PG8_LDB(B1, 1, 1); PG8_STAGE(PG8_SB(1, 0), b3);
            PG8_BAR; PG8_WAIT_L(0); PG8_MMA(0, 1, At, B1); PG8_BAR;
            PG8_LDA(At, 1, 1); PG8_STAGE(PG8_SA(1, 0), a3);
            PG8_BAR; PG8_WAIT_L(0); PG8_MMA(1, 0, At, B0); PG8_BAR; PG8_SCHED;
            PG8_STAGE(PG8_SB(1, 1), b3 + hstep);
            PG8_WAIT_V(6); PG8_BAR; PG8_MMA(1, 1, At, B1); PG8_BAR;
        }
        E(acc, cur, wr, wc, fr, fq);
        if (!has_next) break;
#pragma unroll
        for (int a = 0; a < 2; ++a)
#pragma unroll
            for (int b = 0; b < 2; ++b)
#pragma unroll
                for (int m = 0; m < 4; ++m)
#pragma unroll
                    for (int n = 0; n < 2; ++n) acc[a][b][m][n] = (f32x4){0.f, 0.f, 0.f, 0.f};
        cur = nxt; cA = nA; cB = nB; ++ui;
    }
    PG8_WAIT_V(0);
    if (wr == 0) PG8_BAR;
    PG8_BAR;
#undef PG8_SA
#undef PG8_SB
#undef PG8_STAGE
#undef PG8_LDA
#undef PG8_LDB
#undef PG8_MMA
#undef PG8_WAIT_V
#undef PG8_WAIT_L
#undef PG8_BAR
#undef PG8_SCHED
}
}
using pg8::Unit;

#define EPI_ROWS_BEGIN _Pragma("unroll") for (int ai = 0; ai < 2; ++ai) _Pragma("unroll") for (int m = 0; m < 4; ++m) { const int rloc = ai * 128 + wr * 64 + m * 16 + fr; float v[16]; \
    _Pragma("unroll") for (int bj = 0; bj < 2; ++bj) _Pragma("unroll") for (int n = 0; n < 2; ++n) _Pragma("unroll") for (int j = 0; j < 4; ++j) v[8 * bj + 4 * n + j] = acc[ai][bj][m][n][j];
#define EPI_ROWS_END }
__device__ __forceinline__ void store16_bf16(bf16_t* p, const float (&v)[16]) {
    u32x4 a, b; a.x = pk2(v[0], v[1]); a.y = pk2(v[2], v[3]); a.z = pk2(v[4], v[5]); a.w = pk2(v[6], v[7]);
    b.x = pk2(v[8], v[9]); b.y = pk2(v[10], v[11]); b.z = pk2(v[12], v[13]); b.w = pk2(v[14], v[15]);
    *(u32x4*)p = a; *(u32x4*)(p + 32) = b;
}
__device__ __forceinline__ void load16_bf16(const bf16_t* p, float (&v)[16]) {
    const u32x4 a = *(const u32x4*)p, b = *(const u32x4*)(p + 32);
    v[0] = bflo(a.x); v[1] = bfhi(a.x); v[2] = bflo(a.y); v[3] = bfhi(a.y); v[4] = bflo(a.z); v[5] = bfhi(a.z); v[6] = bflo(a.w); v[7] = bfhi(a.w);
    v[8] = bflo(b.x); v[9] = bfhi(b.x); v[10] = bflo(b.y); v[11] = bfhi(b.y); v[12] = bflo(b.z); v[13] = bfhi(b.z); v[14] = bflo(b.w); v[15] = bfhi(b.w);
}
__device__ __forceinline__ void load16_f32(const float* p, float (&v)[16]) {
#pragma unroll
    for (int q = 0; q < 4; ++q) { const f32x4 t = *(const f32x4*)(p + 4 * (q & 1) + 32 * (q >> 1)); v[4 * q] = t.x; v[4 * q + 1] = t.y; v[4 * q + 2] = t.z; v[4 * q + 3] = t.w; }
}
__device__ __forceinline__ void store16_f32(float* p, const float (&v)[16]) {
#pragma unroll
    for (int q = 0; q < 4; ++q) *(f32x4*)(p + 4 * (q & 1) + 32 * (q >> 1)) = (f32x4){v[4 * q], v[4 * q + 1], v[4 * q + 2], v[4 * q + 3]};
}
__device__ __forceinline__ void nt_store16(u32x4* p, u32x4 v) { __builtin_nontemporal_store(v, p); }
__device__ __forceinline__ void store16_bf16_nt(bf16_t* p, const float (&v)[16]) {
    u32x4 a, b; a.x = pk2(v[0], v[1]); a.y = pk2(v[2], v[3]); a.z = pk2(v[4], v[5]); a.w = pk2(v[6], v[7]);
    b.x = pk2(v[8], v[9]); b.y = pk2(v[10], v[11]); b.z = pk2(v[12], v[13]); b.w = pk2(v[14], v[15]);
    nt_store16((u32x4*)p, a); nt_store16((u32x4*)(p + 32), b);
}
__device__ __forceinline__ void store16_f32_nt(float* p, const float (&v)[16]) {
#pragma unroll
    for (int q = 0; q < 4; ++q) { f32x4 t = (f32x4){v[4 * q], v[4 * q + 1], v[4 * q + 2], v[4 * q + 3]}; __builtin_nontemporal_store(t, (f32x4*)(p + 4 * (q & 1) + 32 * (q >> 1))); }
}
__device__ __forceinline__ void load16c_bf16(const bf16_t* p, float (&v)[16]) {
    const u32x4 a = *(const u32x4*)p, b = *(const u32x4*)(p + 8);
    v[0] = bflo(a.x); v[1] = bfhi(a.x); v[2] = bflo(a.y); v[3] = bfhi(a.y); v[4] = bflo(a.z); v[5] = bfhi(a.z); v[6] = bflo(a.w); v[7] = bfhi(a.w);
    v[8] = bflo(b.x); v[9] = bfhi(b.x); v[10] = bflo(b.y); v[11] = bfhi(b.y); v[12] = bflo(b.z); v[13] = bfhi(b.z); v[14] = bflo(b.w); v[15] = bfhi(b.w);
}
__device__ __forceinline__ void load16c_f32(const float* p, float (&v)[16]) {
#pragma unroll
    for (int q = 0; q < 4; ++q) { const f32x4 t = *(const f32x4*)(p + 4 * q); v[4 * q] = t.x; v[4 * q + 1] = t.y; v[4 * q + 2] = t.z; v[4 * q + 3] = t.w; }
}

__device__ __forceinline__ size_t pofs(int row, int col) { return ((size_t)((row >> 8) * (IN_COLS / 256) + (col >> 8)) << 16) + (size_t)(((row & 255) << 8) + (col & 255)); }
constexpr float QSCALE_DIL = 0.125f * LOG2E;

struct EpiProj {
    bf16_t* P; const float* gq; const float* gk;
    __device__ __forceinline__ void operator()(const f32x4 (&acc)[2][2][4][2], const Unit& u, int wr, int wc, int fr, int fq) const {
        const int pn = u.pn; int mode = 0; const float* gain = gq; float sc = 1.f;
        if (pn < 18) { const int g = pn / 6, t = (pn % 6) >> 1; if (t == 0) { mode = 1; gain = gq + g * 64; sc = QSCALE_DIL; } else if (t == 1) { mode = 1; gain = gk + g * 64; } }
        else if (pn == 19) { mode = 2; sc = 0.125f; }
        else if (pn == 22 || pn == 23) mode = 4;
        else if (pn >= 26) mode = 3;
        float gv[16];
#pragma unroll
        for (int e = 0; e < 16; ++e) gv[e] = 1.f;
        if (mode == 1) load16_f32(gain + fq * 8, gv);
        const int col0 = pn * 256 + wc * 64 + fq * 8;
        EPI_ROWS_BEGIN
            if (mode == 1) {
                float ss = 0.f;
#pragma unroll
                for (int e = 0; e < 16; ++e) ss += v[e] * v[e];
                ss += __shfl_xor(ss, 16); ss += __shfl_xor(ss, 32);
                const float rs = rsqrtf(ss * (1.f / 64.f) + NORM_EPS) * sc;
#pragma unroll
                for (int e = 0; e < 16; ++e) v[e] = v[e] * rs * gv[e];
            } else if (mode == 2) {
#pragma unroll
                for (int e = 0; e < 16; ++e) v[e] *= sc;
            } else if (mode == 3) {
#pragma unroll
                for (int e = 0; e < 16; ++e) v[e] = __builtin_amdgcn_rcpf(1.f + __builtin_amdgcn_exp2f(-LOG2E * v[e]));
            } else if (mode == 4) {
#pragma unroll
                for (int e = 0; e < 16; ++e) v[e] = v[e] * __builtin_amdgcn_rcpf(1.f + __builtin_amdgcn_exp2f(-LOG2E * v[e]));
            }
            store16_bf16_nt(P + pofs(u.pm * 256 + rloc, col0), v);
        EPI_ROWS_END
    }
};
struct EpiPlainBf16 {
    bf16_t* O; int ldc;
    __device__ __forceinline__ void operator()(const f32x4 (&acc)[2][2][4][2], const Unit& u, int wr, int wc, int fr, int fq) const {
        const int col0 = u.pn * 256 + wc * 64 + fq * 8;
        EPI_ROWS_BEGIN
            store16_bf16(O + (size_t)(u.pm * 256 + rloc) * ldc + col0, v);
        EPI_ROWS_END
    }
};
struct EpiBranch {
    bf16_t* Mg; const bf16_t* P;
    __device__ __forceinline__ void operator()(const f32x4 (&acc)[2][2][4][2], const Unit& u, int wr, int wc, int fr, int fq) const {
        const int b = u.pn >> 2, pn = u.pn & 3, pm = u.pm - b * (HTOK / 256);
        const int col0 = pn * 256 + wc * 64 + fq * 8;
        EPI_ROWS_BEGIN
            const size_t row = (size_t)(pm * 256 + rloc);
            float gt[16]; load16_bf16(P + pofs((int)row, GATE_OFF + b * 1024 + col0), gt);
            bf16_t* mp = Mg + row * D_MODEL + col0;
            if (b == 0) {
#pragma unroll
                for (int e = 0; e < 16; ++e) v[e] = v[e] * gt[e];
            } else {
                float old[16]; load16_bf16(mp, old);
#pragma unroll
                for (int e = 0; e < 16; ++e) v[e] = old[e] + v[e] * gt[e];
            }
            store16_bf16(mp, v);
        EPI_ROWS_END
    }
};
struct EpiOut {
    const float* X; float* Out; bf16_t* A2; const float* g2; float* ssq;
    __device__ __forceinline__ void operator()(const f32x4 (&acc)[2][2][4][2], const Unit& u, int wr, int wc, int fr, int fq) const {
        const int col0 = u.pn * 256 + wc * 64 + fq * 8;
        float gv[16]; load16_f32(g2 + col0, gv);
        EPI_ROWS_BEGIN
            const size_t row = (size_t)(u.pm * 256 + rloc);
            float xv[16]; load16_f32(X + row * D_MODEL + col0, xv);
            float ss = 0.f;
#pragma unroll
            for (int e = 0; e < 16; ++e) { v[e] += xv[e]; ss += v[e] * v[e]; }
            store16_f32_nt(Out + row * D_MODEL + col0, v);
#pragma unroll
            for (int e = 0; e < 16; ++e) v[e] *= gv[e];
            store16_bf16_nt(A2 + row * D_MODEL + col0, v);
            ss += __shfl_xor(ss, 16); ss += __shfl_xor(ss, 32);
            if (fq == 0) ssq[row * 16 + u.pn * 4 + wc] = ss;
        EPI_ROWS_END
    }
};
__device__ __forceinline__ float gelu_exact(float v) {
    const float t = __builtin_amdgcn_rcpf(fabsf(v) * 0.2316418882f + 1.0f);
    float q = t * 0.5307027145f + (-0.7265760135f); q = q * t + 0.7107068705f; q = q * t + (-0.142248368f); q = q * t + 0.127414796f; q = q * t;
    const float e = __builtin_amdgcn_exp2f(v * v * (-0.72134752044f));
    const float m = v * (q * e);
    return v < 0.f ? m : v - m;
}
__device__ __forceinline__ f32x2 gelu_pk(f32x2 v) {
    const f32x2 av = __builtin_elementwise_abs(v), d = av * 0.2316418882f + 1.0f;
    f32x2 t; t.x = __builtin_amdgcn_rcpf(d.x); t.y = __builtin_amdgcn_rcpf(d.y);
    f32x2 q = t * 0.5307027145f + (-0.7265760135f); q = q * t + 0.7107068705f; q = q * t + (-0.142248368f); q = q * t + 0.127414796f; q = q * t;
    const f32x2 sq = (v * v) * (-0.72134752044f);
    f32x2 e; e.x = __builtin_amdgcn_exp2f(sq.x); e.y = __builtin_amdgcn_exp2f(sq.y);
    const f32x2 m = v * (q * e), r = v - m;
    f32x2 o; o.x = v.x < 0.f ? m.x : r.x; o.y = v.y < 0.f ? m.y : r.y; return o;
}
struct EpiFfnInConv {
    bf16_t* YF; bf16_t* HALO; const float* ssq; const float* cw; const float* cb;
    __device__ __forceinline__ void operator()(const f32x4 (&acc)[2][2][4][2], const Unit& u, int wr, int wc, int fr, int fq) const {
        const int lane = fq * 16 + fr, chb = u.pn * 128 + wc * 32 + fq * 8;
        const int idx_prev = (lane & 48) | ((fr + 15) & 15), idx_next = (lane & 48) | ((fr + 1) & 15);
#pragma unroll
        for (int ai = 0; ai < 2; ++ai) {
            float rs[4];
#pragma unroll
            for (int m = 0; m < 4; ++m) { const unsigned row = (unsigned)(u.pm * 256 + ai * 128 + wr * 64 + m * 16 + fr); float sp[16]; load16c_f32(ssq + row * 16u, sp); float ss = 0.f;
#pragma unroll
                for (int e = 0; e < 16; ++e) ss += sp[e];
                rs[m] = rsqrtf(ss * (1.f / 1024.f) + NORM_EPS); asm volatile("" ::: "memory"); }
            const int blk = u.pm * 4 + 2 * ai + wr;
            u32x2 keep[4];
#pragma unroll
            for (int n = 0; n < 2; ++n) {
                const f32x4 w0 = *(const f32x4*)(cw + chb + 4 * n), w1 = *(const f32x4*)(cw + D_FF + chb + 4 * n), w2 = *(const f32x4*)(cw + 2 * D_FF + chb + 4 * n), bb = *(const f32x4*)(cb + chb + 4 * n);
#pragma unroll
                for (int m = 0; m < 4; ++m) {
                    float yv[4], uc[4], gc[4];
#pragma unroll
                    for (int j = 0; j < 4; ++j) {
                        const float ucur = acc[ai][0][m][n][j] * rs[m];
                        const float um1 = m > 0 ? acc[ai][0][m > 0 ? m - 1 : 0][n][j] * rs[m > 0 ? m - 1 : 0] : 0.f;
                        const float up1 = m < 3 ? acc[ai][0][m < 3 ? m + 1 : 3][n][j] * rs[m < 3 ? m + 1 : 3] : 0.f;
                        const float uprev = __builtin_bit_cast(float, __builtin_amdgcn_update_dpp(0, __builtin_bit_cast(int, fr == 15 ? um1 : ucur), 0x121, 0xf, 0xf, false));
                        const float unext = __builtin_bit_cast(float, __builtin_amdgcn_update_dpp(0, __builtin_bit_cast(int, fr == 0 ? up1 : ucur), 0x12F, 0xf, 0xf, false));
                        yv[j] = bb[j] + w0[j] * uprev + w1[j] * ucur + w2[j] * unext;
                        uc[j] = ucur; gc[j] = acc[ai][1][m][n][j] * rs[m];
                    }
                    { const f32x2 g01 = gelu_pk((f32x2){yv[0], yv[1]}), g23 = gelu_pk((f32x2){yv[2], yv[3]});
                      yv[0] = g01.x * gc[0]; yv[1] = g01.y * gc[1]; yv[2] = g23.x * gc[2]; yv[3] = g23.y * gc[3]; }
                    const unsigned row = (unsigned)(u.pm * 256 + ai * 128 + wr * 64 + m * 16 + fr);
                    const bool e0 = (m == 0 && fr == 0), e63 = (m == 3 && fr == 15);
                    { u32x2 o; o.x = pk2(yv[0], yv[1]); o.y = pk2(yv[2], yv[3]);
                      if (n == 0) keep[m] = o;
                      else if (!(e0 || e63)) { u32x4 o4; o4.x = keep[m].x; o4.y = keep[m].y; o4.z = o.x; o4.w = o.y; __builtin_nontemporal_store(o4, (u32x4*)(YF + (row * (unsigned)D_FF + (unsigned)chb))); } }
                    if (m == 0 || m == 3) {
                        const int hs = m == 0 ? (fr == 0 ? 0 : (fr == 1 ? 1 : -1)) : (fr == 14 ? 2 : (fr == 15 ? 3 : -1));
                        if (hs >= 0) { u32x2 o; o.x = pk2(uc[0], uc[1]); o.y = pk2(uc[2], uc[3]); *(u32x2*)(HALO + ((unsigned)(blk * 6 + hs) * (unsigned)D_FF + (unsigned)(chb + 4 * n))) = o; }
                        if (e0 || e63) { u32x2 o; o.x = pk2(gc[0], gc[1]); o.y = pk2(gc[2], gc[3]); *(u32x2*)(HALO + ((unsigned)(blk * 6 + (e0 ? 4 : 5)) * (unsigned)D_FF + (unsigned)(chb + 4 * n))) = o; }
                    }
                    asm volatile("" ::: "memory");
                }
            }
        }
    }
};
struct EpiFfnOut {
    float* Out;
    __device__ __forceinline__ void operator()(const f32x4 (&acc)[2][2][4][2], const Unit& u, int wr, int wc, int fr, int fq) const {
        const int col0 = u.pn * 256 + wc * 64 + fq * 8;
        EPI_ROWS_BEGIN
            float* op = Out + (size_t)(u.pm * 256 + rloc) * D_MODEL + col0;
            float xv[16]; load16_f32(op, xv);
#pragma unroll
            for (int e = 0; e < 16; ++e) v[e] += xv[e];
            store16_f32_nt(op, v);
        EPI_ROWS_END
    }
};

__device__ __forceinline__ int ffn_row_of(int ng) { const int gate = ng >= D_FF ? 1 : 0, ch = ng - gate * D_FF, c7 = ch & 127;
    return (ch >> 7) * 256 + 128 * gate + 32 * (c7 >> 5) + 16 * ((c7 >> 2) & 1) + 4 * ((c7 >> 3) & 3) + (c7 & 3); }
template <int PERMMODE>
__device__ __forceinline__ void p0_transpose_item(const float* W, int K, int N, bf16_t* WT, int row_off, LAS float* scr, int item, int lane) {
    const int nblk = N / 32, kb = item / nblk, nb = item % nblk, k0 = 64 * kb, n0 = 32 * nb;
#pragma unroll 8
    for (int i = 0; i < 32; ++i) { const int kk = 2 * i + (lane >> 5); scr[kk * 33 + (lane & 31)] = W[(size_t)(k0 + kk) * N + n0 + (lane & 31)]; }
    asm volatile("s_waitcnt lgkmcnt(0)" ::: "memory");
    const int c = lane & 7;
#pragma unroll
    for (int j = 0; j < 4; ++j) { const int n = (lane >> 3) + 8 * j; const LAS float* s = scr + (8 * c) * 33 + n;
        u32x4 o; o.x = pk2(s[0 * 33], s[1 * 33]); o.y = pk2(s[2 * 33], s[3 * 33]); o.z = pk2(s[4 * 33], s[5 * 33]); o.w = pk2(s[6 * 33], s[7 * 33]);
        const int ng = n0 + n, nrow = PERMMODE == 1 ? ffn_row_of(ng) : (ng & ~255) + slot_of(ng & 255);
        *(u32x4*)(WT + (size_t)(row_off + nrow) * K + k0 + 8 * c) = o; }
    asm volatile("s_waitcnt lgkmcnt(0)" ::: "memory");
}
__device__ __forceinline__ void rms_row_to_bf16(const float* xrow, const float* g, bf16_t* orow, int lane) {
    const f32x4* xr = (const f32x4*)xrow + lane; const f32x4* gr = (const f32x4*)g + lane;
    f32x4 v[4]; float s = 0.f;
#pragma unroll
    for (int j = 0; j < 4; ++j) { v[j] = xr[64 * j]; s += (v[j].x * v[j].x + v[j].y * v[j].y) + (v[j].z * v[j].z + v[j].w * v[j].w); }
    const float rs = rsqrtf(wave_sum(s) * (1.f / 1024.f) + NORM_EPS);
    u32x2* o8 = (u32x2*)orow + lane;
#pragma unroll
    for (int j = 0; j < 4; ++j) { const f32x4 gg = gr[64 * j]; u32x2 w; w.x = pk2(v[j].x * rs * gg.x, v[j].y * rs * gg.y); w.y = pk2(v[j].z * rs * gg.z, v[j].w * rs * gg.w); o8[64 * j] = w; }
}

__device__ __forceinline__ void rms_row2_to_bf16(const float* xa, const float* xb, const float* g, bf16_t* oa, bf16_t* ob, int lane) {
    const f32x4* ra = (const f32x4*)xa + lane; const f32x4* rb = (const f32x4*)xb + lane; const f32x4* gr = (const f32x4*)g + lane;
    f32x4 va[4], vb[4]; float sa = 0.f, sb = 0.f;
#pragma unroll
    for (int j = 0; j < 4; ++j) { va[j] = ra[64 * j]; vb[j] = rb[64 * j]; }
#pragma unroll
    for (int j = 0; j < 4; ++j) { sa += (va[j].x * va[j].x + va[j].y * va[j].y) + (va[j].z * va[j].z + va[j].w * va[j].w); sb += (vb[j].x * vb[j].x + vb[j].y * vb[j].y) + (vb[j].z * vb[j].z + vb[j].w * vb[j].w); }
#pragma unroll
    for (int o = 1; o < 64; o <<= 1) { sa += __shfl_xor(sa, o); sb += __shfl_xor(sb, o); }
    const float rsa = rsqrtf(sa * (1.f / 1024.f) + NORM_EPS), rsb = rsqrtf(sb * (1.f / 1024.f) + NORM_EPS);
    u32x2* o8a = (u32x2*)oa + lane; u32x2* o8b = (u32x2*)ob + lane;
#pragma unroll
    for (int j = 0; j < 4; ++j) { const f32x4 gg = gr[64 * j]; u32x2 w;
        w.x = pk2(va[j].x * rsa * gg.x, va[j].y * rsa * gg.y); w.y = pk2(va[j].z * rsa * gg.z, va[j].w * rsa * gg.w); o8a[64 * j] = w;
        w.x = pk2(vb[j].x * rsb * gg.x, vb[j].y * rsb * gg.y); w.y = pk2(vb[j].z * rsb * gg.z, vb[j].w * rsb * gg.w); o8b[64 * j] = w; }
}


__device__ __forceinline__ void dil_wave(const bf16_t* proj, bf16_t* odil, float* lse, const float* cconst, int item, LAS char* vl, int lane) {
    asm volatile("" : "+v"(lane));
    const int qb = item & 31; int t = item >> 5; const int g = t % 3; t /= 3; const int h = t & 7, b = t >> 3;
    const float cshift = cconst[g];
    const int lr = 2 * g, r = 1 << lr, nsub = SEQ >> lr, nblk = nsub >> 6;
    const int c = qb / nblk, nb = qb % nblk, i0 = nb * 64;
    const int rr = lane & 31, hh = lane >> 5;
    const int rowb = b * SEQ;
    const int qcol = g * 1536 + h * 64, kcol = qcol + 512, vcol = qcol + 1024;
    const int kt_lo = i0 == 0 ? 2 : 0, kt_hi = (i0 == nsub - 64) ? 4 : 6;
    bf16x8 kn[4];
#define DIL_ISSUE(KT) do { const int j0_ = i0 - 64 + 32 * (KT); \
        { int jr = j0_ + rr; jr = jr < 0 ? 0 : (jr >= nsub ? nsub - 1 : jr); const bf16_t* p = proj + pofs(rowb + jr * r + c, kcol + 32 * hh); \
          _Pragma("unroll") for (int ks = 0; ks < 4; ++ks) kn[ks] = *(const bf16x8*)(p + 8 * ks); } \
        _Pragma("unroll") for (int q = 0; q < 4; ++q) { int jv = j0_ + 8 * q + (lane >> 3); jv = jv < 0 ? 0 : (jv >= nsub ? nsub - 1 : jv); \
          __builtin_amdgcn_global_load_lds((const unsigned*)(proj + pofs(rowb + jv * r + c, vcol + 8 * (lane & 7))), (LAS unsigned*)(vl + 4096 * ((KT) & 1) + 1024 * q), 16, 0, 0); } } while (0)
    DIL_ISSUE(kt_lo);
    bf16x8 qf[2][4];
#pragma unroll
    for (int qt = 0; qt < 2; ++qt) { const int tok = (i0 + 32 * qt + rr) * r + c; const bf16_t* p = proj + pofs(rowb + tok, qcol + 32 * hh);
#pragma unroll
        for (int ks = 0; ks < 4; ++ks) qf[qt][ks] = *(const bf16x8*)(p + 8 * ks); }
    f32x16 o[2][2];
#pragma unroll
    for (int a = 0; a < 2; ++a)
#pragma unroll
        for (int q = 0; q < 2; ++q)
#pragma unroll
            for (int e = 0; e < 16; ++e) o[a][q][e] = 0.f;
    float lrun[2] = {0.f, 0.f};
    const float slope2 = exp2f(-(float)(h + 1)) * (float)r * LOG2E;
    const int blk = (lane >> 4) & 1, q4 = (lane & 15) >> 2, p4 = lane & 3;
    float fd[16];
#pragma unroll
    for (int e = 0; e < 16; ++e) fd[e] = (float)(rr - 4 * hh - ((e & 3) + 8 * (e >> 2)));
#ifdef PROBE_DILLOOP
    for (int rep = 0; rep < 2; ++rep) {
    if (rep) { DIL_ISSUE(kt_lo); lrun[0] = 0.f; lrun[1] = 0.f;
        _Pragma("unroll") for (int a = 0; a < 2; ++a) _Pragma("unroll") for (int q = 0; q < 2; ++q) _Pragma("unroll") for (int e = 0; e < 16; ++e) o[a][q][e] = 0.f; }
#endif
    for (int kt = kt_lo; kt < kt_hi; ++kt) {
        asm volatile("s_waitcnt vmcnt(0)" ::: "memory");
        bf16x8 kf[4];
#pragma unroll
        for (int ks = 0; ks < 4; ++ks) kf[ks] = kn[ks];
        if (kt + 1 < kt_hi) DIL_ISSUE(kt + 1);
        asm volatile("" ::: "memory");
        LAS char* vb = vl + 4096 * (kt & 1);
        bf16x8 pf[2][2];
        bool act[2];
#pragma unroll
        for (int qt = 0; qt < 2; ++qt) {
            const int mrel = kt - qt;
            act[qt] = !(mrel == 5 || mrel == -1);
            if (!act[qt]) continue;
            f32x16 s;
#pragma unroll
            for (int e = 0; e < 16; ++e) s[e] = -cshift;
#pragma unroll
            for (int ks = 0; ks < 4; ++ks) s = MFMA32(kf[ks], qf[qt][ks], s);
            const float Df = 64.f - 32.f * (float)mrel;
            const bool edge = (mrel == 0) || (mrel == 4);
            float rs = 0.f;
#pragma unroll
            for (int e = 0; e < 16; ++e) { const float tt = Df + fd[e]; float sv = fmaf(-slope2, fabsf(tt), s[e]);
                if (edge) sv = fabsf(tt) <= 64.f ? sv : -INFINITY;
                const float p = __builtin_amdgcn_exp2f(sv); s[e] = p; rs += p; }
            lrun[qt] += rs;
#pragma unroll
            for (int s2 = 0; s2 < 2; ++s2) pf[qt][s2] = pack8(s[8 * s2], s[8 * s2 + 1], s[8 * s2 + 2], s[8 * s2 + 3], s[8 * s2 + 4], s[8 * s2 + 5], s[8 * s2 + 6], s[8 * s2 + 7]);
        }
#pragma unroll
        for (int dt = 0; dt < 2; ++dt)
#pragma unroll
            for (int s2 = 0; s2 < 2; ++s2) {
                LAS char* a = vb + (16 * s2 + 4 * hh + q4) * 128 + (32 * dt + 16 * blk + 4 * p4) * 2;
                const bf16x8 vf = cat4(tr_read(a), tr_read(a + 8 * 128));
#pragma unroll
                for (int qt = 0; qt < 2; ++qt) if (act[qt]) o[dt][qt] = MFMA32(vf, pf[qt][s2], o[dt][qt]);
            }
        asm volatile("" ::: "memory");
    }
#ifdef PROBE_DILLOOP
    }
#endif
#undef DIL_ISSUE
#pragma unroll
    for (int qt = 0; qt < 2; ++qt) {
        const float lt = lrun[qt] + __shfl_xor(lrun[qt], 32);
        const int row = 32 * qt + rr; const float inv = __builtin_amdgcn_rcpf(lt);
#pragma unroll
        for (int dt = 0; dt < 2; ++dt)
#pragma unroll
            for (int gq = 0; gq < 4; ++gq) { u32x2 w; w.x = pk2(o[dt][qt][4 * gq] * inv, o[dt][qt][4 * gq + 1] * inv); w.y = pk2(o[dt][qt][4 * gq + 2] * inv, o[dt][qt][4 * gq + 3] * inv);
                *(LAS u32x2*)(vl + row * 128 + 16 * ((4 * dt + gq) ^ (row & 7)) + 8 * hh) = w; }
        if (hh == 0) lse[((size_t)g * HTOK + (size_t)b * SEQ + (i0 + row) * r + c) * 8 + h] = log2f(lt) + cshift;
    }
    asm volatile("" ::: "memory");
    { bf16_t* ob = odil + ((size_t)g * HTOK + (size_t)b * SEQ) * 512 + h * 64;
#pragma unroll
        for (int q = 0; q < 8; ++q) { const int row = 8 * q + (lane >> 3), pos = lane & 7, ch = pos ^ (row & 7);
            const u32x4 v = *(const LAS u32x4*)(vl + row * 128 + 16 * pos);
            *(u32x4*)(ob + (size_t)((i0 + row) * r + c) * 512 + 8 * ch) = v; } }
    asm volatile("" ::: "memory");
}

__device__ __forceinline__ void ret_u_item(const bf16_t* proj, bf16_t* U, const float* decay_logit, int item, LAS char* L, int tid) {
    asm volatile("" : "+v"(tid));
    const int n = item & 15, h = (item >> 4) & 3, b = item >> 6;
    const int lane = tid & 63, wave = tid >> 6, rr = lane & 31, hh = lane >> 5, blk = (lane >> 4) & 1, q4 = (lane & 15) >> 2, p4 = lane & 3;
    const float Lf = -log1pf(expf(-decay_logit[h])) * LOG2E, Lb = -log1pf(expf(-decay_logit[4 + h])) * LOG2E;
    const int rowb = b * SEQ + 128 * n;
    { const int row = tid >> 2, pc = tid & 3; const bf16_t* p = proj + pofs(rowb + row, RET_OFF + 256 + h * 64 + 16 * pc);
        const u32x4 a = *(const u32x4*)p, c = *(const u32x4*)(p + 8);
        const float wf = exp2f(Lf * (float)(127 - row)), wb = exp2f(Lb * (float)row);
        u32x4 o;
        o.x = pk2(bflo(a.x) * wf, bfhi(a.x) * wf); o.y = pk2(bflo(a.y) * wf, bfhi(a.y) * wf); o.z = pk2(bflo(a.z) * wf, bfhi(a.z) * wf); o.w = pk2(bflo(a.w) * wf, bfhi(a.w) * wf);
        *(LAS u32x4*)(L + row * 128 + 32 * pc) = o;
        o.x = pk2(bflo(c.x) * wf, bfhi(c.x) * wf); o.y = pk2(bflo(c.y) * wf, bfhi(c.y) * wf); o.z = pk2(bflo(c.z) * wf, bfhi(c.z) * wf); o.w = pk2(bflo(c.w) * wf, bfhi(c.w) * wf);
        *(LAS u32x4*)(L + row * 128 + 32 * pc + 16) = o;
        o.x = pk2(bflo(a.x) * wb, bfhi(a.x) * wb); o.y = pk2(bflo(a.y) * wb, bfhi(a.y) * wb); o.z = pk2(bflo(a.z) * wb, bfhi(a.z) * wb); o.w = pk2(bflo(a.w) * wb, bfhi(a.w) * wb);
        *(LAS u32x4*)(L + 16384 + row * 128 + 32 * pc) = o;
        o.x = pk2(bflo(c.x) * wb, bfhi(c.x) * wb); o.y = pk2(bflo(c.y) * wb, bfhi(c.y) * wb); o.z = pk2(bflo(c.z) * wb, bfhi(c.z) * wb); o.w = pk2(bflo(c.w) * wb, bfhi(c.w) * wb);
        *(LAS u32x4*)(L + 16384 + row * 128 + 32 * pc + 16) = o; }
#pragma unroll
    for (int q = 0; q < 4; ++q) { const int idx = tid + 512 * q, row = idx >> 4, pc = idx & 15;
        *(LAS u32x4*)(L + 32768 + row * 256 + 16 * pc) = *(const u32x4*)(proj + pofs(rowb + row, RET_OFF + 512 + h * 128 + 8 * pc)); }
    __syncthreads();
    const int dir = wave >> 2, vt = wave & 3;
    f32x16 acc[2];
#pragma unroll
    for (int a = 0; a < 2; ++a)
#pragma unroll
        for (int e = 0; e < 16; ++e) acc[a][e] = 0.f;
    LAS char* KI = L + 16384 * dir; LAS char* VI = L + 32768;
#pragma unroll
    for (int ks = 0; ks < 8; ++ks) {
        const int jrow = 16 * ks + 8 * hh + q4;
        LAS char* vb = VI + jrow * 256 + (32 * vt + 16 * blk + 4 * p4) * 2;
        const bf16x8 bfr = cat4(tr_read(vb), tr_read(vb + 4 * 256));
#pragma unroll
        for (int dt = 0; dt < 2; ++dt) { LAS char* ka = KI + jrow * 128 + (32 * dt + 16 * blk + 4 * p4) * 2;
            const bf16x8 afr = cat4(tr_read(ka), tr_read(ka + 4 * 128));
            acc[dt] = MFMA32(afr, bfr, acc[dt]); }
    }
    bf16_t* up = U + ((size_t)((b * 4 + h) * 16 + n) * 2 + dir) * 8192;
#pragma unroll
    for (int dt = 0; dt < 2; ++dt)
#pragma unroll
        for (int e = 0; e < 16; ++e) up[(32 * dt + (e & 3) + 8 * (e >> 2) + 4 * hh) * 128 + 32 * vt + rr] = (bf16_t)(pk2(acc[dt][e], 0.f) & 0xffffu);
    __syncthreads();
}
__device__ __forceinline__ bf16x8 scale_frag(bf16x8 f, float sc) {
    const u32x4 w = __builtin_bit_cast(u32x4, f);
    return pack8(bflo(w.x) * sc, bfhi(w.x) * sc, bflo(w.y) * sc, bfhi(w.y) * sc, bflo(w.z) * sc, bfhi(w.z) * sc, bflo(w.w) * sc, bfhi(w.w) * sc);
}
__device__ __forceinline__ void st16_lds_bf16(LAS char* p, const float (&v)[16]) {
    u32x4 a, b; a.x = pk2(v[0], v[1]); a.y = pk2(v[2], v[3]); a.z = pk2(v[4], v[5]); a.w = pk2(v[6], v[7]);
    b.x = pk2(v[8], v[9]); b.y = pk2(v[10], v[11]); b.z = pk2(v[12], v[13]); b.w = pk2(v[14], v[15]);
    *(LAS u32x4*)p = a; *(LAS u32x4*)(p + 16) = b;
}
__device__ __forceinline__ void ret_chunk_item(const bf16_t* proj, const bf16_t* U, bf16_t* yret, const float* decay_logit, const float* gn_g, int item, LAS char* L, int tid) {
    asm volatile("" : "+v"(tid));
    const int pr = item & 7, h = (item >> 3) & 3, b = item >> 5, n = 2 * pr;
    const int lane = tid & 63, wave = tid >> 6, rr = lane & 31, hh = lane >> 5, blk = (lane >> 4) & 1, q4 = (lane & 15) >> 2, p4 = lane & 3;
    const float Lf = -log1pf(expf(-decay_logit[h])) * LOG2E, Lb = -log1pf(expf(-decay_logit[4 + h])) * LOG2E;
    const int rowb = b * SEQ + 128 * n;
#pragma unroll
    for (int q = 0; q < 8; ++q) { const int idx = tid + 512 * q, row = idx >> 4, pc = idx & 15;
        *(LAS u32x4*)(L + row * 256 + 16 * pc) = *(const u32x4*)(proj + pofs(rowb + row, RET_OFF + 512 + h * 128 + 8 * pc)); }
    { const bf16_t* Ub = U + (size_t)((b * 4 + h) * 16) * 2 * 8192 + tid * 16;
        const float wf = exp2f(128.f * Lf), wb = exp2f(128.f * Lb);
        const int d = tid >> 3, v0 = (tid & 7) * 16;
        LAS char* S = L + 65536 + d * 256 + v0 * 2;
        float acc[16], t[16];
#pragma unroll
        for (int e = 0; e < 16; ++e) acc[e] = 0.f;
        for (int m0 = n - 4 * ((n + 3) >> 2); m0 < n; m0 += 4) {
            float t4[4][16];
#pragma unroll
            for (int u4 = 0; u4 < 4; ++u4) { const int m = m0 + u4; load16c_bf16(Ub + (size_t)((m < 0 ? 0 : m) * 2) * 8192, t4[u4]); }
#pragma unroll
            for (int u4 = 0; u4 < 4; ++u4) { const float msk = (m0 + u4) < 0 ? 0.f : 1.f;
#pragma unroll
                for (int e = 0; e < 16; ++e) acc[e] = acc[e] * wf + t4[u4][e] * msk; } }
        st16_lds_bf16(S, acc);
        load16c_bf16(Ub + (size_t)(n * 2) * 8192, t);
#pragma unroll
        for (int e = 0; e < 16; ++e) acc[e] = acc[e] * wf + t[e];
        st16_lds_bf16(S + 2 * 16384, acc);
#pragma unroll
        for (int e = 0; e < 16; ++e) acc[e] = 0.f;
        { const int cnt = 14 - n;
          for (int m0 = 15 + 4 * ((cnt + 3) >> 2) - cnt; m0 > 15 - cnt; m0 -= 4) {
            float t4[4][16];
#pragma unroll
            for (int u4 = 0; u4 < 4; ++u4) { const int m = m0 - u4; load16c_bf16(Ub + (size_t)((m > 15 ? 15 : m) * 2 + 1) * 8192, t4[u4]); }
#pragma unroll
            for (int u4 = 0; u4 < 4; ++u4) { const float msk = (m0 - u4) > 15 ? 0.f : 1.f;
#pragma unroll
                for (int e = 0; e < 16; ++e) acc[e] = acc[e] * wb + t4[u4][e] * msk; } } }
        st16_lds_bf16(S + 3 * 16384, acc);
        load16c_bf16(Ub + (size_t)((n + 1) * 2 + 1) * 8192, t);
#pragma unroll
        for (int e = 0; e < 16; ++e) acc[e] = acc[e] * wb + t[e];
        st16_lds_bf16(S + 1 * 16384, acc);
    }
    __syncthreads();
    const int cw = wave >> 2, i = 32 * (wave & 3) + rr;
    const int crow = rowb + 128 * cw;
    bf16x8 qf[4];
    { const bf16_t* p = proj + pofs(crow + i, RET_OFF + h * 64 + 32 * hh);
#pragma unroll
        for (int ks = 0; ks < 4; ++ks) qf[ks] = *(const bf16x8*)(p + 8 * ks); }
    f32x16 y[4];
#pragma unroll
    for (int a = 0; a < 4; ++a)
#pragma unroll
        for (int e = 0; e < 16; ++e) y[a][e] = 0.f;
    LAS char* VI = L + cw * 32768;
#pragma unroll
    for (int kt = 0; kt < 4; ++kt) {
        const int j0 = 32 * kt;
        bf16x8 kf[4];
        { const bf16_t* p = proj + pofs(crow + j0 + rr, RET_OFF + 256 + h * 64 + 32 * hh);
#pragma unroll
            for (int ks = 0; ks < 4; ++ks) kf[ks] = *(const bf16x8*)(p + 8 * ks); }
        f32x16 s;
#pragma unroll
        for (int e = 0; e < 16; ++e) s[e] = 0.f;
#pragma unroll
        for (int ks = 0; ks < 4; ++ks) s = MFMA32(kf[ks], qf[ks], s);
#pragma unroll
        for (int e = 0; e < 16; ++e) { const int j = j0 + (e & 3) + 8 * (e >> 2) + 4 * hh; const int dd = i - j;
            const float w = dd >= 0 ? exp2f(Lf * (float)dd) : exp2f(Lb * (float)(-dd)); s[e] *= w; }
        bf16x8 pf[2];
#pragma unroll
        for (int s2 = 0; s2 < 2; ++s2) pf[s2] = pack8(s[8 * s2], s[8 * s2 + 1], s[8 * s2 + 2], s[8 * s2 + 3], s[8 * s2 + 4], s[8 * s2 + 5], s[8 * s2 + 6], s[8 * s2 + 7]);
#pragma unroll
        for (int vt = 0; vt < 4; ++vt)
#pragma unroll
            for (int s2 = 0; s2 < 2; ++s2) {
                LAS char* a = VI + (j0 + 16 * s2 + 4 * hh + q4) * 256 + (32 * vt + 16 * blk + 4 * p4) * 2;
                const bf16x8 vf = cat4(tr_read(a), tr_read(a + 8 * 256));
                y[vt] = MFMA32(vf, pf[s2], y[vt]);
            }
    }
#pragma unroll
    for (int dir = 0; dir < 2; ++dir) {
        const float sc = dir == 0 ? exp2f(Lf * (float)(i + 1)) : exp2f(Lb * (float)(128 - i));
        LAS char* SI = L + 65536 + (cw * 2 + dir) * 16384;
#pragma unroll
        for (int ks = 0; ks < 4; ++ks) {
            const bf16x8 qs = scale_frag(qf[ks], sc);
#pragma unroll
            for (int vt = 0; vt < 4; ++vt) {
                LAS char* a = SI + (32 * hh + 8 * ks + q4) * 256 + (32 * vt + 16 * blk + 4 * p4) * 2;
                const bf16x8 af = cat4(tr_read(a), tr_read(a + 4 * 256));
                y[vt] = MFMA32(af, qs, y[vt]);
            }
        }
    }
    float sm = 0.f;
#pragma unroll
    for (int vt = 0; vt < 4; ++vt)
#pragma unroll
        for (int e = 0; e < 16; ++e) sm += y[vt][e];
    sm += __shfl_xor(sm, 32);
    const float mu = sm * (1.f / 128.f);
    float sq = 0.f;
#pragma unroll
    for (int vt = 0; vt < 4; ++vt)
#pragma unroll
        for (int e = 0; e < 16; ++e) { const float dlt = y[vt][e] - mu; sq += dlt * dlt; }
    sq += __shfl_xor(sq, 32);
    const float rs = rsqrtf(sq * (1.f / 128.f) + NORM_EPS);
    const bf16_t* gp = proj + pofs(crow + i, RET_OFF + 1024 + h * 128);
    bf16_t* op = yret + ((size_t)b * SEQ + 128 * (n + cw) + i) * 512 + h * 128;
    const float* gg = gn_g + h * 128;
#pragma unroll
    for (int vt = 0; vt < 4; ++vt)
#pragma unroll
        for (int gq = 0; gq < 4; ++gq) { const int vi = 32 * vt + 8 * gq + 4 * hh;
            const u32x2 gw = *(const u32x2*)(gp + vi); const f32x4 g4 = *(const f32x4*)(gg + vi);
            u32x2 w; w.x = pk2((y[vt][4 * gq] - mu) * rs * g4.x * bflo(gw.x), (y[vt][4 * gq + 1] - mu) * rs * g4.y * bfhi(gw.x));
            w.y = pk2((y[vt][4 * gq + 2] - mu) * rs * g4.z * bflo(gw.y), (y[vt][4 * gq + 3] - mu) * rs * g4.w * bfhi(gw.y));
            *(u32x2*)(op + vi) = w; }
    __syncthreads();
}

__device__ __forceinline__ bf16x8 scale8(u32x4 w, float rs, const float* g) {
    const f32x4 g0 = *(const f32x4*)g, g1 = *(const f32x4*)(g + 4);
    return pack8(bflo(w.x) * rs * g0.x, bfhi(w.x) * rs * g0.y, bflo(w.y) * rs * g0.z, bfhi(w.y) * rs * g0.w, bflo(w.z) * rs * g1.x, bfhi(w.z) * rs * g1.y, bflo(w.w) * rs * g1.z, bfhi(w.w) * rs * g1.w);
}
__device__ __forceinline__ float ssq8(u32x4 w) {
    const float a = bflo(w.x), b = bfhi(w.x), c = bflo(w.y), d = bfhi(w.y), e = bflo(w.z), f = bfhi(w.z), g = bflo(w.w), h = bfhi(w.w);
    return ((a * a + b * b) + (c * c + d * d)) + ((e * e + f * f) + (g * g + h * h));
}
constexpr int MEM_PITCH = 272;
__device__ __forceinline__ void mem_item(const bf16_t* proj, const bf16_t* memkv  , bf16_t* ymem, const float* gqn, const float* gkn, const float* cconst, int item, LAS char* L, int tid) {
    asm volatile("" : "+v"(tid));
    const float cshift = cconst[3];
    const int qr = item & 3, hd = (item >> 2) & 3, b = item >> 4;
    const int lane = tid & 63, wave = tid >> 6, rr = lane & 31, hh = lane >> 5, blk = (lane >> 4) & 1, q4 = (lane & 15) >> 2, p4 = lane & 3;
    const bf16_t* kvb = memkv + (size_t)b * N_MEM * 1024 + hd * 128;
    LAS char* KI = L; LAS char* VI = L + 256 * MEM_PITCH;
#pragma unroll
    for (int q = 0; q < 8; ++q) {
        const int idx = tid + 512 * q, row = idx >> 4, pc = idx & 15;
        const u32x4 kw = *(const u32x4*)(kvb + (size_t)row * 1024 + 8 * pc), vw = *(const u32x4*)(kvb + (size_t)row * 1024 + 512 + 8 * pc);
        float ss = ssq8(kw);
        ss += __shfl_xor(ss, 1); ss += __shfl_xor(ss, 2); ss += __shfl_xor(ss, 4); ss += __shfl_xor(ss, 8);
        const float rs = rsqrtf(ss * (1.f / 128.f) + NORM_EPS);
        *(LAS bf16x8*)(KI + row * MEM_PITCH + 16 * pc) = scale8(kw, rs, gkn + 8 * pc);
        *(LAS u32x4*)(VI + row * MEM_PITCH + 16 * pc) = vw;
    }
    __syncthreads();
#pragma unroll 1
    for (int tq = 0; tq < 2; ++tq) {
        const int i = 512 * qr + 32 * (wave * 2 + tq) + rr;
        bf16x8 qf[8];
        { const bf16_t* p = proj + pofs(b * SEQ + i, MEMQ_OFF + hd * 128 + 64 * hh);
            u32x4 raw[8]; float ss = 0.f;
#pragma unroll
            for (int ks = 0; ks < 8; ++ks) { raw[ks] = *(const u32x4*)(p + 8 * ks); ss += ssq8(raw[ks]); }
            ss += __shfl_xor(ss, 32);
            const float rs = rsqrtf(ss * (1.f / 128.f) + NORM_EPS) * (0.08838834764831845f * LOG2E);
#pragma unroll
            for (int ks = 0; ks < 8; ++ks) qf[ks] = scale8(raw[ks], rs, gqn + 64 * hh + 8 * ks); }
        f32x16 o[4];
#pragma unroll
        for (int a = 0; a < 4; ++a)
#pragma unroll
            for (int e = 0; e < 16; ++e) o[a][e] = 0.f;
        float lrun = 0.f;
#pragma unroll 2
        for (int kt = 0; kt < 8; ++kt) {
            const int j0 = 32 * kt;
            f32x16 s;
#pragma unroll
            for (int e = 0; e < 16; ++e) s[e] = -cshift;
#pragma unroll
            for (int ks = 0; ks < 8; ++ks) { const bf16x8 kf = *(const LAS bf16x8*)(KI + (j0 + rr) * MEM_PITCH + (64 * hh + 8 * ks) * 2); s = MFMA32(kf, qf[ks], s); }
#pragma unroll
            for (int e = 0; e < 16; ++e) { const float p = __builtin_amdgcn_exp2f(s[e]); s[e] = p; lrun += p; }
            bf16x8 pf[2];
#pragma unroll
            for (int s2 = 0; s2 < 2; ++s2) pf[s2] = pack8(s[8 * s2], s[8 * s2 + 1], s[8 * s2 + 2], s[8 * s2 + 3], s[8 * s2 + 4], s[8 * s2 + 5], s[8 * s2 + 6], s[8 * s2 + 7]);
#pragma unroll
            for (int vt = 0; vt < 4; ++vt)
#pragma unroll
                for (int s2 = 0; s2 < 2; ++s2) {
                    LAS char* a = VI + (j0 + 16 * s2 + 4 * hh + q4) * MEM_PITCH + (32 * vt + 16 * blk + 4 * p4) * 2;
                    const bf16x8 vf = cat4(tr_read(a), tr_read(a + 8 * MEM_PITCH));
                    o[vt] = MFMA32(vf, pf[s2], o[vt]);
                }
        }
        const float inv = __builtin_amdgcn_rcpf(lrun + __shfl_xor(lrun, 32));
        bf16_t* op = ymem + ((size_t)b * SEQ + i) * 512 + hd * 128;
#pragma unroll
        for (int vt = 0; vt < 4; ++vt)
#pragma unroll
            for (int gq = 0; gq < 4; ++gq) { u32x2 w; w.x = pk2(o[vt][4 * gq] * inv, o[vt][4 * gq + 1] * inv); w.y = pk2(o[vt][4 * gq + 2] * inv, o[vt][4 * gq + 3] * inv);
                *(u32x2*)(op + 32 * vt + 8 * gq + 4 * hh) = w; }
    }
    __syncthreads();
}

#define XB_TMO      128
#define XB_XCNT(j)  (256  + 64 * (j))
#define XB_XSUB(j)  (1280 + 64 * (j))
#define XB_XGEN(j)  (2304 + 64 * (j))
#define XB_TOP      3328
#define XB_TOPGEN   3392
#define XCD_BAR_WORDS 3456
#define XB_SPIN_CAP (1u << 22)
__device__ __forceinline__ unsigned xb_ld(unsigned* p)              { return __hip_atomic_load(p, __ATOMIC_RELAXED, __HIP_MEMORY_SCOPE_AGENT); }
__device__ __forceinline__ unsigned xb_add(unsigned* p, unsigned v) { return __hip_atomic_fetch_add(p, v, __ATOMIC_RELAXED, __HIP_MEMORY_SCOPE_AGENT); }
__device__ __forceinline__ unsigned xb_xcc_id() { return (unsigned)__builtin_amdgcn_s_getreg((3 << 11) | 20) & 0xFu; }
#define XB_SPIN(cond, bar) do { unsigned _sp = 0; while (cond) { __builtin_amdgcn_s_sleep(1); \
    if ((++_sp & 255u) == 0u) { if (xb_ld(&(bar)[XB_TMO])) break; if (_sp > XB_SPIN_CAP) { atomicAdd(&(bar)[XB_TMO], 1u); break; } } } } while (0)
struct XcdBarrier { unsigned* bar; unsigned x; volatile LAS unsigned* st; };
__device__ __forceinline__ XcdBarrier xcd_barrier_post(unsigned* bar, volatile LAS unsigned* st) {
    XcdBarrier b; b.bar = bar; b.x = xb_xcc_id(); b.st = st;
    if (threadIdx.x == 0) (void)xb_add(&bar[XB_XCNT(b.x)], 1u);
    return b;
}
__device__ __forceinline__ void xcd_barrier_complete(unsigned* bar, unsigned x, unsigned& nloc, unsigned& nx) {
    const unsigned G = gridDim.x * gridDim.y * gridDim.z;
    unsigned sum, cnt, mine, sp = 0u;
    for (;;) {
        sum = 0u; cnt = 0u; mine = 0u;
#pragma unroll
        for (unsigned j = 0; j < 16; ++j) { const unsigned c = xb_ld(&bar[XB_XCNT(j)]); sum += c; cnt += (c > 0u) ? 1u : 0u; mine = (j == x) ? c : mine; }
        if (sum == G) break;
        __builtin_amdgcn_s_sleep(1);
        if ((++sp & 255u) == 0u) { if (xb_ld(&bar[XB_TMO])) break; if (sp > XB_SPIN_CAP) { atomicAdd(&bar[XB_TMO], 1u); break; } }
    }
    nloc = mine > 0u ? mine : 1u; nx = cnt > 0u ? cnt : 1u;
}
__device__ __forceinline__ void xcd_barrier(const XcdBarrier& b) {
    asm volatile("s_waitcnt vmcnt(0)" ::: "memory");
    __syncthreads();
    if (threadIdx.x == 0) {
        unsigned* bar = b.bar;
        __builtin_amdgcn_s_waitcnt(0);
        unsigned nloc = b.st[0], nx = b.st[1];
        if (nloc == 0u) { xcd_barrier_complete(bar, b.x, nloc, nx); b.st[0] = nloc; b.st[1] = nx; }
        const unsigned old = xb_add(&bar[XB_XSUB(b.x)], 1u);
        const unsigned gen = old / nloc;
        if (old + 1u == (gen + 1u) * nloc) {
            __builtin_amdgcn_fence(__ATOMIC_RELEASE, "agent");
            asm volatile("s_waitcnt vmcnt(0)" ::: "memory");
            const unsigned og = xb_add(&bar[XB_TOP], 1u);
            const unsigned tg = og / nx;
            if (og + 1u == (tg + 1u) * nx) xb_add(&bar[XB_TOPGEN], 1u);
            else XB_SPIN(xb_ld(&bar[XB_TOPGEN]) == tg, bar);
            __builtin_amdgcn_fence(__ATOMIC_ACQUIRE, "agent");
            xb_add(&bar[XB_XGEN(b.x)], 1u);
            asm volatile("s_waitcnt vmcnt(0)" ::: "memory");
        } else {
            XB_SPIN(xb_ld(&bar[XB_XGEN(b.x)]) == gen, bar);
            __builtin_amdgcn_fence(__ATOMIC_ACQUIRE, "agent");
            asm volatile("s_waitcnt vmcnt(0)" ::: "memory");
        }
    }
    __syncthreads();
}

struct Args { const float* in[21]; float* out; unsigned char* ws; int ph_lo, ph_hi; };

__global__ void __launch_bounds__(512, 2) mk_fwd(Args args) {
    extern __shared__ __attribute__((aligned(16))) unsigned char lds_raw[];
    LAS unsigned char* lds = (LAS unsigned char*)lds_raw;
    cg::grid_group grid = cg::this_grid();
    const int tid = threadIdx.x, lane = tid & 63, wave = __builtin_amdgcn_readfirstlane(tid >> 6);
    const int G = gridDim.x, bx = blockIdx.x;
    const int gw = bx * 8 + wave, NGW = G * 8;
    const int NGT = G * 512;
    unsigned char* ws = args.ws;
    const int lo = args.ph_lo, hi = args.ph_hi;
    volatile LAS unsigned* xst = (volatile LAS unsigned*)(lds + LDS_BYTES - 64);
    if (tid < 2) xst[tid] = 0u;
    __syncthreads();
    XcdBarrier xbar; xbar.bar = (unsigned*)(ws + WS_CTL); xbar.x = 0; xbar.st = xst;
    if (!MK_MULTI_LAUNCH) xbar = xcd_barrier_post((unsigned*)(ws + WS_CTL), xst);
#ifndef PH_EN
#define PH_EN 0x3ff
#endif
#ifndef PROBE_REP
#define PROBE_REP 0
#endif
#define REP(b) for (int rep_ = 0; rep_ < 1 + (((PROBE_REP) >> (b)) & 1); ++rep_)
#define IN(k) (lo <= (k) && (k) < hi)
#define EN(b) (((PH_EN) >> (b)) & 1)
#define SEAM(k) do { if (IN(k) && IN((k) + 1)) { if ((k) == 0 || MK_MULTI_LAUNCH) grid.sync(); else xcd_barrier(xbar); } } while (0)

#define WinT ((bf16_t*)(ws_ + WS_WIN))
#define WkvT ((bf16_t*)(ws_ + WS_WKV))
#define WbrT ((bf16_t*)(ws_ + WS_WBR))
#define WoutT ((bf16_t*)(ws_ + WS_WOUT))
#define WfiT ((bf16_t*)(ws_ + WS_WFI))
#define WfoT ((bf16_t*)(ws_ + WS_WFO))
#define MEMKV ((bf16_t*)(ws_ + WS_MEMKV))
#define XB ((bf16_t*)(ws_ + WS_XB))
#define MEMB ((bf16_t*)(ws_ + WS_MEMB))
#define ODIL ((bf16_t*)(ws_ + WS_ODIL))
#define LSE ((float*)(ws_ + WS_LSE))
#define MERGED ((bf16_t*)(ws_ + WS_MERGED))
#define A2 ((bf16_t*)(ws_ + WS_A2))
#define Y3 ((bf16_t*)(ws_ + WS_Y3))
#define SSQ ((float*)(ws_ + WS_SSQ))
#define PROJ ((bf16_t*)(ws_ + WS_PROJ))
#define YF ((bf16_t*)(ws_ + WS_YF))
#define HALO ((bf16_t*)(ws_ + WS_HALO))
#define CCONST ((float*)(ws_ + WS_CTL + 15360))
#define PHASE_LOCALS const Args* ap = &args; size_t zoff_ = 0; asm volatile("" : "+s"(zoff_)); unsigned char* ws_ = ws + zoff_;     int bxl = bx; asm volatile("" : "+s"(bxl)); int tidl = threadIdx.x; asm volatile("" : "+v"(tidl)); const int gtidl = bxl * 512 + tidl; (void)bxl; (void)ws_; (void)ap; (void)gtidl;
    if (EN(0) && IN(0)) REP(0) {
            PHASE_LOCALS
        LAS float* scr = (LAS float*)(lds + wave * 16384);
        constexpr int I_IN = 16 * 304, I_KV = 16 * 32, I_BR = 8 * 32, I_OUT = 16 * 32, I_FI = 16 * 176, I_FO = 44 * 32;
        constexpr int NITEMS = I_IN + I_KV + 3 * I_BR + I_OUT + I_FI + I_FO;
        for (int it = gw; it < NITEMS; it += NGW) {
            int r = it;
            if (r < I_IN) { p0_transpose_item<0>(ap->in[3], 1024, IN_COLS, WinT, 0, scr, r, lane); continue; } r -= I_IN;
            if (r < I_KV) { p0_transpose_item<0>(ap->in[9], 1024, 1024, WkvT, 0, scr, r, lane); continue; } r -= I_KV;
            if (r < I_BR) { p0_transpose_item<0>(ap->in[12], 512, 1024, WbrT, 0, scr, r, lane); continue; } r -= I_BR;
            if (r < I_BR) { p0_transpose_item<0>(ap->in[13], 512, 1024, WbrT, 1024, scr, r, lane); continue; } r -= I_BR;
            if (r < I_BR) { p0_transpose_item<0>(ap->in[14], 512, 1024, WbrT, 2048, scr, r, lane); continue; } r -= I_BR;
            if (r < I_OUT) { p0_transpose_item<0>(ap->in[15], 1024, 1024, WoutT, 0, scr, r, lane); continue; } r -= I_OUT;
            if (r < I_FI) { p0_transpose_item<1>(ap->in[17], 1024, FF2, WfiT, 0, scr, r, lane); continue; } r -= I_FI;
            p0_transpose_item<0>(ap->in[20], D_FF, 1024, WfoT, 0, scr, r, lane);
        }
        if (gw == 0) {
            float cv = 0.f;
            for (int g = 0; g < 3; ++g) { float a = fabsf(args.in[4][g * 64 + lane]), b = fabsf(args.in[5][g * 64 + lane]);
#pragma unroll
                for (int o = 1; o < 64; o <<= 1) { a = fmaxf(a, __shfl_xor(a, o)); b = fmaxf(b, __shfl_xor(b, o)); }
                if (lane == g) cv = 8.f * a * b * LOG2E; }
            { float a = fmaxf(fabsf(args.in[10][lane]), fabsf(args.in[10][64 + lane])), b = fmaxf(fabsf(args.in[11][lane]), fabsf(args.in[11][64 + lane]));
#pragma unroll
                for (int o = 1; o < 64; o <<= 1) { a = fmaxf(a, __shfl_xor(a, o)); b = fmaxf(b, __shfl_xor(b, o)); }
                if (lane == 3) cv = 11.313708499f * a * b * LOG2E; }
            if (lane < 4) CCONST[lane] = cv;
        }
        for (int m = gw; m < BATCH * SEQ; m += 2 * NGW) rms_row2_to_bf16(ap->in[0] + (size_t)m * 1024, ap->in[0] + (size_t)(m + NGW) * 1024, ap->in[2], XB + (size_t)m * 1024, XB + (size_t)(m + NGW) * 1024, lane);
        for (int m = gw; m < BATCH * N_MEM; m += NGW) rms_row_to_bf16(ap->in[1] + (size_t)m * 1024, ap->in[8], MEMB + (size_t)m * 1024, lane);
        __syncthreads();
    }
    SEAM(0);
    if (EN(1) && IN(1)) REP(1) {
            PHASE_LOCALS
        pg8::Gemm g{MEMB, WkvT, BATCH * N_MEM, 1024, 1024}; pg8::StaticOrder S; S.init(g.M, g.N, G, bxl);
        EpiPlainBf16 E{MEMKV, 1024};
        pg8::gemm_phase(lds, g, S, E);
    }
    SEAM(1);
    for (int hf = 0; hf < 2; ++hf) {
        const int P = 2 + 4 * hf;
        if (EN(2) && IN(P + 0)) REP(2) {
            PHASE_LOCALS
            pg8::Gemm g{XB + (size_t)hf * HTOK * 1024, WinT, HTOK, IN_COLS, 1024}; pg8::StaticOrder S; S.init(g.M, g.N, G, bxl);
            EpiProj E{PROJ, ap->in[4], ap->in[5]};
            pg8::gemm_phase(lds, g, S, E);
        }
        SEAM(P + 0);
        if (EN(3) && IN(P + 1)) REP(3) {
            PHASE_LOCALS
            LAS char* vl = (LAS char*)(lds + wave * 8192);
#ifndef ATT_EN
#define ATT_EN 7
#endif
            if (ATT_EN & 1) for (int it = bxl; it < HB * 4 * 16; it += G) ret_u_item(PROJ, XB + (size_t)hf * HTOK * 1024, ap->in[6], it, (LAS char*)lds, tid);
            if (ATT_EN & 2) REP(10) for (int it = gw; it < HB * 8 * 3 * 32; it += NGW) dil_wave(PROJ, ODIL, LSE, CCONST, it, vl, lane);
            __syncthreads();
            if (ATT_EN & 4) REP(11) for (int it = bxl; it < HB * 4 * 4; it += G) mem_item(PROJ, MEMKV + (size_t)hf * HB * N_MEM * 1024, Y3 + (size_t)2 * HTOK * 512, args.in[10], args.in[11], CCONST, it, (LAS char*)lds, tid);
            __syncthreads();
        }
        SEAM(P + 1);
        if (EN(4) && IN(P + 2)) REP(4) {
            PHASE_LOCALS
            for (int it = bxl; it < HB * 4 * 8; it += G) ret_chunk_item(PROJ, XB + (size_t)hf * HTOK * 1024, Y3 + (size_t)1 * HTOK * 512, ap->in[6], ap->in[7], it, (LAS char*)lds, tid);
            for (int idx = gtidl; idx < HTOK * 64; idx += NGT) {
                const int dp = idx & 7, h = (idx >> 3) & 7, tok = idx >> 6;
                const float l0 = LSE[((size_t)0 * HTOK + tok) * 8 + h], l1 = LSE[((size_t)1 * HTOK + tok) * 8 + h], l2 = LSE[((size_t)2 * HTOK + tok) * 8 + h];
                const float mx = fmaxf(l0, fmaxf(l1, l2));
                float w0 = exp2f(l0 - mx), w1 = exp2f(l1 - mx), w2 = exp2f(l2 - mx); const float inv = 1.f / (w0 + w1 + w2); w0 *= inv; w1 *= inv; w2 *= inv;
                const size_t off = (size_t)tok * 512 + h * 64 + dp * 8;
                const u32x4 a = *(const u32x4*)(ODIL + off), b = *(const u32x4*)(ODIL + (size_t)HTOK * 512 + off), c = *(const u32x4*)(ODIL + (size_t)2 * HTOK * 512 + off);
                u32x4 o;
                o.x = pk2(w0 * bflo(a.x) + w1 * bflo(b.x) + w2 * bflo(c.x), w0 * bfhi(a.x) + w1 * bfhi(b.x) + w2 * bfhi(c.x));
                o.y = pk2(w0 * bflo(a.y) + w1 * bflo(b.y) + w2 * bflo(c.y), w0 * bfhi(a.y) + w1 * bfhi(b.y) + w2 * bfhi(c.y));
                o.z = pk2(w0 * bflo(a.z) + w1 * bflo(b.z) + w2 * bflo(c.z), w0 * bfhi(a.z) + w1 * bfhi(b.z) + w2 * bfhi(c.z));
                o.w = pk2(w0 * bflo(a.w) + w1 * bflo(b.w) + w2 * bflo(c.w), w0 * bfhi(a.w) + w1 * bfhi(b.w) + w2 * bfhi(c.w));
                *(u32x4*)(Y3 + off) = o;
            }
        }
        SEAM(P + 2);
        if (EN(5) && IN(P + 3)) REP(5) {
            PHASE_LOCALS
            pg8::Gemm g{Y3, WbrT, 3 * HTOK, 3 * 1024, 512}; pg8::BranchOrder S; S.init(HTOK, 1024, G, bxl);
            EpiBranch E{MERGED + (size_t)hf * HTOK * 1024, PROJ};
            pg8::gemm_phase(lds, g, S, E);
        }
        SEAM(P + 3);
    }
    {
        constexpr int P = 6, NTOK = BATCH * SEQ;
        if (EN(6) && IN(P + 4)) REP(6) {
            PHASE_LOCALS
            pg8::Gemm g{MERGED, WoutT, NTOK, 1024, 1024}; pg8::StaticOrder S; S.init(g.M, g.N, G, bxl);
            EpiOut E{ap->in[0], ap->out, A2, ap->in[16], SSQ};
            pg8::gemm_phase(lds, g, S, E);
        }
        SEAM(P + 4);
        if (EN(7) && IN(P + 5)) REP(7) {
            PHASE_LOCALS
            pg8::Gemm g{A2, WfiT, NTOK, FF2, 1024}; pg8::StaticOrder S; S.init(g.M, g.N, G, bxl);
            EpiFfnInConv E{YF, HALO, SSQ, ap->in[18], ap->in[19]};
            pg8::gemm_phase(lds, g, S, E);
        }
        SEAM(P + 5);
        if (EN(8) && IN(P + 6)) REP(8) {
            PHASE_LOCALS
            const float* cw = ap->in[18]; const float* cb = ap->in[19];
            for (int idx = gtidl; idx < (NTOK / 64) * 2 * 352; idx += NGT) {
                const int cgp = idx % 352, rest = idx / 352, side = rest & 1, blk = rest >> 1, ch = cgp * 8;
                const int row = blk * 64 + (side ? 63 : 0), t = row & (SEQ - 1);
                const bf16_t* hb = HALO + (size_t)blk * 6 * D_FF + ch;
                u32x4 um = {0u, 0u, 0u, 0u}, un = {0u, 0u, 0u, 0u}, uc, gt;
                if (side == 0) { uc = *(const u32x4*)hb; un = *(const u32x4*)(hb + D_FF); gt = *(const u32x4*)(hb + 4 * D_FF); if (t > 0) um = *(const u32x4*)(hb - 6 * D_FF + 3 * D_FF); }
                else { um = *(const u32x4*)(hb + 2 * D_FF); uc = *(const u32x4*)(hb + 3 * D_FF); gt = *(const u32x4*)(hb + 5 * D_FF); if (t < SEQ - 1) un = *(const u32x4*)(hb + 6 * D_FF); }
                float uu[3][8], gg[8];
                const unsigned umw[4] = {um.x, um.y, um.z, um.w}, ucw[4] = {uc.x, uc.y, uc.z, uc.w}, unw[4] = {un.x, un.y, un.z, un.w}, gtw[4] = {gt.x, gt.y, gt.z, gt.w};
#pragma unroll
                for (int q = 0; q < 4; ++q) { uu[0][2 * q] = bflo(umw[q]); uu[0][2 * q + 1] = bfhi(umw[q]); uu[1][2 * q] = bflo(ucw[q]); uu[1][2 * q + 1] = bfhi(ucw[q]);
                    uu[2][2 * q] = bflo(unw[q]); uu[2][2 * q + 1] = bfhi(unw[q]); gg[2 * q] = bflo(gtw[q]); gg[2 * q + 1] = bfhi(gtw[q]); }
                float yv[8];
#pragma unroll
                for (int q2 = 0; q2 < 2; ++q2) {
                    const f32x4 w0 = *(const f32x4*)(cw + ch + 4 * q2), w1 = *(const f32x4*)(cw + D_FF + ch + 4 * q2), w2 = *(const f32x4*)(cw + 2 * D_FF + ch + 4 * q2), bb = *(const f32x4*)(cb + ch + 4 * q2);
#pragma unroll
                    for (int e = 0; e < 4; ++e) { const int k = 4 * q2 + e; const float c = bb[e] + uu[0][k] * w0[e] + uu[1][k] * w1[e] + uu[2][k] * w2[e];
                        yv[k] = gelu_exact(c) * gg[k]; }
                }
                u32x4 o; o.x = pk2(yv[0], yv[1]); o.y = pk2(yv[2], yv[3]); o.z = pk2(yv[4], yv[5]); o.w = pk2(yv[6], yv[7]);
                *(u32x4*)(YF + (size_t)row * D_FF + ch) = o;
            }
        }
        SEAM(P + 6);
        if (EN(9) && IN(P + 7)) REP(9) {
            PHASE_LOCALS
            pg8::Gemm g{YF, WfoT, NTOK, 1024, D_FF}; pg8::StaticOrder S; S.init(g.M, g.N, G, bxl);
            EpiFfnOut E{ap->out};
            pg8::gemm_phase(lds, g, S, E);
        }
    }
#undef IN
#undef SEAM
}

extern "C" void kernel_launch(void* const* d_in, const int* in_sizes, int n_in, void* d_out, int out_size, void* d_ws, size_t ws_size, hipStream_t stream) {
    static int grid = 0;
    if (grid == 0) {
        if (n_in != 21 || out_size != BATCH * SEQ * D_MODEL || ws_size < WS_END) { fprintf(stderr, "kernel_launch: unexpected shapes (n_in %d out %d ws %zu)\n", n_in, out_size, ws_size); grid = -1; return; }
        int dev = 0, cus = 0, per_cu = 0;
        hipGetDevice(&dev); hipDeviceGetAttribute(&cus, hipDeviceAttributeMultiprocessorCount, dev);
        if (hipFuncSetAttribute((const void*)mk_fwd, hipFuncAttributeMaxDynamicSharedMemorySize, LDS_BYTES) != hipSuccess) { fprintf(stderr, "kernel_launch: hipFuncSetAttribute failed\n"); grid = -1; return; }
        if (hipOccupancyMaxActiveBlocksPerMultiprocessor(&per_cu, (const void*)mk_fwd, 512, LDS_BYTES) != hipSuccess || per_cu < 1) { fprintf(stderr, "kernel_launch: occupancy query says %d\n", per_cu); per_cu = 1; }
        (void)hipGetLastError();
        grid = cus * per_cu;
    }
    if (grid < 0) return;
    Args a{};
    for (int i = 0; i < 21; ++i) a.in[i] = (const float*)d_in[i];
    a.out = (float*)d_out; a.ws = (unsigned char*)d_ws;
#if MK_MULTI_LAUNCH
    for (int ph = 0; ph < NPHASE; ++ph) {
        a.ph_lo = ph; a.ph_hi = ph + 1;
        hipLaunchKernelGGL(mk_fwd, dim3(grid), dim3(512), LDS_BYTES, stream, a);
    }
#else
    a.ph_lo = 0; a.ph_hi = NPHASE;
    if (hipMemsetAsync((char*)d_ws + WS_CTL, 0, CTL_BYTES, stream) != hipSuccess) { fprintf(stderr, "kernel_launch: memset of the barrier words failed\n"); return; }
    void* kargs[] = {&a};
    hipError_t e = hipLaunchCooperativeKernel((const void*)mk_fwd, dim3(grid), dim3(512), kargs, LDS_BYTES, stream);
    if (e != hipSuccess) fprintf(stderr, "kernel_launch: cooperative launch failed: %s (grid %d)\n", hipGetErrorString(e), grid);
#endif
}
```

```cpp
#include <hip/hip_runtime.h>
#include <hip/hip_cooperative_groups.h>
#include <cstdio>
namespace cg = cooperative_groups;

#ifndef MK_MULTI_LAUNCH
#define MK_MULTI_LAUNCH 0
#endif

#define LAS __attribute__((address_space(3)))
typedef unsigned short bf16_t;
typedef short bf16x8 __attribute__((ext_vector_type(8)));
typedef short s16x4 __attribute__((ext_vector_type(4)));
typedef float f32x2 __attribute__((ext_vector_type(2)));
typedef float f32x4 __attribute__((ext_vector_type(4)));
typedef float f32x16 __attribute__((ext_vector_type(16)));
typedef unsigned u32x2 __attribute__((ext_vector_type(2)));
typedef unsigned u32x4 __attribute__((ext_vector_type(4)));
typedef __bf16 bf16x2_t __attribute__((ext_vector_type(2)));

constexpr int D_MODEL = 1024, BATCH = 32, SEQ = 2048, N_MEM = 256;
constexpr int HB = 16, HTOK = HB * SEQ;
constexpr int IN_COLS = 9728, RET_OFF = 4608, MEMQ_OFF = 6144, GATE_OFF = 6656;
constexpr int D_FF = 2816, FF2 = 5632;
constexpr float NORM_EPS = 1e-6f;
constexpr float LOG2E = 1.4426950408889634f;
constexpr int NPHASE = 14;

constexpr size_t MiB = 1u << 20;
constexpr size_t WS_WIN = 0;
constexpr size_t WS_WKV = 19 * MiB;
constexpr size_t WS_WBR = 21 * MiB;
constexpr size_t WS_WOUT = 24 * MiB;
constexpr size_t WS_WFI = 26 * MiB;
constexpr size_t WS_WFO = 37 * MiB;
constexpr size_t WS_MEMKV = 43 * MiB;
constexpr size_t WS_XB = 60 * MiB;
constexpr size_t WS_R1 = 188 * MiB;
constexpr size_t WS_MEMB = WS_R1;
constexpr size_t WS_ODIL = WS_R1;
constexpr size_t WS_LSE = WS_R1 + 96 * MiB;
constexpr size_t WS_MERGED = WS_XB;
constexpr size_t WS_A2 = 412 * MiB;
constexpr size_t WS_Y3 = 316 * MiB;
constexpr size_t WS_SSQ = WS_R1 + 100 * MiB;
constexpr size_t WS_HALO = WS_Y3 + 4 * MiB;
constexpr size_t WS_PROJ = 412 * MiB;
constexpr size_t WS_UG = WS_PROJ;
constexpr size_t WS_YF = WS_PROJ + 128 * MiB;
constexpr size_t WS_CTL = 1020 * MiB;
constexpr size_t CTL_BYTES = 16384;
constexpr size_t WS_END = WS_CTL + CTL_BYTES;

constexpr int LDS_BYTES = 147456;

__device__ __forceinline__ unsigned pk2(float a, float b) { f32x2 f = {a, b}; bf16x2_t r = __builtin_convertvector(f, bf16x2_t); return __builtin_bit_cast(unsigned, r); }
__device__ __forceinline__ float bflo(unsigned w) { return __uint_as_float(w << 16); }
__device__ __forceinline__ float bfhi(unsigned w) { return __uint_as_float(w & 0xffff0000u); }
__device__ __forceinline__ float wave_sum(float v) {
#pragma unroll
    for (int o = 1; o < 64; o <<= 1) v += __shfl_xor(v, o);
    return v;
}
__device__ __forceinline__ bf16x8 pack8(float a0, float a1, float a2, float a3, float a4, float a5, float a6, float a7) {
    u32x4 p; p.x = pk2(a0, a1); p.y = pk2(a2, a3); p.z = pk2(a4, a5); p.w = pk2(a6, a7); return __builtin_bit_cast(bf16x8, p);
}
#define MFMA32(a, b, c) __builtin_amdgcn_mfma_f32_32x32x16_bf16((a), (b), (c), 0, 0, 0)
__device__ __forceinline__ s16x4 tr_read(LAS char* p) { return __builtin_amdgcn_ds_read_tr16_b64_v4i16((LAS s16x4*)p); }
__device__ __forceinline__ bf16x8 cat4(s16x4 lo, s16x4 hi) { return __builtin_shufflevector(lo, hi, 0, 1, 2, 3, 4, 5, 6, 7); }
__device__ __forceinline__ int slot_of(int c) { return 128 * ((c >> 5) & 1) + 32 * (c >> 6) + 16 * ((c >> 2) & 1) + 4 * ((c >> 3) & 3) + (c & 3); }

namespace pg8 {
constexpr int BM = 256, BK = 64, HALF = 128, HTB = HALF * BK * 2, NXCD = 8, WGM = 8;
__device__ __forceinline__ int lds_byte(int r, int c) { const int st = (r >> 4) * 2 + (c >> 5), rr = r & 15, cc = c & 31, ob = rr * 64 + cc * 2; return st * 1024 + (ob ^ (((ob >> 9) & 1) << 5)); }
__device__ __forceinline__ void stage_rc(int b, int& R, int& C) { const int st = b / 1024, sb = b % 1024, swz = sb ^ (((sb >> 9) & 1) << 5); R = (st >> 1) * 16 + swz / 64; C = (st & 1) * 32 + (swz % 64) / 2; }
struct Unit { int pm, pn; };
struct Gemm { const bf16_t* A; const bf16_t* Bt; int M, N, K; };
struct StaticOrder {
    int nM, nN, nwg, G, c;
    __device__ void init(int M, int N, int G_, int c_) { nM = M / BM; nN = N / BM; nwg = nM * nN; G = G_; c = c_; }
    __device__ bool next(int i, Unit& u) const {
        const long L = (long)i * G + c; if (L >= nwg) return false;
        int wgid = (int)L; { const int q = nwg / NXCD, r = nwg % NXCD, xcd = wgid % NXCD, off = wgid / NXCD; wgid = (xcd < r ? xcd * (q + 1) : r * (q + 1) + (xcd - r) * q) + off; }
        const int nig = WGM * nN, gid = wgid / nig, fm = gid * WGM, gsz = (nM - fm) < WGM ? (nM - fm) : WGM;
        u.pm = fm + ((wgid % nig) % gsz); u.pn = (wgid % nig) / gsz; return true;
    }
};
struct BranchOrder {
    StaticOrder so;
    __device__ void init(int M, int N, int G_, int c_) { so.init(M, N, G_, c_); }
    __device__ bool next(int i, Unit& u) const { Unit t; if (!so.next(i / 3, t)) return false; const int b = i % 3; u.pm = b * (HTOK / BM) + t.pm; u.pn = b * (D_MODEL / BM) + t.pn; return true; }
};

template <class Epi, class Sched>
__device__ __forceinline__ void gemm_phase(LAS unsigned char* lds, const Gemm g, const Sched& S, const Epi& E) {
    int tid = threadIdx.x; asm volatile("" : "+v"(tid));
    const int wid = __builtin_amdgcn_readfirstlane(tid >> 6), lane = tid & 63, wr = wid >> 2, wc = wid & 3, fr = lane & 15, fq = lane >> 4;
    const int K = g.K, nt = K / BK;
    unsigned voffA[2];
#pragma unroll
    for (int i = 0; i < 2; ++i) { int R, C; stage_rc(tid * 16 + i * 8192, R, C); voffA[i] = (unsigned)(R * K + C) * 2u; }
    const size_t kstep = (size_t)(BK * 2);
    const size_t hstep = (size_t)HALF * K * 2;
    const size_t tstep = 2 * hstep;
    const unsigned ldsw = (unsigned)wid * 1024u;
    const int aoff = lds_byte(wr * 64 + fr, fq * 8), boff = lds_byte(wc * 32 + fr, fq * 8);
#define PG8_SA(b, h) (((b) * 2 + (h)) * HTB)
#define PG8_SB(b, h) ((4 + (b) * 2 + (h)) * HTB)
#define PG8_STAGE(bufoff, gbase) do { _Pragma("unroll") for (int _i = 0; _i < 2; ++_i) \
        __builtin_amdgcn_global_load_lds((const unsigned*)((const char*)(gbase) + voffA[_i]), (LAS unsigned*)(lds + (bufoff) + ldsw + _i * 8192), 16, 0, 0); } while (0)
#define PG8_LDA(dst, b, h) do { _Pragma("unroll") for (int m = 0; m < 4; ++m) _Pragma("unroll") for (int k = 0; k < 2; ++k) dst[m][k] = *(const LAS bf16x8*)(lds + PG8_SA(b, h) + aoff + m * 2048 + k * 1024); } while (0)
#define PG8_LDB(dst, b, h) do { _Pragma("unroll") for (int n = 0; n < 2; ++n) _Pragma("unroll") for (int k = 0; k < 2; ++k) dst[n][k] = *(const LAS bf16x8*)(lds + PG8_SB(b, h) + boff + n * 2048 + k * 1024); } while (0)
#define PG8_MMA(ai, bj, At, Bt) do { __builtin_amdgcn_s_setprio(1); _Pragma("unroll") for (int m = 0; m < 4; ++m) _Pragma("unroll") for (int n = 0; n < 2; ++n) _Pragma("unroll") for (int k = 0; k < 2; ++k) \
        acc[ai][bj][m][n] = __builtin_amdgcn_mfma_f32_16x16x32_bf16(Bt[n][k], At[m][k], acc[ai][bj][m][n], 0, 0, 0); __builtin_amdgcn_s_setprio(0); } while (0)
#define PG8_WAIT_V(n) asm volatile("s_waitcnt vmcnt(" #n ")" ::: "memory")
#define PG8_WAIT_L(n) asm volatile("s_waitcnt lgkmcnt(" #n ")" ::: "memory")
#define PG8_BAR __builtin_amdgcn_s_barrier()
#define PG8_SCHED __builtin_amdgcn_sched_barrier(0)
    Unit cur, nxt; int ui = 0;
    if (!S.next(0, cur)) return;
    f32x4 acc[2][2][4][2];
#pragma unroll
    for (int a = 0; a < 2; ++a)
#pragma unroll
        for (int b = 0; b < 2; ++b)
#pragma unroll
            for (int m = 0; m < 4; ++m)
#pragma unroll
                for (int n = 0; n < 2; ++n) acc[a][b][m][n] = (f32x4){0.f, 0.f, 0.f, 0.f};
    bf16x8 At[4][2], B0[2][2], B1[2][2];
    const char* cA = (const char*)g.A + (size_t)cur.pm * tstep; const char* cB = (const char*)g.Bt + (size_t)cur.pn * tstep;
    PG8_STAGE(PG8_SB(0, 0), cB); PG8_STAGE(PG8_SA(0, 0), cA); PG8_STAGE(PG8_SB(0, 1), cB + hstep); PG8_STAGE(PG8_SA(0, 1), cA + hstep);
    if (wr == 1) PG8_BAR;
    PG8_WAIT_V(4); PG8_BAR;
    PG8_STAGE(PG8_SB(1, 0), cB + kstep); PG8_STAGE(PG8_SA(1, 0), cA + kstep); PG8_STAGE(PG8_SB(1, 1), cB + hstep + kstep);
    PG8_WAIT_V(6); PG8_BAR;
    for (;;) {
        const bool has_next = S.next(ui + 1, nxt);
        const char* nA = has_next ? (const char*)g.A + (size_t)nxt.pm * tstep : cA; const char* nB = has_next ? (const char*)g.Bt + (size_t)nxt.pn * tstep : cB;
        for (int t = 0; t < nt; t += 2) {
            const bool last = (t == nt - 2);
            const char* a1 = cA + (size_t)(t + 1) * kstep;
            const char* a2 = last ? nA : cA + (size_t)(t + 2) * kstep; const char* b2 = last ? nB : cB + (size_t)(t + 2) * kstep;
            const char* a3 = a2 + kstep; const char* b3 = b2 + kstep;
            PG8_LDB(B0, 0, 0); PG8_SCHED; PG8_LDA(At, 0, 0); PG8_STAGE(PG8_SA(1, 1), a1 + hstep);
            PG8_WAIT_L(8); PG8_BAR; PG8_WAIT_L(0); PG8_MMA(0, 0, At, B0); PG8_BAR; PG8_SCHED;
            PG8_LDB(B1, 0, 1); PG8_STAGE(PG8_SB(0, 0), b2);
            PG8_BAR; PG8_WAIT_L(0); PG8_MMA(0, 1, At, B1); PG8_BAR;
            PG8_LDA(At, 0, 1); PG8_STAGE(PG8_SA(0, 0), a2);
            PG8_BAR; PG8_WAIT_L(0); PG8_MMA(1, 0, At, B0); PG8_BAR; PG8_SCHED;
            PG8_STAGE(PG8_SB(0, 1), b2 + hstep);
            PG8_WAIT_V(6); PG8_BAR; PG8_MMA(1, 1, At, B1); PG8_BAR;
            PG8_LDB(B0, 1, 0); PG8_SCHED; PG8_LDA(At, 1, 0); PG8_STAGE(PG8_SA(0, 1), a2 + hstep);
            PG8_WAIT_L(8); PG8_BAR; PG8_WAIT_L(0); PG8_MMA(0, 0, At, B0); PG8_BAR; PG8_SCHED;
            PG8_LDB(B1, 1, 1); PG8_STAGE(PG8_SB(1, 0), b3);
            PG8_BAR; PG8_WAIT_L(0); PG8_MMA(0, 1, At, B1); PG8_BAR;
            PG8_LDA(At, 1, 1); PG8_STAGE(PG8_SA(1, 0), a3);
            PG8_BAR; PG8_WAIT_L(0); PG8_MMA(1, 0, At, B0); PG8_BAR; PG8_SCHED;
            PG8_STAGE(PG8_SB(1, 1), b3 + hstep);
            PG8_WAIT_V(6); PG8_BAR; PG8_MMA(1, 1, At, B1); PG8_BAR;
        }
        E(acc, cur, wr, wc, fr, fq);
        if (!has_next) break;
#pragma unroll
        for (int a = 0; a < 2; ++a)
#pragma unroll
            for (int b = 0; b < 2; ++b)
#pragma unroll
                for (int m = 0; m < 4; ++m)
#pragma unroll
                    for (int n = 0; n < 2; ++n) acc[a][b][m][n] = (f32x4){0.f, 0.f, 0.f, 0.f};
        cur = nxt; cA = nA; cB = nB; ++ui;
    }
    PG8_WAIT_V(0);
    if (wr == 0) PG8_BAR;
    PG8_BAR;
#undef PG8_SA
#undef PG8_SB
#undef PG8_STAGE
#undef PG8_LDA
#undef PG8_LDB
#undef PG8_MMA
#undef PG8_WAIT_V
#undef PG8_WAIT_L
#undef PG8_BAR
#undef PG8_SCHED
}
}
using pg8::Unit;

#define EPI_ROWS_BEGIN _Pragma("unroll") for (int ai = 0; ai < 2; ++ai) _Pragma("unroll") for (int m = 0; m < 4; ++m) { const int rloc = ai * 128 + wr * 64 + m * 16 + fr; float v[16]; \
    _Pragma("unroll") for (int bj = 0; bj < 2; ++bj) _Pragma("unroll") for (int n = 0; n < 2; ++n) _Pragma("unroll") for (int j = 0; j < 4; ++j) v[8 * bj + 4 * n + j] = acc[ai][bj][m][n][j];
#define EPI_ROWS_END }
__device__ __forceinline__ void store16_bf16(bf16_t* p, const float (&v)[16]) {
    u32x4 a, b; a.x = pk2(v[0], v[1]); a.y = pk2(v[2], v[3]); a.z = pk2(v[4], v[5]); a.w = pk2(v[6], v[7]);
    b.x = pk2(v[8], v[9]); b.y = pk2(v[10], v[11]); b.z = pk2(v[12], v[13]); b.w = pk2(v[14], v[15]);
    *(u32x4*)p = a; *(u32x4*)(p + 32) = b;
}
__device__ __forceinline__ void load16_bf16(const bf16_t* p, float (&v)[16]) {
    const u32x4 a = *(const u32x4*)p, b = *(const u32x4*)(p + 32);
    v[0] = bflo(a.x); v[1] = bfhi(a.x); v[2] = bflo(a.y); v[3] = bfhi(a.y); v[4] = bflo(a.z); v[5] = bfhi(a.z); v[6] = bflo(a.w); v[7] = bfhi(a.w);
    v[8] = bflo(b.x); v[9] = bfhi(b.x); v[10] = bflo(b.y); v[11] = bfhi(b.y); v[12] = bflo(b.z); v[13] = bfhi(b.z); v[14] = bflo(b.w); v[15] = bfhi(b.w);
}
__device__ __forceinline__ void load16_f32(const float* p, float (&v)[16]) {
#pragma unroll
    for (int q = 0; q < 4; ++q) { const f32x4 t = *(const f32x4*)(p + 4 * (q & 1) + 32 * (q >> 1)); v[4 * q] = t.x; v[4 * q + 1] = t.y; v[4 * q + 2] = t.z; v[4 * q + 3] = t.w; }
}
__device__ __forceinline__ void store16_f32(float* p, const float (&v)[16]) {
#pragma unroll
    for (int q = 0; q < 4; ++q) *(f32x4*)(p + 4 * (q & 1) + 32 * (q >> 1)) = (f32x4){v[4 * q], v[4 * q + 1], v[4 * q + 2], v[4 * q + 3]};
}
__device__ __forceinline__ void nt_store16(u32x4* p, u32x4 v) { __builtin_nontemporal_store(v, p); }
__device__ __forceinline__ void store16_bf16_nt(bf16_t* p, const float (&v)[16]) {
    u32x4 a, b; a.x = pk2(v[0], v[1]); a.y = pk2(v[2], v[3]); a.z = pk2(v[4], v[5]); a.w = pk2(v[6], v[7]);
    b.x = pk2(v[8], v[9]); b.y = pk2(v[10], v[11]); b.z = pk2(v[12], v[13]); b.w = pk2(v[14], v[15]);
    nt_store16((u32x4*)p, a); nt_store16((u32x4*)(p + 32), b);
}
__device__ __forceinline__ void store16_f32_nt(float* p, const float (&v)[16]) {
#pragma unroll
    for (int q = 0; q < 4; ++q) { f32x4 t = (f32x4){v[4 * q], v[4 * q + 1], v[4 * q + 2], v[4 * q + 3]}; __builtin_nontemporal_store(t, (f32x4*)(p + 4 * (q & 1) + 32 * (q >> 1))); }
}
__device__ __forceinline__ void load16c_bf16(const bf16_t* p, float (&v)[16]) {
    const u32x4 a = *(const u32x4*)p, b = *(const u32x4*)(p + 8);
    v[0] = bflo(a.x); v[1] = bfhi(a.x); v[2] = bflo(a.y); v[3] = bfhi(a.y); v[4] = bflo(a.z); v[5] = bfhi(a.z); v[6] = bflo(a.w); v[7] = bfhi(a.w);
    v[8] = bflo(b.x); v[9] = bfhi(b.x); v[10] = bflo(b.y); v[11] = bfhi(b.y); v[12] = bflo(b.z); v[13] = bfhi(b.z); v[14] = bflo(b.w); v[15] = bfhi(b.w);
}
__device__ __forceinline__ void load16c_f32(const float* p, float (&v)[16]) {
#pragma unroll
    for (int q = 0; q < 4; ++q) { const f32x4 t = *(const f32x4*)(p + 4 * q); v[4 * q] = t.x; v[4 * q + 1] = t.y; v[4 * q + 2] = t.z; v[4 * q + 3] = t.w; }
}

__device__ __forceinline__ size_t pofs(int row, int col) { return ((size_t)((row >> 8) * (IN_COLS / 256) + (col >> 8)) << 16) + (size_t)(((row & 255) << 8) + (col & 255)); }
constexpr float QSCALE_DIL = 0.125f * LOG2E;

struct EpiProj {
    bf16_t* P; const float* gq; const float* gk;
    __device__ __forceinline__ void operator()(const f32x4 (&acc)[2][2][4][2], const Unit& u, int wr, int wc, int fr, int fq) const {
        const int pn = u.pn; int mode = 0; const float* gain = gq; float sc = 1.f;
        if (pn < 18) { const int g = pn / 6, t = (pn % 6) >> 1; if (t == 0) { mode = 1; gain = gq + g * 64; sc = QSCALE_DIL; } else if (t == 1) { mode = 1; gain = gk + g * 64; } }
        else if (pn == 19) { mode = 2; sc = 0.125f; }
        else if (pn == 22 || pn == 23) mode = 4;
        else if (pn >= 26) mode = 3;
        float gv[16];
#pragma unroll
        for (int e = 0; e < 16; ++e) gv[e] = 1.f;
        if (mode == 1) load16_f32(gain + fq * 8, gv);
        const int col0 = pn * 256 + wc * 64 + fq * 8;
        EPI_ROWS_BEGIN
            if (mode == 1) {
                float ss = 0.f;
#pragma unroll
                for (int e = 0; e < 16; ++e) ss += v[e] * v[e];
                ss += __shfl_xor(ss, 16); ss += __shfl_xor(ss, 32);
                const float rs = rsqrtf(ss * (1.f / 64.f) + NORM_EPS) * sc;
#pragma unroll
                for (int e = 0; e < 16; ++e) v[e] = v[e] * rs * gv[e];
            } else if (mode == 2) {
#pragma unroll
                for (int e = 0; e < 16; ++e) v[e] *= sc;
            } else if (mode == 3) {
#pragma unroll
                for (int e = 0; e < 16; ++e) v[e] = __builtin_amdgcn_rcpf(1.f + __builtin_amdgcn_exp2f(-LOG2E * v[e]));
            } else if (mode == 4) {
#pragma unroll
                for (int e = 0; e < 16; ++e) v[e] = v[e] * __builtin_amdgcn_rcpf(1.f + __builtin_amdgcn_exp2f(-LOG2E * v[e]));
            }
            store16_bf16_nt(P + pofs(u.pm * 256 + rloc, col0), v);
        EPI_ROWS_END
    }
};
struct EpiPlainBf16 {
    bf16_t* O; int ldc;
    __device__ __forceinline__ void operator()(const f32x4 (&acc)[2][2][4][2], const Unit& u, int wr, int wc, int fr, int fq) const {
        const int col0 = u.pn * 256 + wc * 64 + fq * 8;
        EPI_ROWS_BEGIN
            store16_bf16(O + (size_t)(u.pm * 256 + rloc) * ldc + col0, v);
        EPI_ROWS_END
    }
};
struct EpiBranch {
    bf16_t* Mg; const bf16_t* P;
    __device__ __forceinline__ void operator()(const f32x4 (&acc)[2][2][4][2], const Unit& u, int wr, int wc, int fr, int fq) const {
        const int b = u.pn >> 2, pn = u.pn & 3, pm = u.pm - b * (HTOK / 256);
        const int col0 = pn * 256 + wc * 64 + fq * 8;
        EPI_ROWS_BEGIN
            const size_t row = (size_t)(pm * 256 + rloc);
            float gt[16]; load16_bf16(P + pofs((int)row, GATE_OFF + b * 1024 + col0), gt);
            bf16_t* mp = Mg + row * D_MODEL + col0;
            if (b == 0) {
#pragma unroll
                for (int e = 0; e < 16; ++e) v[e] = v[e] * gt[e];
            } else {
                float old[16]; load16_bf16(mp, old);
#pragma unroll
                for (int e = 0; e < 16; ++e) v[e] = old[e] + v[e] * gt[e];
            }
            store16_bf16(mp, v);
        EPI_ROWS_END
    }
};
struct EpiOut {
    const float* X; float* Out; bf16_t* A2; const float* g2; float* ssq;
    __device__ __forceinline__ void operator()(const f32x4 (&acc)[2][2][4][2], const Unit& u, int wr, int wc, int fr, int fq) const {
        const int col0 = u.pn * 256 + wc * 64 + fq * 8;
        float gv[16]; load16_f32(g2 + col0, gv);
        EPI_ROWS_BEGIN
            const size_t row = (size_t)(u.pm * 256 + rloc);
            float xv[16]; load16_f32(X + row * D_MODEL + col0, xv);
            float ss = 0.f;
#pragma unroll
            for (int e = 0; e < 16; ++e) { v[e] += xv[e]; ss += v[e] * v[e]; }
            store16_f32_nt(Out + row * D_MODEL + col0, v);
#pragma unroll
            for (int e = 0; e < 16; ++e) v[e] *= gv[e];
            store16_bf16_nt(A2 + row * D_MODEL + col0, v);
            ss += __shfl_xor(ss, 16); ss += __shfl_xor(ss, 32);
            if (fq == 0) (void)__hip_atomic_fetch_add(ssq + row, ss, __ATOMIC_RELAXED, __HIP_MEMORY_SCOPE_AGENT);
        EPI_ROWS_END
    }
};
struct EpiFfnIn {
    bf16_t* UG; const float* ssq;
    __device__ __forceinline__ void operator()(const f32x4 (&acc)[2][2][4][2], const Unit& u, int wr, int wc, int fr, int fq) const {
        const int col0 = u.pn * 256 + wc * 64 + fq * 8;
        EPI_ROWS_BEGIN
            const size_t row = (size_t)(u.pm * 256 + rloc);
            float sp[16]; load16c_f32(ssq + row * 16, sp);
            float ss = 0.f;
#pragma unroll
            for (int e = 0; e < 16; ++e) ss += sp[e];
            const float rs = rsqrtf(ss * (1.f / 1024.f) + NORM_EPS);
#pragma unroll
            for (int e = 0; e < 16; ++e) v[e] *= rs;
            store16_bf16(UG + row * FF2 + col0, v);
        EPI_ROWS_END
    }
};
__device__ __forceinline__ float gelu_exact(float v) {
    const float t = __builtin_amdgcn_rcpf(fabsf(v) * 0.2316418882f + 1.0f);
    float q = t * 0.5307027145f + (-0.7265760135f); q = q * t + 0.7107068705f; q = q * t + (-0.142248368f); q = q * t + 0.127414796f; q = q * t;
    const float e = __builtin_amdgcn_exp2f(v * v * (-0.72134752044f));
    const float m = v * (q * e);
    return v < 0.f ? m : v - m;
}
__device__ __forceinline__ f32x2 gelu_pk(f32x2 v) {
    const f32x2 av = __builtin_elementwise_abs(v), d = av * 0.2316418882f + 1.0f;
    f32x2 t; t.x = __builtin_amdgcn_rcpf(d.x); t.y = __builtin_amdgcn_rcpf(d.y);
    f32x2 q = t * 0.5307027145f + (-0.7265760135f); q = q * t + 0.7107068705f; q = q * t + (-0.142248368f); q = q * t + 0.127414796f; q = q * t;
    const f32x2 sq = (v * v) * (-0.72134752044f);
    f32x2 e; e.x = __builtin_amdgcn_exp2f(sq.x); e.y = __builtin_amdgcn_exp2f(sq.y);
    const f32x2 m = v * (q * e), r = v - m;
    f32x2 o; o.x = v.x < 0.f ? m.x : r.x; o.y = v.y < 0.f ? m.y : r.y; return o;
}
struct EpiFfnInConv {
    bf16_t* YF; bf16_t* HALO; const float* ssq; const float* cw; const float* cb;
    __device__ __forceinline__ void operator()(const f32x4 (&acc)[2][2][4][2], const Unit& u, int wr, int wc, int fr, int fq) const {
        const int lane = fq * 16 + fr, chb = u.pn * 128 + wc * 32 + fq * 8;
        const int idx_prev = (lane & 48) | ((fr + 15) & 15), idx_next = (lane & 48) | ((fr + 1) & 15);
#pragma unroll
        for (int ai = 0; ai < 2; ++ai) {
            float rs[4];
#pragma unroll
            for (int m = 0; m < 4; ++m) rs[m] = ssq[(unsigned)(u.pm * 256 + ai * 128 + wr * 64 + m * 16 + fr)];
#pragma unroll
            for (int m = 0; m < 4; ++m) rs[m] = rsqrtf(rs[m] * (1.f / 1024.f) + NORM_EPS);
            const int blk = u.pm * 4 + 2 * ai + wr;
            u32x2 keep[4];
#pragma unroll
            for (int n = 0; n < 2; ++n) {
                const f32x4 w0 = *(const f32x4*)(cw + chb + 4 * n), w1 = *(const f32x4*)(cw + D_FF + chb + 4 * n), w2 = *(const f32x4*)(cw + 2 * D_FF + chb + 4 * n), bb = *(const f32x4*)(cb + chb + 4 * n);
#pragma unroll
                for (int m = 0; m < 4; ++m) {
                    float yv[4], uc[4], gc[4];
#pragma unroll
                    for (int j = 0; j < 4; ++j) {
                        const float ucur = acc[ai][0][m][n][j] * rs[m];
                        const float um1 = m > 0 ? acc[ai][0][m > 0 ? m - 1 : 0][n][j] * rs[m > 0 ? m - 1 : 0] : 0.f;
                        const float up1 = m < 3 ? acc[ai][0][m < 3 ? m + 1 : 3][n][j] * rs[m < 3 ? m + 1 : 3] : 0.f;
                        const float uprev = __builtin_bit_cast(float, __builtin_amdgcn_update_dpp(0, __builtin_bit_cast(int, fr == 15 ? um1 : ucur), 0x121, 0xf, 0xf, false));
                        const float unext = __builtin_bit_cast(float, __builtin_amdgcn_update_dpp(0, __builtin_bit_cast(int, fr == 0 ? up1 : ucur), 0x12F, 0xf, 0xf, false));
                        yv[j] = bb[j] + w0[j] * uprev + w1[j] * ucur + w2[j] * unext;
                        uc[j] = ucur; gc[j] = acc[ai][1][m][n][j] * rs[m];
                    }
                    { const f32x2 g01 = gelu_pk((f32x2){yv[0], yv[1]}), g23 = gelu_pk((f32x2){yv[2], yv[3]});
                      yv[0] = g01.x * gc[0]; yv[1] = g01.y * gc[1]; yv[2] = g23.x * gc[2]; yv[3] = g23.y * gc[3]; }
                    const unsigned row = (unsigned)(u.pm * 256 + ai * 128 + wr * 64 + m * 16 + fr);
                    const bool e0 = (m == 0 && fr == 0), e63 = (m == 3 && fr == 15);
                    { u32x2 o; o.x = pk2(yv[0], yv[1]); o.y = pk2(yv[2], yv[3]);
                      if (n == 0) keep[m] = o;
                      else if (!(e0 || e63)) { u32x4 o4; o4.x = keep[m].x; o4.y = keep[m].y; o4.z = o.x; o4.w = o.y; __builtin_nontemporal_store(o4, (u32x4*)(YF + (row * (unsigned)D_FF + (unsigned)chb))); } }
                    if (m == 0 || m == 3) {
                        const int hs = m == 0 ? (fr == 0 ? 0 : (fr == 1 ? 1 : -1)) : (fr == 14 ? 2 : (fr == 15 ? 3 : -1));
                        if (hs >= 0) { u32x2 o; o.x = pk2(uc[0], uc[1]); o.y = pk2(uc[2], uc[3]); *(u32x2*)(HALO + ((unsigned)(blk * 6 + hs) * (unsigned)D_FF + (unsigned)(chb + 4 * n))) = o; }
                        if (e0 || e63) { u32x2 o; o.x = pk2(gc[0], gc[1]); o.y = pk2(gc[2], gc[3]); *(u32x2*)(HALO + ((unsigned)(blk * 6 + (e0 ? 4 : 5)) * (unsigned)D_FF + (unsigned)(chb + 4 * n))) = o; }
                    }
                    asm volatile("" ::: "memory");
                }
            }
        }
    }
};
struct EpiFfnOut {
    float* Out;
    __device__ __forceinline__ void operator()(const f32x4 (&acc)[2][2][4][2], const Unit& u, int wr, int wc, int fr, int fq) const {
        const int col0 = u.pn * 256 + wc * 64 + fq * 8;
        EPI_ROWS_BEGIN
            float* op = Out + (size_t)(u.pm * 256 + rloc) * D_MODEL + col0;
            float xv[16]; load16_f32(op, xv);
#pragma unroll
            for (int e = 0; e < 16; ++e) v[e] += xv[e];
            store16_f32_nt(op, v);
        EPI_ROWS_END
    }
};

__device__ __forceinline__ int ffn_row_of(int ng) { const int gate = ng >= D_FF ? 1 : 0, ch = ng - gate * D_FF, c7 = ch & 127;
    return (ch >> 7) * 256 + 128 * gate + 32 * (c7 >> 5) + 16 * ((c7 >> 2) & 1) + 4 * ((c7 >> 3) & 3) + (c7 & 3); }
template <int PERMMODE>
__device__ __forceinline__ void p0_transpose_item(const float* W, int K, int N, bf16_t* WT, int row_off, LAS float* scr, int item, int lane) {
    const int nblk = N / 32, kb = item / nblk, nb = item % nblk, k0 = 64 * kb, n0 = 32 * nb;
#pragma unroll 8
    for (int i = 0; i < 32; ++i) { const int kk = 2 * i + (lane >> 5); scr[kk * 33 + (lane & 31)] = W[(size_t)(k0 + kk) * N + n0 + (lane & 31)]; }
    asm volatile("s_waitcnt lgkmcnt(0)" ::: "memory");
    const int c = lane & 7;
#pragma unroll
    for (int j = 0; j < 4; ++j) { const int n = (lane >> 3) + 8 * j; const LAS float* s = scr + (8 * c) * 33 + n;
        u32x4 o; o.x = pk2(s[0 * 33], s[1 * 33]); o.y = pk2(s[2 * 33], s[3 * 33]); o.z = pk2(s[4 * 33], s[5 * 33]); o.w = pk2(s[6 * 33], s[7 * 33]);
        const int ng = n0 + n, nrow = PERMMODE == 1 ? ffn_row_of(ng) : (ng & ~255) + slot_of(ng & 255);
        *(u32x4*)(WT + (size_t)(row_off + nrow) * K + k0 + 8 * c) = o; }
    asm volatile("s_waitcnt lgkmcnt(0)" ::: "memory");
}
__device__ __forceinline__ void rms_row_to_bf16(const float* xrow, const float* g, bf16_t* orow, int lane) {
    const f32x4* xr = (const f32x4*)xrow + lane; const f32x4* gr = (const f32x4*)g + lane;
    f32x4 v[4]; float s = 0.f;
#pragma unroll
    for (int j = 0; j < 4; ++j) { v[j] = xr[64 * j]; s += (v[j].x * v[j].x + v[j].y * v[j].y) + (v[j].z * v[j].z + v[j].w * v[j].w); }
    const float rs = rsqrtf(wave_sum(s) * (1.f / 1024.f) + NORM_EPS);
    u32x2* o8 = (u32x2*)orow + lane;
#pragma unroll
    for (int j = 0; j < 4; ++j) { const f32x4 gg = gr[64 * j]; u32x2 w; w.x = pk2(v[j].x * rs * gg.x, v[j].y * rs * gg.y); w.y = pk2(v[j].z * rs * gg.z, v[j].w * rs * gg.w); o8[64 * j] = w; }
}

__device__ __forceinline__ void rms_row2_to_bf16(const float* xa, const float* xb, const float* g, bf16_t* oa, bf16_t* ob, int lane) {
    const f32x4* ra = (const f32x4*)xa + lane; const f32x4* rb = (const f32x4*)xb + lane; const f32x4* gr = (const f32x4*)g + lane;
    f32x4 va[4], vb[4]; float sa = 0.f, sb = 0.f;
#pragma unroll
    for (int j = 0; j < 4; ++j) { va[j] = ra[64 * j]; vb[j] = rb[64 * j]; }
#pragma unroll
    for (int j = 0; j < 4; ++j) { sa += (va[j].x * va[j].x + va[j].y * va[j].y) + (va[j].z * va[j].z + va[j].w * va[j].w); sb += (vb[j].x * vb[j].x + vb[j].y * vb[j].y) + (vb[j].z * vb[j].z + vb[j].w * vb[j].w); }
#pragma unroll
    for (int o = 1; o < 64; o <<= 1) { sa += __shfl_xor(sa, o); sb += __shfl_xor(sb, o); }
    const float rsa = rsqrtf(sa * (1.f / 1024.f) + NORM_EPS), rsb = rsqrtf(sb * (1.f / 1024.f) + NORM_EPS);
    u32x2* o8a = (u32x2*)oa + lane; u32x2* o8b = (u32x2*)ob + lane;
#pragma unroll
    for (int j = 0; j < 4; ++j) { const f32x4 gg = gr[64 * j]; u32x2 w;
        w.x = pk2(va[j].x * rsa * gg.x, va[j].y * rsa * gg.y); w.y = pk2(va[j].z * rsa * gg.z, va[j].w * rsa * gg.w); o8a[64 * j] = w;
        w.x = pk2(vb[j].x * rsb * gg.x, vb[j].y * rsb * gg.y); w.y = pk2(vb[j].z * rsb * gg.z, vb[j].w * rsb * gg.w); o8b[64 * j] = w; }
}


__device__ __forceinline__ void dil_wave(const bf16_t* proj, bf16_t* odil, float* lse, const float* cconst, int item, LAS char* vl, int lane) {
    asm volatile("" : "+v"(lane));
    const int qb = item & 31; int t = item >> 5; const int g = t % 3; t /= 3; const int h = t & 7, b = t >> 3;
    const float cshift = cconst[g];
    const int lr = 2 * g, r = 1 << lr, nsub = SEQ >> lr, nblk = nsub >> 6;
    const int c = qb / nblk, nb = qb % nblk, i0 = nb * 64;
    const int rr = lane & 31, hh = lane >> 5;
    const int rowb = b * SEQ;
    const int qcol = g * 1536 + h * 64, kcol = qcol + 512, vcol = qcol + 1024;
    const int kt_lo = i0 == 0 ? 2 : 0, kt_hi = (i0 == nsub - 64) ? 4 : 6;
    bf16x8 kn[4];
#define DIL_ISSUE(KT) do { const int j0_ = i0 - 64 + 32 * (KT); \
        { int jr = j0_ + rr; jr = jr < 0 ? 0 : (jr >= nsub ? nsub - 1 : jr); const bf16_t* p = proj + pofs(rowb + jr * r + c, kcol + 32 * hh); \
          _Pragma("unroll") for (int ks = 0; ks < 4; ++ks) kn[ks] = *(const bf16x8*)(p + 8 * ks); } \
        _Pragma("unroll") for (int q = 0; q < 4; ++q) { int jv = j0_ + 8 * q + (lane >> 3); jv = jv < 0 ? 0 : (jv >= nsub ? nsub - 1 : jv); \
          __builtin_amdgcn_global_load_lds((const unsigned*)(proj + pofs(rowb + jv * r + c, vcol + 8 * (lane & 7))), (LAS unsigned*)(vl + 4096 * ((KT) & 1) + 1024 * q), 16, 0, 0); } } while (0)
    DIL_ISSUE(kt_lo);
    bf16x8 qf[2][4];
#pragma unroll
    for (int qt = 0; qt < 2; ++qt) { const int tok = (i0 + 32 * qt + rr) * r + c; const bf16_t* p = proj + pofs(rowb + tok, qcol + 32 * hh);
#pragma unroll
        for (int ks = 0; ks < 4; ++ks) qf[qt][ks] = *(const bf16x8*)(p + 8 * ks); }
    f32x16 o[2][2];
#pragma unroll
    for (int a = 0; a < 2; ++a)
#pragma unroll
        for (int q = 0; q < 2; ++q)
#pragma unroll
            for (int e = 0; e < 16; ++e) o[a][q][e] = 0.f;
    float lrun[2] = {0.f, 0.f};
    const float slope2 = exp2f(-(float)(h + 1)) * (float)r * LOG2E;
    const int blk = (lane >> 4) & 1, q4 = (lane & 15) >> 2, p4 = lane & 3;
    float fd[16];
#pragma unroll
    for (int e = 0; e < 16; ++e) fd[e] = (float)(rr - 4 * hh - ((e & 3) + 8 * (e >> 2)));
#ifdef PROBE_DILLOOP
    for (int rep = 0; rep < 2; ++rep) {
    if (rep) { DIL_ISSUE(kt_lo); lrun[0] = 0.f; lrun[1] = 0.f;
        _Pragma("unroll") for (int a = 0; a < 2; ++a) _Pragma("unroll") for (int q = 0; q < 2; ++q) _Pragma("unroll") for (int e = 0; e < 16; ++e) o[a][q][e] = 0.f; }
#endif
    for (int kt = kt_lo; kt < kt_hi; ++kt) {
        asm volatile("s_waitcnt vmcnt(0)" ::: "memory");
        bf16x8 kf[4];
#pragma unroll
        for (int ks = 0; ks < 4; ++ks) kf[ks] = kn[ks];
        if (kt + 1 < kt_hi) DIL_ISSUE(kt + 1);
        asm volatile("" ::: "memory");
        LAS char* vb = vl + 4096 * (kt & 1);
        bf16x8 pf[2][2];
        bool act[2];
#pragma unroll
        for (int qt = 0; qt < 2; ++qt) {
            const int mrel = kt - qt;
            act[qt] = !(mrel == 5 || mrel == -1);
            if (!act[qt]) continue;
            f32x16 s;
#pragma unroll
            for (int e = 0; e < 16; ++e) s[e] = -cshift;
#pragma unroll
            for (int ks = 0; ks < 4; ++ks) s = MFMA32(kf[ks], qf[qt][ks], s);
            const float Df = 64.f - 32.f * (float)mrel;
            const bool edge = (mrel == 0) || (mrel == 4);
            float rs = 0.f;
#pragma unroll
            for (int e = 0; e < 16; ++e) { const float tt = Df + fd[e]; float sv = fmaf(-slope2, fabsf(tt), s[e]);
                if (edge) sv = fabsf(tt) <= 64.f ? sv : -INFINITY;
                const float p = __builtin_amdgcn_exp2f(sv); s[e] = p; rs += p; }
            lrun[qt] += rs;
#pragma unroll
            for (int s2 = 0; s2 < 2; ++s2) pf[qt][s2] = pack8(s[8 * s2], s[8 * s2 + 1], s[8 * s2 + 2], s[8 * s2 + 3], s[8 * s2 + 4], s[8 * s2 + 5], s[8 * s2 + 6], s[8 * s2 + 7]);
        }
#pragma unroll
        for (int dt = 0; dt < 2; ++dt)
#pragma unroll
            for (int s2 = 0; s2 < 2; ++s2) {
                LAS char* a = vb + (16 * s2 + 4 * hh + q4) * 128 + (32 * dt + 16 * blk + 4 * p4) * 2;
                const bf16x8 vf = cat4(tr_read(a), tr_read(a + 8 * 128));
#pragma unroll
                for (int qt = 0; qt < 2; ++qt) if (act[qt]) o[dt][qt] = MFMA32(vf, pf[qt][s2], o[dt][qt]);
            }
        asm volatile("" ::: "memory");
    }
#ifdef PROBE_DILLOOP
    }
#endif
#undef DIL_ISSUE
#pragma unroll
    for (int qt = 0; qt < 2; ++qt) {
        const float lt = lrun[qt] + __shfl_xor(lrun[qt], 32);
        const int row = 32 * qt + rr; const float inv = __builtin_amdgcn_rcpf(lt);
#pragma unroll
        for (int dt = 0; dt < 2; ++dt)
#pragma unroll
            for (int gq = 0; gq < 4; ++gq) { u32x2 w; w.x = pk2(o[dt][qt][4 * gq] * inv, o[dt][qt][4 * gq + 1] * inv); w.y = pk2(o[dt][qt][4 * gq + 2] * inv, o[dt][qt][4 * gq + 3] * inv);
                *(LAS u32x2*)(vl + row * 128 + 16 * ((4 * dt + gq) ^ (row & 7)) + 8 * hh) = w; }
        if (hh == 0) lse[((size_t)g * HTOK + (size_t)b * SEQ + (i0 + row) * r + c) * 8 + h] = log2f(lt) + cshift;
    }
    asm volatile("" ::: "memory");
    { bf16_t* ob = odil + ((size_t)g * HTOK + (size_t)b * SEQ) * 512 + h * 64;
#pragma unroll
        for (int q = 0; q < 8; ++q) { const int row = 8 * q + (lane >> 3), pos = lane & 7, ch = pos ^ (row & 7);
            const u32x4 v = *(const LAS u32x4*)(vl + row * 128 + 16 * pos);
            *(u32x4*)(ob + (size_t)((i0 + row) * r + c) * 512 + 8 * ch) = v; } }
    asm volatile("" ::: "memory");
}

__device__ __forceinline__ void ret_u_item(const bf16_t* proj, bf16_t* U, const float* decay_logit, int item, LAS char* L, int tid) {
    asm volatile("" : "+v"(tid));
    const int n = item & 15, h = (item >> 4) & 3, b = item >> 6;
    const int lane = tid & 63, wave = tid >> 6, rr = lane & 31, hh = lane >> 5, blk = (lane >> 4) & 1, q4 = (lane & 15) >> 2, p4 = lane & 3;
    const float Lf = -log1pf(expf(-decay_logit[h])) * LOG2E, Lb = -log1pf(expf(-decay_logit[4 + h])) * LOG2E;
    const int rowb = b * SEQ + 128 * n;
    { const int row = tid >> 2, pc = tid & 3; const bf16_t* p = proj + pofs(rowb + row, RET_OFF + 256 + h * 64 + 16 * pc);
        const u32x4 a = *(const u32x4*)p, c = *(const u32x4*)(p + 8);
        const float wf = exp2f(Lf * (float)(127 - row)), wb = exp2f(Lb * (float)row);
        u32x4 o;
        o.x = pk2(bflo(a.x) * wf, bfhi(a.x) * wf); o.y = pk2(bflo(a.y) * wf, bfhi(a.y) * wf); o.z = pk2(bflo(a.z) * wf, bfhi(a.z) * wf); o.w = pk2(bflo(a.w) * wf, bfhi(a.w) * wf);
        *(LAS u32x4*)(L + row * 128 + 32 * pc) = o;
        o.x = pk2(bflo(c.x) * wf, bfhi(c.x) * wf); o.y = pk2(bflo(c.y) * wf, bfhi(c.y) * wf); o.z = pk2(bflo(c.z) * wf, bfhi(c.z) * wf); o.w = pk2(bflo(c.w) * wf, bfhi(c.w) * wf);
        *(LAS u32x4*)(L + row * 128 + 32 * pc + 16) = o;
        o.x = pk2(bflo(a.x) * wb, bfhi(a.x) * wb); o.y = pk2(bflo(a.y) * wb, bfhi(a.y) * wb); o.z = pk2(bflo(a.z) * wb, bfhi(a.z) * wb); o.w = pk2(bflo(a.w) * wb, bfhi(a.w) * wb);
        *(LAS u32x4*)(L + 16384 + row * 128 + 32 * pc) = o;
        o.x = pk2(bflo(c.x) * wb, bfhi(c.x) * wb); o.y = pk2(bflo(c.y) * wb, bfhi(c.y) * wb); o.z = pk2(bflo(c.z) * wb, bfhi(c.z) * wb); o.w = pk2(bflo(c.w) * wb, bfhi(c.w) * wb);
        *(LAS u32x4*)(L + 16384 + row * 128 + 32 * pc + 16) = o; }
#pragma unroll
    for (int q = 0; q < 4; ++q) { const int idx = tid + 512 * q, row = idx >> 4, pc = idx & 15;
        *(LAS u32x4*)(L + 32768 + row * 256 + 16 * pc) = *(const u32x4*)(proj + pofs(rowb + row, RET_OFF + 512 + h * 128 + 8 * pc)); }
    __syncthreads();
    const int dir = wave >> 2, vt = wave & 3;
    f32x16 acc[2];
#pragma unroll
    for (int a = 0; a < 2; ++a)
#pragma unroll
        for (int e = 0; e < 16; ++e) acc[a][e] = 0.f;
    LAS char* KI = L + 16384 * dir; LAS char* VI = L + 32768;
#pragma unroll
    for (int ks = 0; ks < 8; ++ks) {
        const int jrow = 16 * ks + 8 * hh + q4;
        LAS char* vb = VI + jrow * 256 + (32 * vt + 16 * blk + 4 * p4) * 2;
        const bf16x8 bfr = cat4(tr_read(vb), tr_read(vb + 4 * 256));
#pragma unroll
        for (int dt = 0; dt < 2; ++dt) { LAS char* ka = KI + jrow * 128 + (32 * dt + 16 * blk + 4 * p4) * 2;
            const bf16x8 afr = cat4(tr_read(ka), tr_read(ka + 4 * 128));
            acc[dt] = MFMA32(afr, bfr, acc[dt]); }
    }
    bf16_t* up = U + ((size_t)((b * 4 + h) * 16 + n) * 2 + dir) * 8192;
#pragma unroll
    for (int dt = 0; dt < 2; ++dt)
#pragma unroll
        for (int e = 0; e < 16; ++e) up[(32 * dt + (e & 3) + 8 * (e >> 2) + 4 * hh) * 128 + 32 * vt + rr] = (bf16_t)(pk2(acc[dt][e], 0.f) & 0xffffu);
    __syncthreads();
}
__device__ __forceinline__ bf16x8 scale_frag(bf16x8 f, float sc) {
    const u32x4 w = __builtin_bit_cast(u32x4, f);
    return pack8(bflo(w.x) * sc, bfhi(w.x) * sc, bflo(w.y) * sc, bfhi(w.y) * sc, bflo(w.z) * sc, bfhi(w.z) * sc, bflo(w.w) * sc, bfhi(w.w) * sc);
}
__device__ __forceinline__ void st16_lds_bf16(LAS char* p, const float (&v)[16]) {
    u32x4 a, b; a.x = pk2(v[0], v[1]); a.y = pk2(v[2], v[3]); a.z = pk2(v[4], v[5]); a.w = pk2(v[6], v[7]);
    b.x = pk2(v[8], v[9]); b.y = pk2(v[10], v[11]); b.z = pk2(v[12], v[13]); b.w = pk2(v[14], v[15]);
    *(LAS u32x4*)p = a; *(LAS u32x4*)(p + 16) = b;
}
__device__ __forceinline__ void ret_chunk_item(const bf16_t* proj, const bf16_t* U, bf16_t* yret, const float* decay_logit, const float* gn_g, int item, LAS char* L, int tid) {
    asm volatile("" : "+v"(tid));
    const int pr = item & 7, h = (item >> 3) & 3, b = item >> 5, n = 2 * pr;
    const int lane = tid & 63, wave = tid >> 6, rr = lane & 31, hh = lane >> 5, blk = (lane >> 4) & 1, q4 = (lane & 15) >> 2, p4 = lane & 3;
    const float Lf = -log1pf(expf(-decay_logit[h])) * LOG2E, Lb = -log1pf(expf(-decay_logit[4 + h])) * LOG2E;
    const int rowb = b * SEQ + 128 * n;
#pragma unroll
    for (int q = 0; q < 8; ++q) { const int idx = tid + 512 * q, row = idx >> 4, pc = idx & 15;
        *(LAS u32x4*)(L + row * 256 + 16 * pc) = *(const u32x4*)(proj + pofs(rowb + row, RET_OFF + 512 + h * 128 + 8 * pc)); }
    { const bf16_t* Ub = U + (size_t)((b * 4 + h) * 16) * 2 * 8192 + tid * 16;
        const float wf = exp2f(128.f * Lf), wb = exp2f(128.f * Lb);
        const int d = tid >> 3, v0 = (tid & 7) * 16;
        LAS char* S = L + 65536 + d * 256 + v0 * 2;
        float acc[16], t[16];
#pragma unroll
        for (int e = 0; e < 16; ++e) acc[e] = 0.f;
        for (int m0 = n - 4 * ((n + 3) >> 2); m0 < n; m0 += 4) {
            float t4[4][16];
#pragma unroll
            for (int u4 = 0; u4 < 4; ++u4) { const int m = m0 + u4; load16c_bf16(Ub + (size_t)((m < 0 ? 0 : m) * 2) * 8192, t4[u4]); }
#pragma unroll
            for (int u4 = 0; u4 < 4; ++u4) { const float msk = (m0 + u4) < 0 ? 0.f : 1.f;
#pragma unroll
                for (int e = 0; e < 16; ++e) acc[e] = acc[e] * wf + t4[u4][e] * msk; } }
        st16_lds_bf16(S, acc);
        load16c_bf16(Ub + (size_t)(n * 2) * 8192, t);
#pragma unroll
        for (int e = 0; e < 16; ++e) acc[e] = acc[e] * wf + t[e];
        st16_lds_bf16(S + 2 * 16384, acc);
#pragma unroll
        for (int e = 0; e < 16; ++e) acc[e] = 0.f;
        { const int cnt = 14 - n;
          for (int m0 = 15 + 4 * ((cnt + 3) >> 2) - cnt; m0 > 15 - cnt; m0 -= 4) {
            float t4[4][16];
#pragma unroll
            for (int u4 = 0; u4 < 4; ++u4) { const int m = m0 - u4; load16c_bf16(Ub + (size_t)((m > 15 ? 15 : m) * 2 + 1) * 8192, t4[u4]); }
#pragma unroll
            for (int u4 = 0; u4 < 4; ++u4) { const float msk = (m0 - u4) > 15 ? 0.f : 1.f;
#pragma unroll
                for (int e = 0; e < 16; ++e) acc[e] = acc[e] * wb + t4[u4][e] * msk; } } }
        st16_lds_bf16(S + 3 * 16384, acc);
        load16c_bf16(Ub + (size_t)((n + 1) * 2 + 1) * 8192, t);
#pragma unroll
        for (int e = 0; e < 16; ++e) acc[e] = acc[e] * wb + t[e];
        st16_lds_bf16(S + 1 * 16384, acc);
    }
    __syncthreads();
    const int cw = wave >> 2, i = 32 * (wave & 3) + rr;
    const int crow = rowb + 128 * cw;
    bf16x8 qf[4];
    { const bf16_t* p = proj + pofs(crow + i, RET_OFF + h * 64 + 32 * hh);
#pragma unroll
        for (int ks = 0; ks < 4; ++ks) qf[ks] = *(const bf16x8*)(p + 8 * ks); }
    f32x16 y[4];
#pragma unroll
    for (int a = 0; a < 4; ++a)
#pragma unroll
        for (int e = 0; e < 16; ++e) y[a][e] = 0.f;
    LAS char* VI = L + cw * 32768;
#pragma unroll
    for (int kt = 0; kt < 4; ++kt) {
        const int j0 = 32 * kt;
        bf16x8 kf[4];
        { const bf16_t* p = proj + pofs(crow + j0 + rr, RET_OFF + 256 + h * 64 + 32 * hh);
#pragma unroll
            for (int ks = 0; ks < 4; ++ks) kf[ks] = *(const bf16x8*)(p + 8 * ks); }
        f32x16 s;
#pragma unroll
        for (int e = 0; e < 16; ++e) s[e] = 0.f;
#pragma unroll
        for (int ks = 0; ks < 4; ++ks) s = MFMA32(kf[ks], qf[ks], s);
#pragma unroll
        for (int e = 0; e < 16; ++e) { const int j = j0 + (e & 3) + 8 * (e >> 2) + 4 * hh; const int dd = i - j;
            const float w = dd >= 0 ? exp2f(Lf * (float)dd) : exp2f(Lb * (float)(-dd)); s[e] *= w; }
        bf16x8 pf[2];
#pragma unroll
        for (int s2 = 0; s2 < 2; ++s2) pf[s2] = pack8(s[8 * s2], s[8 * s2 + 1], s[8 * s2 + 2], s[8 * s2 + 3], s[8 * s2 + 4], s[8 * s2 + 5], s[8 * s2 + 6], s[8 * s2 + 7]);
#pragma unroll
        for (int vt = 0; vt < 4; ++vt)
#pragma unroll
            for (int s2 = 0; s2 < 2; ++s2) {
                LAS char* a = VI + (j0 + 16 * s2 + 4 * hh + q4) * 256 + (32 * vt + 16 * blk + 4 * p4) * 2;
                const bf16x8 vf = cat4(tr_read(a), tr_read(a + 8 * 256));
                y[vt] = MFMA32(vf, pf[s2], y[vt]);
            }
    }
#pragma unroll
    for (int dir = 0; dir < 2; ++dir) {
        const float sc = dir == 0 ? exp2f(Lf * (float)(i + 1)) : exp2f(Lb * (float)(128 - i));
        LAS char* SI = L + 65536 + (cw * 2 + dir) * 16384;
#pragma unroll
        for (int ks = 0; ks < 4; ++ks) {
            const bf16x8 qs = scale_frag(qf[ks], sc);
#pragma unroll
            for (int vt = 0; vt < 4; ++vt) {
                LAS char* a = SI + (32 * hh + 8 * ks + q4) * 256 + (32 * vt + 16 * blk + 4 * p4) * 2;
                const bf16x8 af = cat4(tr_read(a), tr_read(a + 4 * 256));
                y[vt] = MFMA32(af, qs, y[vt]);
            }
        }
    }
    float sm = 0.f;
#pragma unroll
    for (int vt = 0; vt < 4; ++vt)
#pragma unroll
        for (int e = 0; e < 16; ++e) sm += y[vt][e];
    sm += __shfl_xor(sm, 32);
    const float mu = sm * (1.f / 128.f);
    float sq = 0.f;
#pragma unroll
    for (int vt = 0; vt < 4; ++vt)
#pragma unroll
        for (int e = 0; e < 16; ++e) { const float dlt = y[vt][e] - mu; sq += dlt * dlt; }
    sq += __shfl_xor(sq, 32);
    const float rs = rsqrtf(sq * (1.f / 128.f) + NORM_EPS);
    const bf16_t* gp = proj + pofs(crow + i, RET_OFF + 1024 + h * 128);
    bf16_t* op = yret + ((size_t)b * SEQ + 128 * (n + cw) + i) * 512 + h * 128;
    const float* gg = gn_g + h * 128;
#pragma unroll
    for (int vt = 0; vt < 4; ++vt)
#pragma unroll
        for (int gq = 0; gq < 4; ++gq) { const int vi = 32 * vt + 8 * gq + 4 * hh;
            const u32x2 gw = *(const u32x2*)(gp + vi); const f32x4 g4 = *(const f32x4*)(gg + vi);
            u32x2 w; w.x = pk2((y[vt][4 * gq] - mu) * rs * g4.x * bflo(gw.x), (y[vt][4 * gq + 1] - mu) * rs * g4.y * bfhi(gw.x));
            w.y = pk2((y[vt][4 * gq + 2] - mu) * rs * g4.z * bflo(gw.y), (y[vt][4 * gq + 3] - mu) * rs * g4.w * bfhi(gw.y));
            *(u32x2*)(op + vi) = w; }
    __syncthreads();
}

__device__ __forceinline__ bf16x8 scale8(u32x4 w, float rs, const float* g) {
    const f32x4 g0 = *(const f32x4*)g, g1 = *(const f32x4*)(g + 4);
    return pack8(bflo(w.x) * rs * g0.x, bfhi(w.x) * rs * g0.y, bflo(w.y) * rs * g0.z, bfhi(w.y) * rs * g0.w, bflo(w.z) * rs * g1.x, bfhi(w.z) * rs * g1.y, bflo(w.w) * rs * g1.z, bfhi(w.w) * rs * g1.w);
}
__device__ __forceinline__ float ssq8(u32x4 w) {
    const float a = bflo(w.x), b = bfhi(w.x), c = bflo(w.y), d = bfhi(w.y), e = bflo(w.z), f = bfhi(w.z), g = bflo(w.w), h = bfhi(w.w);
    return ((a * a + b * b) + (c * c + d * d)) + ((e * e + f * f) + (g * g + h * h));
}
constexpr int MEM_PITCH = 272;
__device__ __forceinline__ void mem_item(const bf16_t* proj, const bf16_t* memkv  , bf16_t* ymem, const float* gqn, const float* gkn, const float* cconst, int item, LAS char* L, int tid) {
    asm volatile("" : "+v"(tid));
    const float cshift = cconst[3];
    const int qr = item & 3, hd = (item >> 2) & 3, b = item >> 4;
    const int lane = tid & 63, wave = tid >> 6, rr = lane & 31, hh = lane >> 5, blk = (lane >> 4) & 1, q4 = (lane & 15) >> 2, p4 = lane & 3;
    const bf16_t* kvb = memkv + (size_t)b * N_MEM * 1024 + hd * 128;
    LAS char* KI = L; LAS char* VI = L + 256 * MEM_PITCH;
#pragma unroll
    for (int q = 0; q < 8; ++q) {
        const int idx = tid + 512 * q, row = idx >> 4, pc = idx & 15;
        const u32x4 kw = *(const u32x4*)(kvb + (size_t)row * 1024 + 8 * pc), vw = *(const u32x4*)(kvb + (size_t)row * 1024 + 512 + 8 * pc);
        float ss = ssq8(kw);
        ss += __shfl_xor(ss, 1); ss += __shfl_xor(ss, 2); ss += __shfl_xor(ss, 4); ss += __shfl_xor(ss, 8);
        const float rs = rsqrtf(ss * (1.f / 128.f) + NORM_EPS);
        *(LAS bf16x8*)(KI + row * MEM_PITCH + 16 * pc) = scale8(kw, rs, gkn + 8 * pc);
        *(LAS u32x4*)(VI + row * MEM_PITCH + 16 * pc) = vw;
    }
    __syncthreads();
#pragma unroll 1
    for (int tq = 0; tq < 2; ++tq) {
        const int i = 512 * qr + 32 * (wave * 2 + tq) + rr;
        bf16x8 qf[8];
        { const bf16_t* p = proj + pofs(b * SEQ + i, MEMQ_OFF + hd * 128 + 64 * hh);
            u32x4 raw[8]; float ss = 0.f;
#pragma unroll
            for (int ks = 0; ks < 8; ++ks) { raw[ks] = *(const u32x4*)(p + 8 * ks); ss += ssq8(raw[ks]); }
            ss += __shfl_xor(ss, 32);
            const float rs = rsqrtf(ss * (1.f / 128.f) + NORM_EPS) * (0.08838834764831845f * LOG2E);
#pragma unroll
            for (int ks = 0; ks < 8; ++ks) qf[ks] = scale8(raw[ks], rs, gqn + 64 * hh + 8 * ks); }
        f32x16 o[4];
#pragma unroll
        for (int a = 0; a < 4; ++a)
#pragma unroll
            for (int e = 0; e < 16; ++e) o[a][e] = 0.f;
        float lrun = 0.f;
#pragma unroll 2
        for (int kt = 0; kt < 8; ++kt) {
            const int j0 = 32 * kt;
            f32x16 s;
#pragma unroll
            for (int e = 0; e < 16; ++e) s[e] = -cshift;
#pragma unroll
            for (int ks = 0; ks < 8; ++ks) { const bf16x8 kf = *(const LAS bf16x8*)(KI + (j0 + rr) * MEM_PITCH + (64 * hh + 8 * ks) * 2); s = MFMA32(kf, qf[ks], s); }
#pragma unroll
            for (int e = 0; e < 16; ++e) { const float p = __builtin_amdgcn_exp2f(s[e]); s[e] = p; lrun += p; }
            bf16x8 pf[2];
#pragma unroll
            for (int s2 = 0; s2 < 2; ++s2) pf[s2] = pack8(s[8 * s2], s[8 * s2 + 1], s[8 * s2 + 2], s[8 * s2 + 3], s[8 * s2 + 4], s[8 * s2 + 5], s[8 * s2 + 6], s[8 * s2 + 7]);
#pragma unroll
            for (int vt = 0; vt < 4; ++vt)
#pragma unroll
                for (int s2 = 0; s2 < 2; ++s2) {
                    LAS char* a = VI + (j0 + 16 * s2 + 4 * hh + q4) * MEM_PITCH + (32 * vt + 16 * blk + 4 * p4) * 2;
                    const bf16x8 vf = cat4(tr_read(a), tr_read(a + 8 * MEM_PITCH));
                    o[vt] = MFMA32(vf, pf[s2], o[vt]);
                }
        }
        const float inv = __builtin_amdgcn_rcpf(lrun + __shfl_xor(lrun, 32));
        bf16_t* op = ymem + ((size_t)b * SEQ + i) * 512 + hd * 128;
#pragma unroll
        for (int vt = 0; vt < 4; ++vt)
#pragma unroll
            for (int gq = 0; gq < 4; ++gq) { u32x2 w; w.x = pk2(o[vt][4 * gq] * inv, o[vt][4 * gq + 1] * inv); w.y = pk2(o[vt][4 * gq + 2] * inv, o[vt][4 * gq + 3] * inv);
                *(u32x2*)(op + 32 * vt + 8 * gq + 4 * hh) = w; }
    }
    __syncthreads();
}

#define XB_TMO      128
#define XB_XCNT(j)  (256  + 64 * (j))
#define XB_XSUB(j)  (1280 + 64 * (j))
#define XB_XGEN(j)  (2304 + 64 * (j))
#define XB_TOP      3328
#define XB_TOPGEN   3392
#define XCD_BAR_WORDS 3456
#define XB_SPIN_CAP (1u << 22)
__device__ __forceinline__ unsigned xb_ld(unsigned* p)              { return __hip_atomic_load(p, __ATOMIC_RELAXED, __HIP_MEMORY_SCOPE_AGENT); }
__device__ __forceinline__ unsigned xb_add(unsigned* p, unsigned v) { return __hip_atomic_fetch_add(p, v, __ATOMIC_RELAXED, __HIP_MEMORY_SCOPE_AGENT); }
__device__ __forceinline__ unsigned xb_xcc_id() { return (unsigned)__builtin_amdgcn_s_getreg((3 << 11) | 20) & 0xFu; }
#define XB_SPIN(cond, bar) do { unsigned _sp = 0; while (cond) { __builtin_amdgcn_s_sleep(1); \
    if ((++_sp & 255u) == 0u) { if (xb_ld(&(bar)[XB_TMO])) break; if (_sp > XB_SPIN_CAP) { atomicAdd(&(bar)[XB_TMO], 1u); break; } } } } while (0)
struct XcdBarrier { unsigned* bar; unsigned x; volatile LAS unsigned* st; };
__device__ __forceinline__ XcdBarrier xcd_barrier_post(unsigned* bar, volatile LAS unsigned* st) {
    XcdBarrier b; b.bar = bar; b.x = xb_xcc_id(); b.st = st;
    if (threadIdx.x == 0) (void)xb_add(&bar[XB_XCNT(b.x)], 1u);
    return b;
}
__device__ __forceinline__ void xcd_barrier_complete(unsigned* bar, unsigned x, unsigned& nloc, unsigned& nx) {
    const unsigned G = gridDim.x * gridDim.y * gridDim.z;
    unsigned sum, cnt, mine, sp = 0u;
    for (;;) {
        sum = 0u; cnt = 0u; mine = 0u;
#pragma unroll
        for (unsigned j = 0; j < 16; ++j) { const unsigned c = xb_ld(&bar[XB_XCNT(j)]); sum += c; cnt += (c > 0u) ? 1u : 0u; mine = (j == x) ? c : mine; }
        if (sum == G) break;
        __builtin_amdgcn_s_sleep(1);
        if ((++sp & 255u) == 0u) { if (xb_ld(&bar[XB_TMO])) break; if (sp > XB_SPIN_CAP) { atomicAdd(&bar[XB_TMO], 1u); break; } }
    }
    nloc = mine > 0u ? mine : 1u; nx = cnt > 0u ? cnt : 1u;
}
__device__ __forceinline__ void xcd_barrier(const XcdBarrier& b) {
    asm volatile("s_waitcnt vmcnt(0)" ::: "memory");
    __syncthreads();
    if (threadIdx.x == 0) {
        unsigned* bar = b.bar;
        __builtin_amdgcn_s_waitcnt(0);
        unsigned nloc = b.st[0], nx = b.st[1];
        if (nloc == 0u) { xcd_barrier_complete(bar, b.x, nloc, nx); b.st[0] = nloc; b.st[1] = nx; }
        const unsigned old = xb_add(&bar[XB_XSUB(b.x)], 1u);
        const unsigned gen = old / nloc;
        if (old + 1u == (gen + 1u) * nloc) {
            __builtin_amdgcn_fence(__ATOMIC_RELEASE, "agent");
            asm volatile("s_waitcnt vmcnt(0)" ::: "memory");
            const unsigned og = xb_add(&bar[XB_TOP], 1u);
            const unsigned tg = og / nx;
            if (og + 1u == (tg + 1u) * nx) xb_add(&bar[XB_TOPGEN], 1u);
            else XB_SPIN(xb_ld(&bar[XB_TOPGEN]) == tg, bar);
            __builtin_amdgcn_fence(__ATOMIC_ACQUIRE, "agent");
            xb_add(&bar[XB_XGEN(b.x)], 1u);
            asm volatile("s_waitcnt vmcnt(0)" ::: "memory");
        } else {
            XB_SPIN(xb_ld(&bar[XB_XGEN(b.x)]) == gen, bar);
            __builtin_amdgcn_fence(__ATOMIC_ACQUIRE, "agent");
            asm volatile("s_waitcnt vmcnt(0)" ::: "memory");
        }
    }
    __syncthreads();
}

struct Args { const float* in[21]; float* out; unsigned char* ws; int ph_lo, ph_hi; };

__global__ void __launch_bounds__(512, 2) mk_fwd(Args args) {
    extern __shared__ __attribute__((aligned(16))) unsigned char lds_raw[];
    LAS unsigned char* lds = (LAS unsigned char*)lds_raw;
    cg::grid_group grid = cg::this_grid();
    const int tid = threadIdx.x, lane = tid & 63, wave = __builtin_amdgcn_readfirstlane(tid >> 6);
    const int G = gridDim.x, bx = blockIdx.x;
    const int gw = bx * 8 + wave, NGW = G * 8;
    const int NGT = G * 512;
    unsigned char* ws = args.ws;
    const int lo = args.ph_lo, hi = args.ph_hi;
    volatile LAS unsigned* xst = (volatile LAS unsigned*)(lds + LDS_BYTES - 64);
    if (tid < 2) xst[tid] = 0u;
    __syncthreads();
    XcdBarrier xbar; xbar.bar = (unsigned*)(ws + WS_CTL); xbar.x = 0; xbar.st = xst;
    if (!MK_MULTI_LAUNCH) xbar = xcd_barrier_post((unsigned*)(ws + WS_CTL), xst);
#ifndef PH_EN
#define PH_EN 0x3ff
#endif
#ifndef PROBE_REP
#define PROBE_REP 0
#endif
#define REP(b) for (int rep_ = 0; rep_ < 1 + (((PROBE_REP) >> (b)) & 1); ++rep_)
#define IN(k) (lo <= (k) && (k) < hi)
#define EN(b) (((PH_EN) >> (b)) & 1)
#define SEAM(k) do { if (IN(k) && IN((k) + 1)) { if ((k) == 0 || MK_MULTI_LAUNCH) grid.sync(); else xcd_barrier(xbar); } } while (0)

#define WinT ((bf16_t*)(ws_ + WS_WIN))
#define WkvT ((bf16_t*)(ws_ + WS_WKV))
#define WbrT ((bf16_t*)(ws_ + WS_WBR))
#define WoutT ((bf16_t*)(ws_ + WS_WOUT))
#define WfiT ((bf16_t*)(ws_ + WS_WFI))
#define WfoT ((bf16_t*)(ws_ + WS_WFO))
#define MEMKV ((bf16_t*)(ws_ + WS_MEMKV))
#define XB ((bf16_t*)(ws_ + WS_XB))
#define MEMB ((bf16_t*)(ws_ + WS_MEMB))
#define ODIL ((bf16_t*)(ws_ + WS_ODIL))
#define LSE ((float*)(ws_ + WS_LSE))
#define MERGED ((bf16_t*)(ws_ + WS_MERGED))
#define A2 ((bf16_t*)(ws_ + WS_A2))
#define Y3 ((bf16_t*)(ws_ + WS_Y3))
#define SSQ ((float*)(ws_ + WS_SSQ))
#define PROJ ((bf16_t*)(ws_ + WS_PROJ))
#define YF ((bf16_t*)(ws_ + WS_YF))
#define HALO ((bf16_t*)(ws_ + WS_HALO))
#define CCONST ((float*)(ws_ + WS_CTL + 15360))
#define PHASE_LOCALS const Args* ap = &args; size_t zoff_ = 0; asm volatile("" : "+s"(zoff_)); unsigned char* ws_ = ws + zoff_;     int bxl = bx; asm volatile("" : "+s"(bxl)); int tidl = threadIdx.x; asm volatile("" : "+v"(tidl)); const int gtidl = bxl * 512 + tidl; (void)bxl; (void)ws_; (void)ap; (void)gtidl;
    if (EN(0) && IN(0)) REP(0) {
            PHASE_LOCALS
        LAS float* scr = (LAS float*)(lds + wave * 16384);
        constexpr int I_IN = 16 * 304, I_KV = 16 * 32, I_BR = 8 * 32, I_OUT = 16 * 32, I_FI = 16 * 176, I_FO = 44 * 32;
        constexpr int NITEMS = I_IN + I_KV + 3 * I_BR + I_OUT + I_FI + I_FO;
        for (int it = gw; it < NITEMS; it += NGW) {
            int r = it;
            if (r < I_IN) { p0_transpose_item<0>(ap->in[3], 1024, IN_COLS, WinT, 0, scr, r, lane); continue; } r -= I_IN;
            if (r < I_KV) { p0_transpose_item<0>(ap->in[9], 1024, 1024, WkvT, 0, scr, r, lane); continue; } r -= I_KV;
            if (r < I_BR) { p0_transpose_item<0>(ap->in[12], 512, 1024, WbrT, 0, scr, r, lane); continue; } r -= I_BR;
            if (r < I_BR) { p0_transpose_item<0>(ap->in[13], 512, 1024, WbrT, 1024, scr, r, lane); continue; } r -= I_BR;
            if (r < I_BR) { p0_transpose_item<0>(ap->in[14], 512, 1024, WbrT, 2048, scr, r, lane); continue; } r -= I_BR;
            if (r < I_OUT) { p0_transpose_item<0>(ap->in[15], 1024, 1024, WoutT, 0, scr, r, lane); continue; } r -= I_OUT;
            if (r < I_FI) { p0_transpose_item<1>(ap->in[17], 1024, FF2, WfiT, 0, scr, r, lane); continue; } r -= I_FI;
            p0_transpose_item<0>(ap->in[20], D_FF, 1024, WfoT, 0, scr, r, lane);
        }
        for (int i = bx * 512 + tid; i < BATCH * SEQ; i += NGT) SSQ[i] = 0.f;
        if (gw == 0) {
            float cv = 0.f;
            for (int g = 0; g < 3; ++g) { float a = fabsf(args.in[4][g * 64 + lane]), b = fabsf(args.in[5][g * 64 + lane]);
#pragma unroll
                for (int o = 1; o < 64; o <<= 1) { a = fmaxf(a, __shfl_xor(a, o)); b = fmaxf(b, __shfl_xor(b, o)); }
                if (lane == g) cv = 8.f * a * b * LOG2E; }
            { float a = fmaxf(fabsf(args.in[10][lane]), fabsf(args.in[10][64 + lane])), b = fmaxf(fabsf(args.in[11][lane]), fabsf(args.in[11][64 + lane]));
#pragma unroll
                for (int o = 1; o < 64; o <<= 1) { a = fmaxf(a, __shfl_xor(a, o)); b = fmaxf(b, __shfl_xor(b, o)); }
                if (lane == 3) cv = 11.313708499f * a * b * LOG2E; }
            if (lane < 4) CCONST[lane] = cv;
        }
        for (int m = gw; m < BATCH * SEQ; m += 2 * NGW) rms_row2_to_bf16(ap->in[0] + (size_t)m * 1024, ap->in[0] + (size_t)(m + NGW) * 1024, ap->in[2], XB + (size_t)m * 1024, XB + (size_t)(m + NGW) * 1024, lane);
        for (int m = gw; m < BATCH * N_MEM; m += NGW) rms_row_to_bf16(ap->in[1] + (size_t)m * 1024, ap->in[8], MEMB + (size_t)m * 1024, lane);
        __syncthreads();
    }
    SEAM(0);
    if (EN(1) && IN(1)) REP(1) {
            PHASE_LOCALS
        pg8::Gemm g{MEMB, WkvT, BATCH * N_MEM, 1024, 1024}; pg8::StaticOrder S; S.init(g.M, g.N, G, bxl);
        EpiPlainBf16 E{MEMKV, 1024};
        pg8::gemm_phase(lds, g, S, E);
    }
    SEAM(1);
    for (int hf = 0; hf < 2; ++hf) {
        const int P = 2 + 4 * hf;
        if (EN(2) && IN(P + 0)) REP(2) {
            PHASE_LOCALS
            pg8::Gemm g{XB + (size_t)hf * HTOK * 1024, WinT, HTOK, IN_COLS, 1024}; pg8::StaticOrder S; S.init(g.M, g.N, G, bxl);
            EpiProj E{PROJ, ap->in[4], ap->in[5]};
            pg8::gemm_phase(lds, g, S, E);
        }
        SEAM(P + 0);
        if (EN(3) && IN(P + 1)) REP(3) {
            PHASE_LOCALS
            LAS char* vl = (LAS char*)(lds + wave * 8192);
#ifndef ATT_EN
#define ATT_EN 7
#endif
            if (ATT_EN & 1) for (int it = bxl; it < HB * 4 * 16; it += G) ret_u_item(PROJ, XB + (size_t)hf * HTOK * 1024, ap->in[6], it, (LAS char*)lds, tid);
            if (ATT_EN & 2) REP(10) for (int it = gw; it < HB * 8 * 3 * 32; it += NGW) dil_wave(PROJ, ODIL, LSE, CCONST, it, vl, lane);
            __syncthreads();
            if (ATT_EN & 4) REP(11) for (int it = bxl; it < HB * 4 * 4; it += G) mem_item(PROJ, MEMKV + (size_t)hf * HB * N_MEM * 1024, Y3 + (size_t)2 * HTOK * 512, args.in[10], args.in[11], CCONST, it, (LAS char*)lds, tid);
            __syncthreads();
        }
        SEAM(P + 1);
        if (EN(4) && IN(P + 2)) REP(4) {
            PHASE_LOCALS
            for (int it = bxl; it < HB * 4 * 8; it += G) ret_chunk_item(PROJ, XB + (size_t)hf * HTOK * 1024, Y3 + (size_t)1 * HTOK * 512, ap->in[6], ap->in[7], it, (LAS char*)lds, tid);
            for (int idx = gtidl; idx < HTOK * 64; idx += NGT) {
                const int dp = idx & 7, h = (idx >> 3) & 7, tok = idx >> 6;
                const float l0 = LSE[((size_t)0 * HTOK + tok) * 8 + h], l1 = LSE[((size_t)1 * HTOK + tok) * 8 + h], l2 = LSE[((size_t)2 * HTOK + tok) * 8 + h];
                const float mx = fmaxf(l0, fmaxf(l1, l2));
                float w0 = exp2f(l0 - mx), w1 = exp2f(l1 - mx), w2 = exp2f(l2 - mx); const float inv = 1.f / (w0 + w1 + w2); w0 *= inv; w1 *= inv; w2 *= inv;
                const size_t off = (size_t)tok * 512 + h * 64 + dp * 8;
                const u32x4 a = *(const u32x4*)(ODIL + off), b = *(const u32x4*)(ODIL + (size_t)HTOK * 512 + off), c = *(const u32x4*)(ODIL + (size_t)2 * HTOK * 512 + off);
                u32x4 o;
                o.x = pk2(w0 * bflo(a.x) + w1 * bflo(b.x) + w2 * bflo(c.x), w0 * bfhi(a.x) + w1 * bfhi(b.x) + w2 * bfhi(c.x));
                o.y = pk2(w0 * bflo(a.y) + w1 * bflo(b.y) + w2 * bflo(c.y), w0 * bfhi(a.y) + w1 * bfhi(b.y) + w2 * bfhi(c.y));
                o.z = pk2(w0 * bflo(a.z) + w1 * bflo(b.z) + w2 * bflo(c.z), w0 * bfhi(a.z) + w1 * bfhi(b.z) + w2 * bfhi(c.z));
                o.w = pk2(w0 * bflo(a.w) + w1 * bflo(b.w) + w2 * bflo(c.w), w0 * bfhi(a.w) + w1 * bfhi(b.w) + w2 * bfhi(c.w));
                *(u32x4*)(Y3 + off) = o;
            }
        }
        SEAM(P + 2);
        if (EN(5) && IN(P + 3)) REP(5) {
            PHASE_LOCALS
            pg8::Gemm g{Y3, WbrT, 3 * HTOK, 3 * 1024, 512}; pg8::BranchOrder S; S.init(HTOK, 1024, G, bxl);
            EpiBranch E{MERGED + (size_t)hf * HTOK * 1024, PROJ};
            pg8::gemm_phase(lds, g, S, E);
        }
        SEAM(P + 3);
    }
    {
        constexpr int P = 6, NTOK = BATCH * SEQ;
        if (EN(6) && IN(P + 4)) REP(6) {
            PHASE_LOCALS
            pg8::Gemm g{MERGED, WoutT, NTOK, 1024, 1024}; pg8::StaticOrder S; S.init(g.M, g.N, G, bxl);
            EpiOut E{ap->in[0], ap->out, A2, ap->in[16], SSQ};
            pg8::gemm_phase(lds, g, S, E);
        }
        SEAM(P + 4);
        if (EN(7) && IN(P + 5)) REP(7) {
            PHASE_LOCALS
            pg8::Gemm g{A2, WfiT, NTOK, FF2, 1024}; pg8::StaticOrder S; S.init(g.M, g.N, G, bxl);
            EpiFfnInConv E{YF, HALO, SSQ, ap->in[18], ap->in[19]};
            pg8::gemm_phase(lds, g, S, E);
        }
        SEAM(P + 5);
        if (EN(8) && IN(P + 6)) REP(8) {
            PHASE_LOCALS
            const float* cw = ap->in[18]; const float* cb = ap->in[19];
            for (int idx = gtidl; idx < (NTOK / 64) * 2 * 352; idx += NGT) {
                const int cgp = idx % 352, rest = idx / 352, side = rest & 1, blk = rest >> 1, ch = cgp * 8;
                const int row = blk * 64 + (side ? 63 : 0), t = row & (SEQ - 1);
                const bf16_t* hb = HALO + (size_t)blk * 6 * D_FF + ch;
                u32x4 um = {0u, 0u, 0u, 0u}, un = {0u, 0u, 0u, 0u}, uc, gt;
                if (side == 0) { uc = *(const u32x4*)hb; un = *(const u32x4*)(hb + D_FF); gt = *(const u32x4*)(hb + 4 * D_FF); if (t > 0) um = *(const u32x4*)(hb - 6 * D_FF + 3 * D_FF); }
                else { um = *(const u32x4*)(hb + 2 * D_FF); uc = *(const u32x4*)(hb + 3 * D_FF); gt = *(const u32x4*)(hb + 5 * D_FF); if (t < SEQ - 1) un = *(const u32x4*)(hb + 6 * D_FF); }
                float uu[3][8], gg[8];
                const unsigned umw[4] = {um.x, um.y, um.z, um.w}, ucw[4] = {uc.x, uc.y, uc.z, uc.w}, unw[4] = {un.x, un.y, un.z, un.w}, gtw[4] = {gt.x, gt.y, gt.z, gt.w};
#pragma unroll
                for (int q = 0; q < 4; ++q) { uu[0][2 * q] = bflo(umw[q]); uu[0][2 * q + 1] = bfhi(umw[q]); uu[1][2 * q] = bflo(ucw[q]); uu[1][2 * q + 1] = bfhi(ucw[q]);
                    uu[2][2 * q] = bflo(unw[q]); uu[2][2 * q + 1] = bfhi(unw[q]); gg[2 * q] = bflo(gtw[q]); gg[2 * q + 1] = bfhi(gtw[q]); }
                float yv[8];
#pragma unroll
                for (int q2 = 0; q2 < 2; ++q2) {
                    const f32x4 w0 = *(const f32x4*)(cw + ch + 4 * q2), w1 = *(const f32x4*)(cw + D_FF + ch + 4 * q2), w2 = *(const f32x4*)(cw + 2 * D_FF + ch + 4 * q2), bb = *(const f32x4*)(cb + ch + 4 * q2);
#pragma unroll
                    for (int e = 0; e < 4; ++e) { const int k = 4 * q2 + e; const float c = bb[e] + uu[0][k] * w0[e] + uu[1][k] * w1[e] + uu[2][k] * w2[e];
                        yv[k] = gelu_exact(c) * gg[k]; }
                }
                u32x4 o; o.x = pk2(yv[0], yv[1]); o.y = pk2(yv[2], yv[3]); o.z = pk2(yv[4], yv[5]); o.w = pk2(yv[6], yv[7]);
                *(u32x4*)(YF + (size_t)row * D_FF + ch) = o;
            }
        }
        SEAM(P + 6);
        if (EN(9) && IN(P + 7)) REP(9) {
            PHASE_LOCALS
            pg8::Gemm g{YF, WfoT, NTOK, 1024, D_FF}; pg8::StaticOrder S; S.init(g.M, g.N, G, bxl);
            EpiFfnOut E{ap->out};
            pg8::gemm_phase(lds, g, S, E);
        }
    }
#undef IN
#undef SEAM
}

extern "C" void kernel_launch(void* const* d_in, const int* in_sizes, int n_in, void* d_out, int out_size, void* d_ws, size_t ws_size, hipStream_t stream) {
    static int grid = 0;
    if (grid == 0) {
        if (n_in != 21 || out_size != BATCH * SEQ * D_MODEL || ws_size < WS_END) { fprintf(stderr, "kernel_launch: unexpected shapes (n_in %d out %d ws %zu)\n", n_in, out_size, ws_size); grid = -1; return; }
        int dev = 0, cus = 0, per_cu = 0;
        hipGetDevice(&dev); hipDeviceGetAttribute(&cus, hipDeviceAttributeMultiprocessorCount, dev);
        if (hipFuncSetAttribute((const void*)mk_fwd, hipFuncAttributeMaxDynamicSharedMemorySize, LDS_BYTES) != hipSuccess) { fprintf(stderr, "kernel_launch: hipFuncSetAttribute failed\n"); grid = -1; return; }
        if (hipOccupancyMaxActiveBlocksPerMultiprocessor(&per_cu, (const void*)mk_fwd, 512, LDS_BYTES) != hipSuccess || per_cu < 1) { fprintf(stderr, "kernel_launch: occupancy query says %d\n", per_cu); per_cu = 1; }
        (void)hipGetLastError();
        grid = cus * per_cu;
    }
    if (grid < 0) return;
    Args a{};
    for (int i = 0; i < 21; ++i) a.in[i] = (const float*)d_in[i];
    a.out = (float*)d_out; a.ws = (unsigned char*)d_ws;
#if MK_MULTI_LAUNCH
    for (int ph = 0; ph < NPHASE; ++ph) {
        a.ph_lo = ph; a.ph_hi = ph + 1;
        hipLaunchKernelGGL(mk_fwd, dim3(grid), dim3(512), LDS_BYTES, stream, a);
    }
#else
    a.ph_lo = 0; a.ph_hi = NPHASE;
    if (hipMemsetAsync((char*)d_ws + WS_CTL, 0, CTL_BYTES, stream) != hipSuccess) { fprintf(stderr, "kernel_launch: memset of the barrier words failed\n"); return; }
    void* kargs[] = {&a};
    hipError_t e = hipLaunchCooperativeKernel((const void*)mk_fwd, dim3(grid), dim3(512), kargs, LDS_BYTES, stream);
    if (e != hipSuccess) fprintf(stderr, "kernel_launch: cooperative launch failed: %s (grid %d)\n", hipGetErrorString(e), grid);
#endif
}
```

```cpp
#include <hip/hip_runtime.h>
#include <hip/hip_cooperative_groups.h>
#include <cstdio>
namespace cg = cooperative_groups;

#ifndef MK_MULTI_LAUNCH
#define MK_MULTI_LAUNCH 0
#endif

#define LAS __attribute__((address_space(3)))
typedef unsigned short bf16_t;
typedef short bf16x8 __attribute__((ext_vector_type(8)));
typedef short s16x4 __attribute__((ext_vector_type(4)));
typedef float f32x2 __attribute__((ext_vector_type(2)));
typedef float f32x4 __attribute__((ext_vector_type(4)));
typedef float f32x16 __attribute__((ext_vector_type(16)));
typedef unsigned u32x2 __attribute__((ext_vector_type(2)));
typedef unsigned u32x4 __attribute__((ext_vector_type(4)));
typedef __bf16 bf16x2_t __attribute__((ext_vector_type(2)));

constexpr int D_MODEL = 1024, BATCH = 32, SEQ = 2048, N_MEM = 256;
constexpr int HB = 16, HTOK = HB * SEQ;
constexpr int IN_COLS = 9728, RET_OFF = 4608, MEMQ_OFF = 6144, GATE_OFF = 6656;
constexpr int D_FF = 2816, FF2 = 5632;
constexpr float NORM_EPS = 1e-6f;
constexpr float LOG2E = 1.4426950408889634f;
constexpr int NPHASE = 14;

constexpr size_t MiB = 1u << 20;
constexpr size_t WS_WIN = 0;
constexpr size_t WS_WKV = 19 * MiB;
constexpr size_t WS_WBR = 21 * MiB;
constexpr size_t WS_WOUT = 24 * MiB;
constexpr size_t WS_WFI = 26 * MiB;
constexpr size_t WS_WFO = 37 * MiB;
constexpr size_t WS_MEMKV = 43 * MiB;
constexpr size_t WS_XB = 60 * MiB;
constexpr size_t WS_R1 = 188 * MiB;
constexpr size_t WS_MEMB = WS_R1;
constexpr size_t WS_ODIL = WS_R1;
constexpr size_t WS_LSE = WS_R1 + 96 * MiB;
constexpr size_t WS_MERGED = WS_XB;
constexpr size_t WS_A2 = 412 * MiB;
constexpr size_t WS_Y3 = 316 * MiB;
constexpr size_t WS_SSQ = WS_R1 + 100 * MiB;
constexpr size_t WS_HALO = WS_Y3 + 4 * MiB;
constexpr size_t WS_PROJ = 412 * MiB;
constexpr size_t WS_UG = WS_PROJ;
constexpr size_t WS_YF = WS_PROJ + 128 * MiB;
constexpr size_t WS_CTL = 1020 * MiB;
constexpr size_t CTL_BYTES = 16384;
constexpr size_t WS_END = WS_CTL + CTL_BYTES;

constexpr int LDS_BYTES = 147456;

__device__ __forceinline__ unsigned pk2(float a, float b) { f32x2 f = {a, b}; bf16x2_t r = __builtin_convertvector(f, bf16x2_t); return __builtin_bit_cast(unsigned, r); }
__device__ __forceinline__ float bflo(unsigned w) { return __uint_as_float(w << 16); }
__device__ __forceinline__ float bfhi(unsigned w) { return __uint_as_float(w & 0xffff0000u); }
__device__ __forceinline__ float wave_sum(float v) {
#pragma unroll
    for (int o = 1; o < 64; o <<= 1) v += __shfl_xor(v, o);
    return v;
}
__device__ __forceinline__ bf16x8 pack8(float a0, float a1, float a2, float a3, float a4, float a5, float a6, float a7) {
    u32x4 p; p.x = pk2(a0, a1); p.y = pk2(a2, a3); p.z = pk2(a4, a5); p.w = pk2(a6, a7); return __builtin_bit_cast(bf16x8, p);
}
#define MFMA32(a, b, c) __builtin_amdgcn_mfma_f32_32x32x16_bf16((a), (b), (c), 0, 0, 0)
__device__ __forceinline__ s16x4 tr_read(LAS char* p) { return __builtin_amdgcn_ds_read_tr16_b64_v4i16((LAS s16x4*)p); }
__device__ __forceinline__ bf16x8 cat4(s16x4 lo, s16x4 hi) { return __builtin_shufflevector(lo, hi, 0, 1, 2, 3, 4, 5, 6, 7); }
__device__ __forceinline__ int slot_of(int c) { return 128 * ((c >> 5) & 1) + 32 * (c >> 6) + 16 * ((c >> 2) & 1) + 4 * ((c >> 3) & 3) + (c & 3); }

namespace pg8 {
constexpr int BM = 256, BK = 64, HALF = 128, HTB = HALF * BK * 2, NXCD = 8, WGM = 8;
__device__ __forceinline__ int lds_byte(int r, int c) { const int st = (r >> 4) * 2 + (c >> 5), rr = r & 15, cc = c & 31, ob = rr * 64 + cc * 2; return st * 1024 + (ob ^ (((ob >> 9) & 1) << 5)); }
__device__ __forceinline__ void stage_rc(int b, int& R, int& C) { const int st = b / 1024, sb = b % 1024, swz = sb ^ (((sb >> 9) & 1) << 5); R = (st >> 1) * 16 + swz / 64; C = (st & 1) * 32 + (swz % 64) / 2; }
struct Unit { int pm, pn; };
struct Gemm { const bf16_t* A; const bf16_t* Bt; int M, N, K; };
struct StaticOrder {
    int nM, nN, nwg, G, c;
    __device__ void init(int M, int N, int G_, int c_) { nM = M / BM; nN = N / BM; nwg = nM * nN; G = G_; c = c_; }
    __device__ bool next(int i, Unit& u) const {
        const long L = (long)i * G + c; if (L >= nwg) return false;
        int wgid = (int)L; { const int q = nwg / NXCD, r = nwg % NXCD, xcd = wgid % NXCD, off = wgid / NXCD; wgid = (xcd < r ? xcd * (q + 1) : r * (q + 1) + (xcd - r) * q) + off; }
        const int nig = WGM * nN, gid = wgid / nig, fm = gid * WGM, gsz = (nM - fm) < WGM ? (nM - fm) : WGM;
        u.pm = fm + ((wgid % nig) % gsz); u.pn = (wgid % nig) / gsz; return true;
    }
};
struct BranchOrder {
    StaticOrder so;
    __device__ void init(int M, int N, int G_, int c_) { so.init(M, N, G_, c_); }
    __device__ bool next(int i, Unit& u) const { Unit t; if (!so.next(i / 3, t)) return false; const int b = i % 3; u.pm = b * (HTOK / BM) + t.pm; u.pn = b * (D_MODEL / BM) + t.pn; return true; }
};

template <class Epi, class Sched>
__device__ __forceinline__ void gemm_phase(LAS unsigned char* lds, const Gemm g, const Sched& S, const Epi& E) {
    int tid = threadIdx.x; asm volatile("" : "+v"(tid));
    const int wid = __builtin_amdgcn_readfirstlane(tid >> 6), lane = tid & 63, wr = wid >> 2, wc = wid & 3, fr = lane & 15, fq = lane >> 4;
    const int K = g.K, nt = K / BK;
    unsigned voffA[2];
#pragma unroll
    for (int i = 0; i < 2; ++i) { int R, C; stage_rc(tid * 16 + i * 8192, R, C); voffA[i] = (unsigned)(R * K + C) * 2u; }
    const size_t kstep = (size_t)(BK * 2);
    const size_t hstep = (size_t)HALF * K * 2;
    const size_t tstep = 2 * hstep;
    const unsigned ldsw = (unsigned)wid * 1024u;
    const int aoff = lds_byte(wr * 64 + fr, fq * 8), boff = lds_byte(wc * 32 + fr, fq * 8);
#define PG8_SA(b, h) (((b) * 2 + (h)) * HTB)
#define PG8_SB(b, h) ((4 + (b) * 2 + (h)) * HTB)
#define PG8_STAGE(bufoff, gbase) do { _Pragma("unroll") for (int _i = 0; _i < 2; ++_i) \
        __builtin_amdgcn_global_load_lds((const unsigned*)((const char*)(gbase) + voffA[_i]), (LAS unsigned*)(lds + (bufoff) + ldsw + _i * 8192), 16, 0, 0); } while (0)
#define PG8_LDA(dst, b, h) do { _Pragma("unroll") for (int m = 0; m < 4; ++m) _Pragma("unroll") for (int k = 0; k < 2; ++k) dst[m][k] = *(const LAS bf16x8*)(lds + PG8_SA(b, h) + aoff + m * 2048 + k * 1024); } while (0)
#define PG8_LDB(dst, b, h) do { _Pragma("unroll") for (int n = 0; n < 2; ++n) _Pragma("unroll") for (int k = 0; k < 2; ++k) dst[n][k] = *(const LAS bf16x8*)(lds + PG8_SB(b, h) + boff + n * 2048 + k * 1024); } while (0)
#define PG8_MMA(ai, bj, At, Bt) do { __builtin_amdgcn_s_setprio(1); _Pragma("unroll") for (int m = 0; m < 4; ++m) _Pragma("unroll") for (int n = 0; n < 2; ++n) _Pragma("unroll") for (int k = 0; k < 2; ++k) \
        acc[ai][bj][m][n] = __builtin_amdgcn_mfma_f32_16x16x32_bf16(Bt[n][k], At[m][k], acc[ai][bj][m][n], 0, 0, 0); __builtin_amdgcn_s_setprio(0); } while (0)
#define PG8_WAIT_V(n) asm volatile("s_waitcnt vmcnt(" #n ")" ::: "memory")
#define PG8_WAIT_L(n) asm volatile("s_waitcnt lgkmcnt(" #n ")" ::: "memory")
#define PG8_BAR __builtin_amdgcn_s_barrier()
#define PG8_SCHED __builtin_amdgcn_sched_barrier(0)
    Unit cur, nxt; int ui = 0;
    if (!S.next(0, cur)) return;
    f32x4 acc[2][2][4][2];
#pragma unroll
    for (int a = 0; a < 2; ++a)
#pragma unroll
        for (int b = 0; b < 2; ++b)
#pragma unroll
            for (int m = 0; m < 4; ++m)
#pragma unroll
                for (int n = 0; n < 2; ++n) acc[a][b][m][n] = (f32x4){0.f, 0.f, 0.f, 0.f};
    bf16x8 At[4][2], B0[2][2], B1[2][2];
    const char* cA = (const char*)g.A + (size_t)cur.pm * tstep; const char* cB = (const char*)g.Bt + (size_t)cur.pn * tstep;
    PG8_STAGE(PG8_SB(0, 0), cB); PG8_STAGE(PG8_SA(0, 0), cA); PG8_STAGE(PG8_SB(0, 1), cB + hstep); PG8_STAGE(PG8_SA(0, 1), cA + hstep);
    if (wr == 1) PG8_BAR;
    PG8_WAIT_V(4); PG8_BAR;
    PG8_STAGE(PG8_SB(1, 0), cB + kstep); PG8_STAGE(PG8_SA(1, 0), cA + kstep); PG8_STAGE(PG8_SB(1, 1), cB + hstep + kstep);
    PG8_WAIT_V(6); PG8_BAR;
    for (;;) {
        const bool has_next = S.next(ui + 1, nxt);
        const char* nA = has_next ? (const char*)g.A + (size_t)nxt.pm * tstep : cA; const char* nB = has_next ? (const char*)g.Bt + (size_t)nxt.pn * tstep : cB;
        for (int t = 0; t < nt; t += 2) {
            const bool last = (t == nt - 2);
            const char* a1 = cA + (size_t)(t + 1) * kstep;
            const char* a2 = last ? nA : cA + (size_t)(t + 2) * kstep; const char* b2 = last ? nB : cB + (size_t)(t + 2) * kstep;
            const char* a3 = a2 + kstep; const char* b3 = b2 + kstep;
            PG8_LDB(B0, 0, 0); PG8_SCHED; PG8_LDA(At, 0, 0); PG8_STAGE(PG8_SA(1, 1), a1 + hstep);
            PG8_WAIT_L(8); PG8_BAR; PG8_WAIT_L(0); PG8_MMA(0, 0, At, B0); PG8_BAR; PG8_SCHED;
            PG8_LDB(B1, 0, 1); PG8_STAGE(PG8_SB(0, 0), b2);
            PG8_BAR; PG8_WAIT_L(0); PG8_MMA(0, 1, At, B1); PG8_BAR;
            PG8_LDA(At, 0, 1); PG8_STAGE(PG8_SA(0, 0), a2);
            PG8_BAR; PG8_WAIT_L(0); PG8_MMA(1, 0, At, B0); PG8_BAR; PG8_SCHED;
            PG8_STAGE(PG8_SB(0, 1), b2 + hstep);
            PG8_WAIT_V(6); PG8_BAR; PG8_MMA(1, 1, At, B1); PG8_BAR;
            PG8_LDB(B0, 1, 0); PG8_SCHED; PG8_LDA(At, 1, 0); PG8_STAGE(PG8_SA(0, 1), a2 + hstep);
            PG8_WAIT_L(8); PG8_BAR; PG8_WAIT_L(0); PG8_MMA(0, 0, At, B0); PG8_BAR; PG8_SCHED;
            PG8_LDB(B1, 1, 1); PG8_STAGE(PG8_SB(1, 0), b3);
            PG8_BAR; PG8_WAIT_L(0); PG8_MMA(0, 1, At, B1); PG8_BAR;
            PG8_LDA(At, 1, 1); PG8_STAGE(PG8_SA(1, 0), a3);
            PG8_BAR; PG8_WAIT_L(0); PG8_MMA(1, 0, At, B0); PG8_BAR; PG8_SCHED;
            PG8_STAGE(PG8_SB(1, 1), b3 + hstep);
            PG8_WAIT_V(6); PG8_BAR; PG8_MMA(1, 1, At, B1); PG8_BAR;
        }
        E(acc, cur, wr, wc, fr, fq);
        if (!has_next) break;
#pragma unroll
        for (int a = 0; a < 2; ++a)
#pragma unroll
            for (int b = 0; b < 2; ++b)
#pragma unroll
                for (int m = 0; m < 4; ++m)
#pragma unroll
                    for (int n = 0; n < 2; ++n) acc[a][b][m][n] = (f32x4){0.f, 0.f, 0.f, 0.f};
        cur = nxt; cA = nA; cB = nB; ++ui;
    }
    PG8_WAIT_V(0);
    if (wr == 0) PG8_BAR;
    PG8_BAR;
#undef PG8_SA
#undef PG8_SB
#undef PG8_STAGE
#undef PG8_LDA
#undef PG8_LDB
#undef PG8_MMA
#undef PG8_WAIT_V
#undef PG8_WAIT_L
#undef PG8_BAR
#undef PG8_SCHED
}
}
using pg8::Unit;

#define EPI_ROWS_BEGIN _Pragma("unroll") for (int ai = 0; ai < 2; ++ai) _Pragma("unroll") for (int m = 0; m < 4; ++m) { const int rloc = ai * 128 + wr * 64 + m * 16 + fr; float v[16]; \
    _Pragma("unroll") for (int bj = 0; bj < 2; ++bj) _Pragma("unroll") for (int n = 0; n < 2; ++n) _Pragma("unroll") for (int j = 0; j < 4; ++j) v[8 * bj + 4 * n + j] = acc[ai][bj][m][n][j];
#define EPI_ROWS_END }
__device__ __forceinline__ void store16_bf16(bf16_t* p, const float (&v)[16]) {
    u32x4 a, b; a.x = pk2(v[0], v[1]); a.y = pk2(v[2], v[3]); a.z = pk2(v[4], v[5]); a.w = pk2(v[6], v[7]);
    b.x = pk2(v[8], v[9]); b.y = pk2(v[10], v[11]); b.z = pk2(v[12], v[13]); b.w = pk2(v[14], v[15]);
    *(u32x4*)p = a; *(u32x4*)(p + 32) = b;
}
__device__ __forceinline__ void load16_bf16(const bf16_t* p, float (&v)[16]) {
    const u32x4 a = *(const u32x4*)p, b = *(const u32x4*)(p + 32);
    v[0] = bflo(a.x); v[1] = bfhi(a.x); v[2] = bflo(a.y); v[3] = bfhi(a.y); v[4] = bflo(a.z); v[5] = bfhi(a.z); v[6] = bflo(a.w); v[7] = bfhi(a.w);
    v[8] = bflo(b.x); v[9] = bfhi(b.x); v[10] = bflo(b.y); v[11] = bfhi(b.y); v[12] = bflo(b.z); v[13] = bfhi(b.z); v[14] = bflo(b.w); v[15] = bfhi(b.w);
}
__device__ __forceinline__ void load16_f32(const float* p, float (&v)[16]) {
#pragma unroll
    for (int q = 0; q < 4; ++q) { const f32x4 t = *(const f32x4*)(p + 4 * (q & 1) + 32 * (q >> 1)); v[4 * q] = t.x; v[4 * q + 1] = t.y; v[4 * q + 2] = t.z; v[4 * q + 3] = t.w; }
}
__device__ __forceinline__ void store16_f32(float* p, const float (&v)[16]) {
#pragma unroll
    for (int q = 0; q < 4; ++q) *(f32x4*)(p + 4 * (q & 1) + 32 * (q >> 1)) = (f32x4){v[4 * q], v[4 * q + 1], v[4 * q + 2], v[4 * q + 3]};
}
__device__ __forceinline__ void nt_store16(u32x4* p, u32x4 v) { __builtin_nontemporal_store(v, p); }
__device__ __forceinline__ void store16_bf16_nt(bf16_t* p, const float (&v)[16]) {
    u32x4 a, b; a.x = pk2(v[0], v[1]); a.y = pk2(v[2], v[3]); a.z = pk2(v[4], v[5]); a.w = pk2(v[6], v[7]);
    b.x = pk2(v[8], v[9]); b.y = pk2(v[10], v[11]); b.z = pk2(v[12], v[13]); b.w = pk2(v[14], v[15]);
    nt_store16((u32x4*)p, a); nt_store16((u32x4*)(p + 32), b);
}
__device__ __forceinline__ void store16_f32_nt(float* p, const float (&v)[16]) {
#pragma unroll
    for (int q = 0; q < 4; ++q) { f32x4 t = (f32x4){v[4 * q], v[4 * q + 1], v[4 * q + 2], v[4 * q + 3]}; __builtin_nontemporal_store(t, (f32x4*)(p + 4 * (q & 1) + 32 * (q >> 1))); }
}
__device__ __forceinline__ void load16c_bf16(const bf16_t* p, float (&v)[16]) {
    const u32x4 a = *(const u32x4*)p, b = *(const u32x4*)(p + 8);
    v[0] = bflo(a.x); v[1] = bfhi(a.x); v[2] = bflo(a.y); v[3] = bfhi(a.y); v[4] = bflo(a.z); v[5] = bfhi(a.z); v[6] = bflo(a.w); v[7] = bfhi(a.w);
    v[8] = bflo(b.x); v[9] = bfhi(b.x); v[10] = bflo(b.y); v[11] = bfhi(b.y); v[12] = bflo(b.z); v[13] = bfhi(b.z); v[14] = bflo(b.w); v[15] = bfhi(b.w);
}
__device__ __forceinline__ void load16c_f32(const float* p, float (&v)[16]) {
#pragma unroll
    for (int q = 0; q < 4; ++q) { const f32x4 t = *(const f32x4*)(p + 4 * q); v[4 * q] = t.x; v[4 * q + 1] = t.y; v[4 * q + 2] = t.z; v[4 * q + 3] = t.w; }
}

__device__ __forceinline__ size_t pofs(int row, int col) { return ((size_t)((row >> 8) * (IN_COLS / 256) + (col >> 8)) << 16) + (size_t)(((row & 255) << 8) + (col & 255)); }
constexpr float QSCALE_DIL = 0.125f * LOG2E;

struct EpiProj {
    bf16_t* P; const float* gq; const float* gk;
    __device__ __forceinline__ void operator()(const f32x4 (&acc)[2][2][4][2], const Unit& u, int wr, int wc, int fr, int fq) const {
        const int pn = u.pn; int mode = 0; const float* gain = gq; float sc = 1.f;
        if (pn < 18) { const int g = pn / 6, t = (pn % 6) >> 1; if (t == 0) { mode = 1; gain = gq + g * 64; sc = QSCALE_DIL; } else if (t == 1) { mode = 1; gain = gk + g * 64; } }
        else if (pn == 19) { mode = 2; sc = 0.125f; }
        else if (pn == 22 || pn == 23) mode = 4;
        else if (pn >= 26) mode = 3;
        float gv[16];
#pragma unroll
        for (int e = 0; e < 16; ++e) gv[e] = 1.f;
        if (mode == 1) load16_f32(gain + fq * 8, gv);
        const int col0 = pn * 256 + wc * 64 + fq * 8;
        EPI_ROWS_BEGIN
            if (mode == 1) {
                float ss = 0.f;
#pragma unroll
                for (int e = 0; e < 16; ++e) ss += v[e] * v[e];
                ss += __shfl_xor(ss, 16); ss += __shfl_xor(ss, 32);
                const float rs = rsqrtf(ss * (1.f / 64.f) + NORM_EPS) * sc;
#pragma unroll
                for (int e = 0; e < 16; ++e) v[e] = v[e] * rs * gv[e];
            } else if (mode == 2) {
#pragma unroll
                for (int e = 0; e < 16; ++e) v[e] *= sc;
            } else if (mode == 3) {
#pragma unroll
                for (int e = 0; e < 16; ++e) v[e] = __builtin_amdgcn_rcpf(1.f + __builtin_amdgcn_exp2f(-LOG2E * v[e]));
            } else if (mode == 4) {
#pragma unroll
                for (int e = 0; e < 16; ++e) v[e] = v[e] * __builtin_amdgcn_rcpf(1.f + __builtin_amdgcn_exp2f(-LOG2E * v[e]));
            }
            store16_bf16_nt(P + pofs(u.pm * 256 + rloc, col0), v);
        EPI_ROWS_END
    }
};
struct EpiPlainBf16 {
    bf16_t* O; int ldc;
    __device__ __forceinline__ void operator()(const f32x4 (&acc)[2][2][4][2], const Unit& u, int wr, int wc, int fr, int fq) const {
        const int col0 = u.pn * 256 + wc * 64 + fq * 8;
        EPI_ROWS_BEGIN
            store16_bf16(O + (size_t)(u.pm * 256 + rloc) * ldc + col0, v);
        EPI_ROWS_END
    }
};
struct EpiBranch {
    bf16_t* Mg; const bf16_t* P;
    __device__ __forceinline__ void operator()(const f32x4 (&acc)[2][2][4][2], const Unit& u, int wr, int wc, int fr, int fq) const {
        const int b = u.pn >> 2, pn = u.pn & 3, pm = u.pm - b * (HTOK / 256);
        const int col0 = pn * 256 + wc * 64 + fq * 8;
        const float keepw = b == 0 ? 0.f : 1.f;
#pragma unroll
        for (int ai = 0; ai < 2; ++ai)
#pragma unroll
            for (int mp2 = 0; mp2 < 2; ++mp2) {
                u32x4 ga[2][2], oa[2][2];
#pragma unroll
                for (int mm = 0; mm < 2; ++mm) { const int rloc = ai * 128 + wr * 64 + (2 * mp2 + mm) * 16 + fr; const int row = pm * 256 + rloc;
                    const bf16_t* gp = P + pofs(row, GATE_OFF + b * 1024 + col0); const bf16_t* mq = Mg + (size_t)row * D_MODEL + col0;
                    ga[mm][0] = *(const u32x4*)gp; ga[mm][1] = *(const u32x4*)(gp + 32);
                    if (b != 0) { oa[mm][0] = *(const u32x4*)mq; oa[mm][1] = *(const u32x4*)(mq + 32); } else { oa[mm][0] = (u32x4){0u, 0u, 0u, 0u}; oa[mm][1] = (u32x4){0u, 0u, 0u, 0u}; } }
#pragma unroll
                for (int mm = 0; mm < 2; ++mm) { const int m = 2 * mp2 + mm; const int row = pm * 256 + ai * 128 + wr * 64 + m * 16 + fr;
                    bf16_t* mq = Mg + (size_t)row * D_MODEL + col0;
#pragma unroll
                    for (int bj = 0; bj < 2; ++bj) { const u32x4 g = ga[mm][bj], o = oa[mm][bj]; const f32x4 a0 = acc[ai][bj][m][0], a1 = acc[ai][bj][m][1]; u32x4 w;
                        w.x = pk2(keepw * bflo(o.x) + a0[0] * bflo(g.x), keepw * bfhi(o.x) + a0[1] * bfhi(g.x));
                        w.y = pk2(keepw * bflo(o.y) + a0[2] * bflo(g.y), keepw * bfhi(o.y) + a0[3] * bfhi(g.y));
                        w.z = pk2(keepw * bflo(o.z) + a1[0] * bflo(g.z), keepw * bfhi(o.z) + a1[1] * bfhi(g.z));
                        w.w = pk2(keepw * bflo(o.w) + a1[2] * bflo(g.w), keepw * bfhi(o.w) + a1[3] * bfhi(g.w));
                        *(u32x4*)(mq + 32 * bj) = w; } }
            }
    }
};
struct EpiOut {
    const float* X; float* Out; bf16_t* A2; const float* g2; float* ssq;
    __device__ __forceinline__ void operator()(const f32x4 (&acc)[2][2][4][2], const Unit& u, int wr, int wc, int fr, int fq) const {
        const int col0 = u.pn * 256 + wc * 64 + fq * 8;
        float gv[16]; load16_f32(g2 + col0, gv);
        EPI_ROWS_BEGIN
            const size_t row = (size_t)(u.pm * 256 + rloc);
            float xv[16]; load16_f32(X + row * D_MODEL + col0, xv);
            float ss = 0.f;
#pragma unroll
            for (int e = 0; e < 16; ++e) { v[e] += xv[e]; ss += v[e] * v[e]; }
            store16_f32_nt(Out + row * D_MODEL + col0, v);
#pragma unroll
            for (int e = 0; e < 16; ++e) v[e] *= gv[e];
            store16_bf16_nt(A2 + row * D_MODEL + col0, v);
            ss += __shfl_xor(ss, 16); ss += __shfl_xor(ss, 32);
            if (fq == 0) (void)__hip_atomic_fetch_add(ssq + row, ss, __ATOMIC_RELAXED, __HIP_MEMORY_SCOPE_AGENT);
        EPI_ROWS_END
    }
};
struct EpiFfnIn {
    bf16_t* UG; const float* ssq;
    __device__ __forceinline__ void operator()(const f32x4 (&acc)[2][2][4][2], const Unit& u, int wr, int wc, int fr, int fq) const {
        const int col0 = u.pn * 256 + wc * 64 + fq * 8;
        EPI_ROWS_BEGIN
            const size_t row = (size_t)(u.pm * 256 + rloc);
            float sp[16]; load16c_f32(ssq + row * 16, sp);
            float ss = 0.f;
#pragma unroll
            for (int e = 0; e < 16; ++e) ss += sp[e];
            const float rs = rsqrtf(ss * (1.f / 1024.f) + NORM_EPS);
#pragma unroll
            for (int e = 0; e < 16; ++e) v[e] *= rs;
            store16_bf16(UG + row * FF2 + col0, v);
        EPI_ROWS_END
    }
};
__device__ __forceinline__ float gelu_exact(float v) {
    const float t = __builtin_amdgcn_rcpf(fabsf(v) * 0.2316418882f + 1.0f);
    float q = t * 0.5307027145f + (-0.7265760135f); q = q * t + 0.7107068705f; q = q * t + (-0.142248368f); q = q * t + 0.127414796f; q = q * t;
    const float e = __builtin_amdgcn_exp2f(v * v * (-0.72134752044f));
    const float m = v * (q * e);
    return v < 0.f ? m : v - m;
}
__device__ __forceinline__ f32x2 gelu_pk(f32x2 v) {
    const f32x2 av = __builtin_elementwise_abs(v), d = av * 0.2316418882f + 1.0f;
    f32x2 t; t.x = __builtin_amdgcn_rcpf(d.x); t.y = __builtin_amdgcn_rcpf(d.y);
    f32x2 q = t * 0.5307027145f + (-0.7265760135f); q = q * t + 0.7107068705f; q = q * t + (-0.142248368f); q = q * t + 0.127414796f; q = q * t;
    const f32x2 sq = (v * v) * (-0.72134752044f);
    f32x2 e; e.x = __builtin_amdgcn_exp2f(sq.x); e.y = __builtin_amdgcn_exp2f(sq.y);
    const f32x2 m = v * (q * e), r = v - m;
    f32x2 o; o.x = v.x < 0.f ? m.x : r.x; o.y = v.y < 0.f ? m.y : r.y; return o;
}
struct EpiFfnInConv {
    bf16_t* YF; bf16_t* HALO; const float* ssq; const float* cw; const float* cb;
    __device__ __forceinline__ void operator()(const f32x4 (&acc)[2][2][4][2], const Unit& u, int wr, int wc, int fr, int fq) const {
        const int lane = fq * 16 + fr, chb = u.pn * 128 + wc * 32 + fq * 8;
        (void)lane;
        float rsa[2][4]; f32x4 wv[2][4];
#pragma unroll
        for (int ai = 0; ai < 2; ++ai)
#pragma unroll
            for (int m = 0; m < 4; ++m) rsa[ai][m] = ssq[(unsigned)(u.pm * 256 + ai * 128 + wr * 64 + m * 16 + fr)];
#pragma unroll
        for (int n = 0; n < 2; ++n) { wv[n][0] = *(const f32x4*)(cw + chb + 4 * n); wv[n][1] = *(const f32x4*)(cw + D_FF + chb + 4 * n); wv[n][2] = *(const f32x4*)(cw + 2 * D_FF + chb + 4 * n); wv[n][3] = *(const f32x4*)(cb + chb + 4 * n); }
#pragma unroll
        for (int ai = 0; ai < 2; ++ai) {
            float rs[4];
#pragma unroll
            for (int m = 0; m < 4; ++m) rs[m] = rsqrtf(rsa[ai][m] * (1.f / 1024.f) + NORM_EPS);
            const int blk = u.pm * 4 + 2 * ai + wr;
            u32x2 keep[4];
#pragma unroll
            for (int n = 0; n < 2; ++n) {
                const f32x4 w0 = wv[n][0], w1 = wv[n][1], w2 = wv[n][2], bb = wv[n][3];
#pragma unroll
                for (int m = 0; m < 4; ++m) {
                    float yv[4], uc[4], gc[4];
#pragma unroll
                    for (int j = 0; j < 4; ++j) {
                        const float ucur = acc[ai][0][m][n][j] * rs[m];
                        const float um1 = m > 0 ? acc[ai][0][m > 0 ? m - 1 : 0][n][j] * rs[m > 0 ? m - 1 : 0] : 0.f;
                        const float up1 = m < 3 ? acc[ai][0][m < 3 ? m + 1 : 3][n][j] * rs[m < 3 ? m + 1 : 3] : 0.f;
                        const float uprev = __builtin_bit_cast(float, __builtin_amdgcn_update_dpp(0, __builtin_bit_cast(int, fr == 15 ? um1 : ucur), 0x121, 0xf, 0xf, false));
                        const float unext = __builtin_bit_cast(float, __builtin_amdgcn_update_dpp(0, __builtin_bit_cast(int, fr == 0 ? up1 : ucur), 0x12F, 0xf, 0xf, false));
                        yv[j] = bb[j] + w0[j] * uprev + w1[j] * ucur + w2[j] * unext;
                        uc[j] = ucur; gc[j] = acc[ai][1][m][n][j] * rs[m];
                    }
                    { const f32x2 g01 = gelu_pk((f32x2){yv[0], yv[1]}), g23 = gelu_pk((f32x2){yv[2], yv[3]});
                      yv[0] = g01.x * gc[0]; yv[1] = g01.y * gc[1]; yv[2] = g23.x * gc[2]; yv[3] = g23.y * gc[3]; }
                    const unsigned row = (unsigned)(u.pm * 256 + ai * 128 + wr * 64 + m * 16 + fr);
                    const bool e0 = (m == 0 && fr == 0), e63 = (m == 3 && fr == 15);
                    { u32x2 o; o.x = pk2(yv[0], yv[1]); o.y = pk2(yv[2], yv[3]);
                      if (n == 0) keep[m] = o;
                      else if (!(e0 || e63)) { u32x4 o4; o4.x = keep[m].x; o4.y = keep[m].y; o4.z = o.x; o4.w = o.y; __builtin_nontemporal_store(o4, (u32x4*)(YF + (row * (unsigned)D_FF + (unsigned)chb))); } }
                    if (m == 0 || m == 3) {
                        const int hs = m == 0 ? (fr == 0 ? 0 : (fr == 1 ? 1 : -1)) : (fr == 14 ? 2 : (fr == 15 ? 3 : -1));
                        if (hs >= 0) { u32x2 o; o.x = pk2(uc[0], uc[1]); o.y = pk2(uc[2], uc[3]); *(u32x2*)(HALO + ((unsigned)(blk * 6 + hs) * (unsigned)D_FF + (unsigned)(chb + 4 * n))) = o; }
                        if (e0 || e63) { u32x2 o; o.x = pk2(gc[0], gc[1]); o.y = pk2(gc[2], gc[3]); *(u32x2*)(HALO + ((unsigned)(blk * 6 + (e0 ? 4 : 5)) * (unsigned)D_FF + (unsigned)(chb + 4 * n))) = o; }
                    }
                    asm volatile("" ::: "memory");
                }
            }
        }
    }
};
struct EpiFfnOut {
    float* Out;
    __device__ __forceinline__ void operator()(const f32x4 (&acc)[2][2][4][2], const Unit& u, int wr, int wc, int fr, int fq) const {
        const int col0 = u.pn * 256 + wc * 64 + fq * 8;
        EPI_ROWS_BEGIN
            float* op = Out + (size_t)(u.pm * 256 + rloc) * D_MODEL + col0;
            float xv[16]; load16_f32(op, xv);
#pragma unroll
            for (int e = 0; e < 16; ++e) v[e] += xv[e];
            store16_f32_nt(op, v);
        EPI_ROWS_END
    }
};

__device__ __forceinline__ int ffn_row_of(int ng) { const int gate = ng >= D_FF ? 1 : 0, ch = ng - gate * D_FF, c7 = ch & 127;
    return (ch >> 7) * 256 + 128 * gate + 32 * (c7 >> 5) + 16 * ((c7 >> 2) & 1) + 4 * ((c7 >> 3) & 3) + (c7 & 3); }
template <int PERMMODE>
__device__ __forceinline__ void p0_transpose_item(const float* W, int K, int N, bf16_t* WT, int row_off, LAS float* scr, int item, int lane) {
    const int nblk = N / 32, kb = item / nblk, nb = item % nblk, k0 = 64 * kb, n0 = 32 * nb;
#pragma unroll 8
    for (int i = 0; i < 32; ++i) { const int kk = 2 * i + (lane >> 5); scr[kk * 33 + (lane & 31)] = W[(size_t)(k0 + kk) * N + n0 + (lane & 31)]; }
    asm volatile("s_waitcnt lgkmcnt(0)" ::: "memory");
    const int c = lane & 7;
#pragma unroll
    for (int j = 0; j < 4; ++j) { const int n = (lane >> 3) + 8 * j; const LAS float* s = scr + (8 * c) * 33 + n;
        u32x4 o; o.x = pk2(s[0 * 33], s[1 * 33]); o.y = pk2(s[2 * 33], s[3 * 33]); o.z = pk2(s[4 * 33], s[5 * 33]); o.w = pk2(s[6 * 33], s[7 * 33]);
        const int ng = n0 + n, nrow = PERMMODE == 1 ? ffn_row_of(ng) : (ng & ~255) + slot_of(ng & 255);
        *(u32x4*)(WT + (size_t)(row_off + nrow) * K + k0 + 8 * c) = o; }
    asm volatile("s_waitcnt lgkmcnt(0)" ::: "memory");
}
__device__ __forceinline__ void rms_row_to_bf16(const float* xrow, const float* g, bf16_t* orow, int lane) {
    const f32x4* xr = (const f32x4*)xrow + lane; const f32x4* gr = (const f32x4*)g + lane;
    f32x4 v[4]; float s = 0.f;
#pragma unroll
    for (int j = 0; j < 4; ++j) { v[j] = xr[64 * j]; s += (v[j].x * v[j].x + v[j].y * v[j].y) + (v[j].z * v[j].z + v[j].w * v[j].w); }
    const float rs = rsqrtf(wave_sum(s) * (1.f / 1024.f) + NORM_EPS);
    u32x2* o8 = (u32x2*)orow + lane;
#pragma unroll
    for (int j = 0; j < 4; ++j) { const f32x4 gg = gr[64 * j]; u32x2 w; w.x = pk2(v[j].x * rs * gg.x, v[j].y * rs * gg.y); w.y = pk2(v[j].z * rs * gg.z, v[j].w * rs * gg.w); o8[64 * j] = w; }
}

__device__ __forceinline__ void rms_row2_to_bf16(const float* xa, const float* xb, const float* g, bf16_t* oa, bf16_t* ob, int lane) {
    const f32x4* ra = (const f32x4*)xa + lane; const f32x4* rb = (const f32x4*)xb + lane; const f32x4* gr = (const f32x4*)g + lane;
    f32x4 va[4], vb[4]; float sa = 0.f, sb = 0.f;
#pragma unroll
    for (int j = 0; j < 4; ++j) { va[j] = ra[64 * j]; vb[j] = rb[64 * j]; }
#pragma unroll
    for (int j = 0; j < 4; ++j) { sa += (va[j].x * va[j].x + va[j].y * va[j].y) + (va[j].z * va[j].z + va[j].w * va[j].w); sb += (vb[j].x * vb[j].x + vb[j].y * vb[j].y) + (vb[j].z * vb[j].z + vb[j].w * vb[j].w); }
#pragma unroll
    for (int o = 1; o < 64; o <<= 1) { sa += __shfl_xor(sa, o); sb += __shfl_xor(sb, o); }
    const float rsa = rsqrtf(sa * (1.f / 1024.f) + NORM_EPS), rsb = rsqrtf(sb * (1.f / 1024.f) + NORM_EPS);
    u32x2* o8a = (u32x2*)oa + lane; u32x2* o8b = (u32x2*)ob + lane;
#pragma unroll
    for (int j = 0; j < 4; ++j) { const f32x4 gg = gr[64 * j]; u32x2 w;
        w.x = pk2(va[j].x * rsa * gg.x, va[j].y * rsa * gg.y); w.y = pk2(va[j].z * rsa * gg.z, va[j].w * rsa * gg.w); o8a[64 * j] = w;
        w.x = pk2(vb[j].x * rsb * gg.x, vb[j].y * rsb * gg.y); w.y = pk2(vb[j].z * rsb * gg.z, vb[j].w * rsb * gg.w); o8b[64 * j] = w; }
}


__device__ __forceinline__ void dil_wave(const bf16_t* proj, bf16_t* odil, float* lse, const float* cconst, int item, LAS char* vl, int lane) {
    asm volatile("" : "+v"(lane));
    const int qb = item & 31; int t = item >> 5; const int g = t % 3; t /= 3; const int h = t & 7, b = t >> 3;
    const float cshift = cconst[g];
    const int lr = 2 * g, r = 1 << lr, nsub = SEQ >> lr, nblk = nsub >> 6;
    const int c = qb / nblk, nb = qb % nblk, i0 = nb * 64;
    const int rr = lane & 31, hh = lane >> 5;
    const int rowb = b * SEQ;
    const int qcol = g * 1536 + h * 64, kcol = qcol + 512, vcol = qcol + 1024;
    const int kt_lo = i0 == 0 ? 2 : 0, kt_hi = (i0 == nsub - 64) ? 4 : 6;
    bf16x8 kn[4];
#define DIL_ISSUE(KT) do { const int j0_ = i0 - 64 + 32 * (KT); \
        { int jr = j0_ + rr; jr = jr < 0 ? 0 : (jr >= nsub ? nsub - 1 : jr); const bf16_t* p = proj + pofs(rowb + jr * r + c, kcol + 32 * hh); \
          _Pragma("unroll") for (int ks = 0; ks < 4; ++ks) kn[ks] = *(const bf16x8*)(p + 8 * ks); } \
        _Pragma("unroll") for (int q = 0; q < 4; ++q) { int jv = j0_ + 8 * q + (lane >> 3); jv = jv < 0 ? 0 : (jv >= nsub ? nsub - 1 : jv); \
          __builtin_amdgcn_global_load_lds((const unsigned*)(proj + pofs(rowb + jv * r + c, vcol + 8 * (lane & 7))), (LAS unsigned*)(vl + 4096 * ((KT) & 1) + 1024 * q), 16, 0, 0); } } while (0)
    DIL_ISSUE(kt_lo);
    bf16x8 qf[2][4];
#pragma unroll
    for (int qt = 0; qt < 2; ++qt) { const int tok = (i0 + 32 * qt + rr) * r + c; const bf16_t* p = proj + pofs(rowb + tok, qcol + 32 * hh);
#pragma unroll
        for (int ks = 0; ks < 4; ++ks) qf[qt][ks] = *(const bf16x8*)(p + 8 * ks); }
    f32x16 o[2][2];
#pragma unroll
    for (int a = 0; a < 2; ++a)
#pragma unroll
        for (int q = 0; q < 2; ++q)
#pragma unroll
            for (int e = 0; e < 16; ++e) o[a][q][e] = 0.f;
    float lrun[2] = {0.f, 0.f};
    const float slope2 = exp2f(-(float)(h + 1)) * (float)r * LOG2E;
    const int blk = (lane >> 4) & 1, q4 = (lane & 15) >> 2, p4 = lane & 3;
    float fd[16];
#pragma unroll
    for (int e = 0; e < 16; ++e) fd[e] = (float)(rr - 4 * hh - ((e & 3) + 8 * (e >> 2)));
#ifdef PROBE_DILLOOP
    for (int rep = 0; rep < 2; ++rep) {
    if (rep) { DIL_ISSUE(kt_lo); lrun[0] = 0.f; lrun[1] = 0.f;
        _Pragma("unroll") for (int a = 0; a < 2; ++a) _Pragma("unroll") for (int q = 0; q < 2; ++q) _Pragma("unroll") for (int e = 0; e < 16; ++e) o[a][q][e] = 0.f; }
#endif
    for (int kt = kt_lo; kt < kt_hi; ++kt) {
        asm volatile("s_waitcnt vmcnt(0)" ::: "memory");
        bf16x8 kf[4];
#pragma unroll
        for (int ks = 0; ks < 4; ++ks) kf[ks] = kn[ks];
        if (kt + 1 < kt_hi) DIL_ISSUE(kt + 1);
        asm volatile("" ::: "memory");
        LAS char* vb = vl + 4096 * (kt & 1);
        bf16x8 pf[2][2];
        bool act[2];
#pragma unroll
        for (int qt = 0; qt < 2; ++qt) {
            const int mrel = kt - qt;
            act[qt] = !(mrel == 5 || mrel == -1);
            if (!act[qt]) continue;
            f32x16 s;
#pragma unroll
            for (int e = 0; e < 16; ++e) s[e] = -cshift;
#pragma unroll
            for (int ks = 0; ks < 4; ++ks) s = MFMA32(kf[ks], qf[qt][ks], s);
            const float Df = 64.f - 32.f * (float)mrel;
            const bool edge = (mrel == 0) || (mrel == 4);
            float rs = 0.f;
#pragma unroll
            for (int e = 0; e < 16; ++e) { const float tt = Df + fd[e]; float sv = fmaf(-slope2, fabsf(tt), s[e]);
                if (edge) sv = fabsf(tt) <= 64.f ? sv : -INFINITY;
                const float p = __builtin_amdgcn_exp2f(sv); s[e] = p; rs += p; }
            lrun[qt] += rs;
#pragma unroll
            for (int s2 = 0; s2 < 2; ++s2) pf[qt][s2] = pack8(s[8 * s2], s[8 * s2 + 1], s[8 * s2 + 2], s[8 * s2 + 3], s[8 * s2 + 4], s[8 * s2 + 5], s[8 * s2 + 6], s[8 * s2 + 7]);
        }
#pragma unroll
        for (int dt = 0; dt < 2; ++dt)
#pragma unroll
            for (int s2 = 0; s2 < 2; ++s2) {
                LAS char* a = vb + (16 * s2 + 4 * hh + q4) * 128 + (32 * dt + 16 * blk + 4 * p4) * 2;
                const bf16x8 vf = cat4(tr_read(a), tr_read(a + 8 * 128));
#pragma unroll
                for (int qt = 0; qt < 2; ++qt) if (act[qt]) o[dt][qt] = MFMA32(vf, pf[qt][s2], o[dt][qt]);
            }
        asm volatile("" ::: "memory");
    }
#ifdef PROBE_DILLOOP
    }
#endif
#undef DIL_ISSUE
#pragma unroll
    for (int qt = 0; qt < 2; ++qt) {
        const float lt = lrun[qt] + __shfl_xor(lrun[qt], 32);
        const int row = 32 * qt + rr; const float inv = __builtin_amdgcn_rcpf(lt);
#pragma unroll
        for (int dt = 0; dt < 2; ++dt)
#pragma unroll
            for (int gq = 0; gq < 4; ++gq) { u32x2 w; w.x = pk2(o[dt][qt][4 * gq] * inv, o[dt][qt][4 * gq + 1] * inv); w.y = pk2(o[dt][qt][4 * gq + 2] * inv, o[dt][qt][4 * gq + 3] * inv);
                *(LAS u32x2*)(vl + row * 128 + 16 * ((4 * dt + gq) ^ (row & 7)) + 8 * hh) = w; }
        if (hh == 0) lse[((size_t)g * HTOK + (size_t)b * SEQ + (i0 + row) * r + c) * 8 + h] = log2f(lt) + cshift;
    }
    asm volatile("" ::: "memory");
    { bf16_t* ob = odil + ((size_t)g * HTOK + (size_t)b * SEQ) * 512 + h * 64;
#pragma unroll
        for (int q = 0; q < 8; ++q) { const int row = 8 * q + (lane >> 3), pos = lane & 7, ch = pos ^ (row & 7);
            const u32x4 v = *(const LAS u32x4*)(vl + row * 128 + 16 * pos);
            *(u32x4*)(ob + (size_t)((i0 + row) * r + c) * 512 + 8 * ch) = v; } }
    asm volatile("" ::: "memory");
}

__device__ __forceinline__ void ret_u_item(const bf16_t* proj, bf16_t* U, const float* decay_logit, int item, LAS char* L, int tid) {
    asm volatile("" : "+v"(tid));
    const int n = item & 15, h = (item >> 4) & 3, b = item >> 6;
    const int lane = tid & 63, wave = tid >> 6, rr = lane & 31, hh = lane >> 5, blk = (lane >> 4) & 1, q4 = (lane & 15) >> 2, p4 = lane & 3;
    const float Lf = -log1pf(expf(-decay_logit[h])) * LOG2E, Lb = -log1pf(expf(-decay_logit[4 + h])) * LOG2E;
    const int rowb = b * SEQ + 128 * n;
    { const int row = tid >> 2, pc = tid & 3; const bf16_t* p = proj + pofs(rowb + row, RET_OFF + 256 + h * 64 + 16 * pc);
        const u32x4 a = *(const u32x4*)p, c = *(const u32x4*)(p + 8);
        const float wf = exp2f(Lf * (float)(127 - row)), wb = exp2f(Lb * (float)row);
        u32x4 o;
        o.x = pk2(bflo(a.x) * wf, bfhi(a.x) * wf); o.y = pk2(bflo(a.y) * wf, bfhi(a.y) * wf); o.z = pk2(bflo(a.z) * wf, bfhi(a.z) * wf); o.w = pk2(bflo(a.w) * wf, bfhi(a.w) * wf);
        *(LAS u32x4*)(L + row * 128 + 32 * pc) = o;
        o.x = pk2(bflo(c.x) * wf, bfhi(c.x) * wf); o.y = pk2(bflo(c.y) * wf, bfhi(c.y) * wf); o.z = pk2(bflo(c.z) * wf, bfhi(c.z) * wf); o.w = pk2(bflo(c.w) * wf, bfhi(c.w) * wf);
        *(LAS u32x4*)(L + row * 128 + 32 * pc + 16) = o;
        o.x = pk2(bflo(a.x) * wb, bfhi(a.x) * wb); o.y = pk2(bflo(a.y) * wb, bfhi(a.y) * wb); o.z = pk2(bflo(a.z) * wb, bfhi(a.z) * wb); o.w = pk2(bflo(a.w) * wb, bfhi(a.w) * wb);
        *(LAS u32x4*)(L + 16384 + row * 128 + 32 * pc) = o;
        o.x = pk2(bflo(c.x) * wb, bfhi(c.x) * wb); o.y = pk2(bflo(c.y) * wb, bfhi(c.y) * wb); o.z = pk2(bflo(c.z) * wb, bfhi(c.z) * wb); o.w = pk2(bflo(c.w) * wb, bfhi(c.w) * wb);
        *(LAS u32x4*)(L + 16384 + row * 128 + 32 * pc + 16) = o; }
#pragma unroll
    for (int q = 0; q < 4; ++q) { const int idx = tid + 512 * q, row = idx >> 4, pc = idx & 15;
        *(LAS u32x4*)(L + 32768 + row * 256 + 16 * pc) = *(const u32x4*)(proj + pofs(rowb + row, RET_OFF + 512 + h * 128 + 8 * pc)); }
    __syncthreads();
    const int dir = wave >> 2, vt = wave & 3;
    f32x16 acc[2];
#pragma unroll
    for (int a = 0; a < 2; ++a)
#pragma unroll
        for (int e = 0; e < 16; ++e) acc[a][e] = 0.f;
    LAS char* KI = L + 16384 * dir; LAS char* VI = L + 32768;
#pragma unroll
    for (int ks = 0; ks < 8; ++ks) {
        const int jrow = 16 * ks + 8 * hh + q4;
        LAS char* vb = VI + jrow * 256 + (32 * vt + 16 * blk + 4 * p4) * 2;
        const bf16x8 bfr = cat4(tr_read(vb), tr_read(vb + 4 * 256));
#pragma unroll
        for (int dt = 0; dt < 2; ++dt) { LAS char* ka = KI + jrow * 128 + (32 * dt + 16 * blk + 4 * p4) * 2;
            const bf16x8 afr = cat4(tr_read(ka), tr_read(ka + 4 * 128));
            acc[dt] = MFMA32(afr, bfr, acc[dt]); }
    }
    bf16_t* up = U + ((size_t)((b * 4 + h) * 16 + n) * 2 + dir) * 8192;
#pragma unroll
    for (int dt = 0; dt < 2; ++dt)
#pragma unroll
        for (int e = 0; e < 16; ++e) up[(32 * dt + (e & 3) + 8 * (e >> 2) + 4 * hh) * 128 + 32 * vt + rr] = (bf16_t)(pk2(acc[dt][e], 0.f) & 0xffffu);
    __syncthreads();
}
__device__ __forceinline__ bf16x8 scale_frag(bf16x8 f, float sc) {
    const u32x4 w = __builtin_bit_cast(u32x4, f);
    return pack8(bflo(w.x) * sc, bfhi(w.x) * sc, bflo(w.y) * sc, bfhi(w.y) * sc, bflo(w.z) * sc, bfhi(w.z) * sc, bflo(w.w) * sc, bfhi(w.w) * sc);
}
__device__ __forceinline__ void st16_lds_bf16(LAS char* p, const float (&v)[16]) {
    u32x4 a, b; a.x = pk2(v[0], v[1]); a.y = pk2(v[2], v[3]); a.z = pk2(v[4], v[5]); a.w = pk2(v[6], v[7]);
    b.x = pk2(v[8], v[9]); b.y = pk2(v[10], v[11]); b.z = pk2(v[12], v[13]); b.w = pk2(v[14], v[15]);
    *(LAS u32x4*)p = a; *(LAS u32x4*)(p + 16) = b;
}
__device__ __forceinline__ void ret_chunk_item(const bf16_t* proj, const bf16_t* U, bf16_t* yret, const float* decay_logit, const float* gn_g, int item, LAS char* L, int tid) {
    asm volatile("" : "+v"(tid));
    const int pr = item & 7, h = (item >> 3) & 3, b = item >> 5, n = 2 * pr;
    const int lane = tid & 63, wave = tid >> 6, rr = lane & 31, hh = lane >> 5, blk = (lane >> 4) & 1, q4 = (lane & 15) >> 2, p4 = lane & 3;
    const float Lf = -log1pf(expf(-decay_logit[h])) * LOG2E, Lb = -log1pf(expf(-decay_logit[4 + h])) * LOG2E;
    const int rowb = b * SEQ + 128 * n;
#pragma unroll
    for (int q = 0; q < 8; ++q) { const int idx = tid + 512 * q, row = idx >> 4, pc = idx & 15;
        *(LAS u32x4*)(L + row * 256 + 16 * pc) = *(const u32x4*)(proj + pofs(rowb + row, RET_OFF + 512 + h * 128 + 8 * pc)); }
    { const bf16_t* Ub = U + (size_t)((b * 4 + h) * 16) * 2 * 8192 + tid * 16;
        const float wf = exp2f(128.f * Lf), wb = exp2f(128.f * Lb);
        const int d = tid >> 3, v0 = (tid & 7) * 16;
        LAS char* S = L + 65536 + d * 256 + v0 * 2;
        float acc[16], t[16];
#pragma unroll
        for (int e = 0; e < 16; ++e) acc[e] = 0.f;
        for (int m0 = n - 4 * ((n + 3) >> 2); m0 < n; m0 += 4) {
            float t4[4][16];
#pragma unroll
            for (int u4 = 0; u4 < 4; ++u4) { const int m = m0 + u4; load16c_bf16(Ub + (size_t)((m < 0 ? 0 : m) * 2) * 8192, t4[u4]); }
#pragma unroll
            for (int u4 = 0; u4 < 4; ++u4) { const float msk = (m0 + u4) < 0 ? 0.f : 1.f;
#pragma unroll
                for (int e = 0; e < 16; ++e) acc[e] = acc[e] * wf + t4[u4][e] * msk; } }
        st16_lds_bf16(S, acc);
        load16c_bf16(Ub + (size_t)(n * 2) * 8192, t);
#pragma unroll
        for (int e = 0; e < 16; ++e) acc[e] = acc[e] * wf + t[e];
        st16_lds_bf16(S + 2 * 16384, acc);
#pragma unroll
        for (int e = 0; e < 16; ++e) acc[e] = 0.f;
        { const int cnt = 14 - n;
          for (int m0 = 15 + 4 * ((cnt + 3) >> 2) - cnt; m0 > 15 - cnt; m0 -= 4) {
            float t4[4][16];
#pragma unroll
            for (int u4 = 0; u4 < 4; ++u4) { const int m = m0 - u4; load16c_bf16(Ub + (size_t)((m > 15 ? 15 : m) * 2 + 1) * 8192, t4[u4]); }
#pragma unroll
            for (int u4 = 0; u4 < 4; ++u4) { const float msk = (m0 - u4) > 15 ? 0.f : 1.f;
#pragma unroll
                for (int e = 0; e < 16; ++e) acc[e] = acc[e] * wb + t4[u4][e] * msk; } } }
        st16_lds_bf16(S + 3 * 16384, acc);
        load16c_bf16(Ub + (size_t)((n + 1) * 2 + 1) * 8192, t);
#pragma unroll
        for (int e = 0; e < 16; ++e) acc[e] = acc[e] * wb + t[e];
        st16_lds_bf16(S + 1 * 16384, acc);
    }
    __syncthreads();
    const int cw = wave >> 2, i = 32 * (wave & 3) + rr;
    const int crow = rowb + 128 * cw;
    bf16x8 qf[4];
    { const bf16_t* p = proj + pofs(crow + i, RET_OFF + h * 64 + 32 * hh);
#pragma unroll
        for (int ks = 0; ks < 4; ++ks) qf[ks] = *(const bf16x8*)(p + 8 * ks); }
    f32x16 y[4];
#pragma unroll
    for (int a = 0; a < 4; ++a)
#pragma unroll
        for (int e = 0; e < 16; ++e) y[a][e] = 0.f;
    LAS char* VI = L + cw * 32768;
#pragma unroll
    for (int kt = 0; kt < 4; ++kt) {
        const int j0 = 32 * kt;
        bf16x8 kf[4];
        { const bf16_t* p = proj + pofs(crow + j0 + rr, RET_OFF + 256 + h * 64 + 32 * hh);
#pragma unroll
            for (int ks = 0; ks < 4; ++ks) kf[ks] = *(const bf16x8*)(p + 8 * ks); }
        f32x16 s;
#pragma unroll
        for (int e = 0; e < 16; ++e) s[e] = 0.f;
#pragma unroll
        for (int ks = 0; ks < 4; ++ks) s = MFMA32(kf[ks], qf[ks], s);
#pragma unroll
        for (int e = 0; e < 16; ++e) { const int j = j0 + (e & 3) + 8 * (e >> 2) + 4 * hh; const int dd = i - j;
            const float w = dd >= 0 ? exp2f(Lf * (float)dd) : exp2f(Lb * (float)(-dd)); s[e] *= w; }
        bf16x8 pf[2];
#pragma unroll
        for (int s2 = 0; s2 < 2; ++s2) pf[s2] = pack8(s[8 * s2], s[8 * s2 + 1], s[8 * s2 + 2], s[8 * s2 + 3], s[8 * s2 + 4], s[8 * s2 + 5], s[8 * s2 + 6], s[8 * s2 + 7]);
#pragma unroll
        for (int vt = 0; vt < 4; ++vt)
#pragma unroll
            for (int s2 = 0; s2 < 2; ++s2) {
                LAS char* a = VI + (j0 + 16 * s2 + 4 * hh + q4) * 256 + (32 * vt + 16 * blk + 4 * p4) * 2;
                const bf16x8 vf = cat4(tr_read(a), tr_read(a + 8 * 256));
                y[vt] = MFMA32(vf, pf[s2], y[vt]);
            }
    }
#pragma unroll
    for (int dir = 0; dir < 2; ++dir) {
        const float sc = dir == 0 ? exp2f(Lf * (float)(i + 1)) : exp2f(Lb * (float)(128 - i));
        LAS char* SI = L + 65536 + (cw * 2 + dir) * 16384;
#pragma unroll
        for (int ks = 0; ks < 4; ++ks) {
            const bf16x8 qs = scale_frag(qf[ks], sc);
#pragma unroll
            for (int vt = 0; vt < 4; ++vt) {
                LAS char* a = SI + (32 * hh + 8 * ks + q4) * 256 + (32 * vt + 16 * blk + 4 * p4) * 2;
                const bf16x8 af = cat4(tr_read(a), tr_read(a + 4 * 256));
                y[vt] = MFMA32(af, qs, y[vt]);
            }
        }
    }
    float sm = 0.f;
#pragma unroll
    for (int vt = 0; vt < 4; ++vt)
#pragma unroll
        for (int e = 0; e < 16; ++e) sm += y[vt][e];
    sm += __shfl_xor(sm, 32);
    const float mu = sm * (1.f / 128.f);
    float sq = 0.f;
#pragma unroll
    for (int vt = 0; vt < 4; ++vt)
#pragma unroll
        for (int e = 0; e < 16; ++e) { const float dlt = y[vt][e] - mu; sq += dlt * dlt; }
    sq += __shfl_xor(sq, 32);
    const float rs = rsqrtf(sq * (1.f / 128.f) + NORM_EPS);
    const bf16_t* gp = proj + pofs(crow + i, RET_OFF + 1024 + h * 128);
    bf16_t* op = yret + ((size_t)b * SEQ + 128 * (n + cw) + i) * 512 + h * 128;
    const float* gg = gn_g + h * 128;
#pragma unroll
    for (int vt = 0; vt < 4; ++vt)
#pragma unroll
        for (int gq = 0; gq < 4; ++gq) { const int vi = 32 * vt + 8 * gq + 4 * hh;
            const u32x2 gw = *(const u32x2*)(gp + vi); const f32x4 g4 = *(const f32x4*)(gg + vi);
            u32x2 w; w.x = pk2((y[vt][4 * gq] - mu) * rs * g4.x * bflo(gw.x), (y[vt][4 * gq + 1] - mu) * rs * g4.y * bfhi(gw.x));
            w.y = pk2((y[vt][4 * gq + 2] - mu) * rs * g4.z * bflo(gw.y), (y[vt][4 * gq + 3] - mu) * rs * g4.w * bfhi(gw.y));
            *(u32x2*)(op + vi) = w; }
    __syncthreads();
}

__device__ __forceinline__ bf16x8 scale8(u32x4 w, float rs, const float* g) {
    const f32x4 g0 = *(const f32x4*)g, g1 = *(const f32x4*)(g + 4);
    return pack8(bflo(w.x) * rs * g0.x, bfhi(w.x) * rs * g0.y, bflo(w.y) * rs * g0.z, bfhi(w.y) * rs * g0.w, bflo(w.z) * rs * g1.x, bfhi(w.z) * rs * g1.y, bflo(w.w) * rs * g1.z, bfhi(w.w) * rs * g1.w);
}
__device__ __forceinline__ float ssq8(u32x4 w) {
    const float a = bflo(w.x), b = bfhi(w.x), c = bflo(w.y), d = bfhi(w.y), e = bflo(w.z), f = bfhi(w.z), g = bflo(w.w), h = bfhi(w.w);
    return ((a * a + b * b) + (c * c + d * d)) + ((e * e + f * f) + (g * g + h * h));
}
constexpr int MEM_PITCH = 272;
__device__ __forceinline__ void mem_item(const bf16_t* proj, const bf16_t* memkv  , bf16_t* ymem, const float* gqn, const float* gkn, const float* cconst, int item, LAS char* L, int tid) {
    asm volatile("" : "+v"(tid));
    const float cshift = cconst[3];
    const int qr = item & 3, hd = (item >> 2) & 3, b = item >> 4;
    const int lane = tid & 63, wave = tid >> 6, rr = lane & 31, hh = lane >> 5, blk = (lane >> 4) & 1, q4 = (lane & 15) >> 2, p4 = lane & 3;
    const bf16_t* kvb = memkv + (size_t)b * N_MEM * 1024 + hd * 128;
    LAS char* KI = L; LAS char* VI = L + 256 * MEM_PITCH;
#pragma unroll
    for (int q = 0; q < 8; ++q) {
        const int idx = tid + 512 * q, row = idx >> 4, pc = idx & 15;
        const u32x4 kw = *(const u32x4*)(kvb + (size_t)row * 1024 + 8 * pc), vw = *(const u32x4*)(kvb + (size_t)row * 1024 + 512 + 8 * pc);
        float ss = ssq8(kw);
        ss += __shfl_xor(ss, 1); ss += __shfl_xor(ss, 2); ss += __shfl_xor(ss, 4); ss += __shfl_xor(ss, 8);
        const float rs = rsqrtf(ss * (1.f / 128.f) + NORM_EPS);
        *(LAS bf16x8*)(KI + row * MEM_PITCH + 16 * pc) = scale8(kw, rs, gkn + 8 * pc);
        *(LAS u32x4*)(VI + row * MEM_PITCH + 16 * pc) = vw;
    }
    __syncthreads();
#pragma unroll 1
    for (int tq = 0; tq < 2; ++tq) {
        const int i = 512 * qr + 32 * (wave * 2 + tq) + rr;
        bf16x8 qf[8];
        { const bf16_t* p = proj + pofs(b * SEQ + i, MEMQ_OFF + hd * 128 + 64 * hh);
            u32x4 raw[8]; float ss = 0.f;
#pragma unroll
            for (int ks = 0; ks < 8; ++ks) { raw[ks] = *(const u32x4*)(p + 8 * ks); ss += ssq8(raw[ks]); }
            ss += __shfl_xor(ss, 32);
            const float rs = rsqrtf(ss * (1.f / 128.f) + NORM_EPS) * (0.08838834764831845f * LOG2E);
#pragma unroll
            for (int ks = 0; ks < 8; ++ks) qf[ks] = scale8(raw[ks], rs, gqn + 64 * hh + 8 * ks); }
        f32x16 o[4];
#pragma unroll
        for (int a = 0; a < 4; ++a)
#pragma unroll
            for (int e = 0; e < 16; ++e) o[a][e] = 0.f;
        float lrun = 0.f;
#pragma unroll 2
        for (int kt = 0; kt < 8; ++kt) {
            const int j0 = 32 * kt;
            f32x16 s;
#pragma unroll
            for (int e = 0; e < 16; ++e) s[e] = -cshift;
#pragma unroll
            for (int ks = 0; ks < 8; ++ks) { const bf16x8 kf = *(const LAS bf16x8*)(KI + (j0 + rr) * MEM_PITCH + (64 * hh + 8 * ks) * 2); s = MFMA32(kf, qf[ks], s); }
#pragma unroll
            for (int e = 0; e < 16; ++e) { const float p = __builtin_amdgcn_exp2f(s[e]); s[e] = p; lrun += p; }
            bf16x8 pf[2];
#pragma unroll
            for (int s2 = 0; s2 < 2; ++s2) pf[s2] = pack8(s[8 * s2], s[8 * s2 + 1], s[8 * s2 + 2], s[8 * s2 + 3], s[8 * s2 + 4], s[8 * s2 + 5], s[8 * s2 + 6], s[8 * s2 + 7]);
#pragma unroll
            for (int vt = 0; vt < 4; ++vt)
#pragma unroll
                for (int s2 = 0; s2 < 2; ++s2) {
                    LAS char* a = VI + (j0 + 16 * s2 + 4 * hh + q4) * MEM_PITCH + (32 * vt + 16 * blk + 4 * p4) * 2;
                    const bf16x8 vf = cat4(tr_read(a), tr_read(a + 8 * MEM_PITCH));
                    o[vt] = MFMA32(vf, pf[s2], o[vt]);
                }
        }
        const float inv = __builtin_amdgcn_rcpf(lrun + __shfl_xor(lrun, 32));
        bf16_t* op = ymem + ((size_t)b * SEQ + i) * 512 + hd * 128;
#pragma unroll
        for (int vt = 0; vt < 4; ++vt)
#pragma unroll
            for (int gq = 0; gq < 4; ++gq) { u32x2 w; w.x = pk2(o[vt][4 * gq] * inv, o[vt][4 * gq + 1] * inv); w.y = pk2(o[vt][4 * gq + 2] * inv, o[vt][4 * gq + 3] * inv);
                *(u32x2*)(op + 32 * vt + 8 * gq + 4 * hh) = w; }
    }
    __syncthreads();
}

#define XB_TMO      128
#define XB_XCNT(j)  (256  + 64 * (j))
#define XB_XSUB(j)  (1280 + 64 * (j))
#define XB_XGEN(j)  (2304 + 64 * (j))
#define XB_TOP      3328
#define XB_TOPGEN   3392
#define XCD_BAR_WORDS 3456
#define XB_SPIN_CAP (1u << 22)
__device__ __forceinline__ unsigned xb_ld(unsigned* p)              { return __hip_atomic_load(p, __ATOMIC_RELAXED, __HIP_MEMORY_SCOPE_AGENT); }
__device__ __forceinline__ unsigned xb_add(unsigned* p, unsigned v) { return __hip_atomic_fetch_add(p, v, __ATOMIC_RELAXED, __HIP_MEMORY_SCOPE_AGENT); }
__device__ __forceinline__ unsigned xb_xcc_id() { return (unsigned)__builtin_amdgcn_s_getreg((3 << 11) | 20) & 0xFu; }
#define XB_SPIN(cond, bar) do { unsigned _sp = 0; while (cond) { __builtin_amdgcn_s_sleep(1); \
    if ((++_sp & 255u) == 0u) { if (xb_ld(&(bar)[XB_TMO])) break; if (_sp > XB_SPIN_CAP) { atomicAdd(&(bar)[XB_TMO], 1u); break; } } } } while (0)
struct XcdBarrier { unsigned* bar; unsigned x; volatile LAS unsigned* st; };
__device__ __forceinline__ XcdBarrier xcd_barrier_post(unsigned* bar, volatile LAS unsigned* st) {
    XcdBarrier b; b.bar = bar; b.x = xb_xcc_id(); b.st = st;
    if (threadIdx.x == 0) (void)xb_add(&bar[XB_XCNT(b.x)], 1u);
    return b;
}
__device__ __forceinline__ void xcd_barrier_complete(unsigned* bar, unsigned x, unsigned& nloc, unsigned& nx) {
    const unsigned G = gridDim.x * gridDim.y * gridDim.z;
    unsigned sum, cnt, mine, sp = 0u;
    for (;;) {
        sum = 0u; cnt = 0u; mine = 0u;
#pragma unroll
        for (unsigned j = 0; j < 16; ++j) { const unsigned c = xb_ld(&bar[XB_XCNT(j)]); sum += c; cnt += (c > 0u) ? 1u : 0u; mine = (j == x) ? c : mine; }
        if (sum == G) break;
        __builtin_amdgcn_s_sleep(1);
        if ((++sp & 255u) == 0u) { if (xb_ld(&bar[XB_TMO])) break; if (sp > XB_SPIN_CAP) { atomicAdd(&bar[XB_TMO], 1u); break; } }
    }
    nloc = mine > 0u ? mine : 1u; nx = cnt > 0u ? cnt : 1u;
}
__device__ __forceinline__ void xcd_barrier(const XcdBarrier& b) {
    asm volatile("s_waitcnt vmcnt(0)" ::: "memory");
    __syncthreads();
    if (threadIdx.x == 0) {
        unsigned* bar = b.bar;
        __builtin_amdgcn_s_waitcnt(0);
        unsigned nloc = b.st[0], nx = b.st[1];
        if (nloc == 0u) { xcd_barrier_complete(bar, b.x, nloc, nx); b.st[0] = nloc; b.st[1] = nx; }
        const unsigned old = xb_add(&bar[XB_XSUB(b.x)], 1u);
        const unsigned gen = old / nloc;
        if (old + 1u == (gen + 1u) * nloc) {
            __builtin_amdgcn_fence(__ATOMIC_RELEASE, "agent");
            asm volatile("s_waitcnt vmcnt(0)" ::: "memory");
            const unsigned og = xb_add(&bar[XB_TOP], 1u);
            const unsigned tg = og / nx;
            if (og + 1u == (tg + 1u) * nx) xb_add(&bar[XB_TOPGEN], 1u);
            else XB_SPIN(xb_ld(&bar[XB_TOPGEN]) == tg, bar);
            __builtin_amdgcn_fence(__ATOMIC_ACQUIRE, "agent");
            xb_add(&bar[XB_XGEN(b.x)], 1u);
            asm volatile("s_waitcnt vmcnt(0)" ::: "memory");
        } else {
            XB_SPIN(xb_ld(&bar[XB_XGEN(b.x)]) == gen, bar);
            __builtin_amdgcn_fence(__ATOMIC_ACQUIRE, "agent");
            asm volatile("s_waitcnt vmcnt(0)" ::: "memory");
        }
    }
    __syncthreads();
}

struct Args { const float* in[21]; float* out; unsigned char* ws; int ph_lo, ph_hi; };

__global__ void __launch_bounds__(512, 2) mk_fwd(Args args) {
    extern __shared__ __attribute__((aligned(16))) unsigned char lds_raw[];
    LAS unsigned char* lds = (LAS unsigned char*)lds_raw;
    cg::grid_group grid = cg::this_grid();
    const int tid = threadIdx.x, lane = tid & 63, wave = __builtin_amdgcn_readfirstlane(tid >> 6);
    const int G = gridDim.x, bx = blockIdx.x;
    const int gw = bx * 8 + wave, NGW = G * 8;
    const int NGT = G * 512;
    unsigned char* ws = args.ws;
    const int lo = args.ph_lo, hi = args.ph_hi;
    volatile LAS unsigned* xst = (volatile LAS unsigned*)(lds + LDS_BYTES - 64);
    if (tid < 2) xst[tid] = 0u;
    __syncthreads();
    XcdBarrier xbar; xbar.bar = (unsigned*)(ws + WS_CTL); xbar.x = 0; xbar.st = xst;
    if (!MK_MULTI_LAUNCH) xbar = xcd_barrier_post((unsigned*)(ws + WS_CTL), xst);
#ifndef PH_EN
#define PH_EN 0x3ff
#endif
#ifndef PROBE_REP
#define PROBE_REP 0
#endif
#define REP(b) for (int rep_ = 0; rep_ < 1 + (((PROBE_REP) >> (b)) & 1); ++rep_)
#define IN(k) (lo <= (k) && (k) < hi)
#define EN(b) (((PH_EN) >> (b)) & 1)
#define SEAM(k) do { if (IN(k) && IN((k) + 1)) { if ((k) == 0 || MK_MULTI_LAUNCH) grid.sync(); else xcd_barrier(xbar); } } while (0)

#define WinT ((bf16_t*)(ws_ + WS_WIN))
#define WkvT ((bf16_t*)(ws_ + WS_WKV))
#define WbrT ((bf16_t*)(ws_ + WS_WBR))
#define WoutT ((bf16_t*)(ws_ + WS_WOUT))
#define WfiT ((bf16_t*)(ws_ + WS_WFI))
#define WfoT ((bf16_t*)(ws_ + WS_WFO))
#define MEMKV ((bf16_t*)(ws_ + WS_MEMKV))
#define XB ((bf16_t*)(ws_ + WS_XB))
#define MEMB ((bf16_t*)(ws_ + WS_MEMB))
#define ODIL ((bf16_t*)(ws_ + WS_ODIL))
#define LSE ((float*)(ws_ + WS_LSE))
#define MERGED ((bf16_t*)(ws_ + WS_MERGED))
#define A2 ((bf16_t*)(ws_ + WS_A2))
#define Y3 ((bf16_t*)(ws_ + WS_Y3))
#define SSQ ((float*)(ws_ + WS_SSQ))
#define PROJ ((bf16_t*)(ws_ + WS_PROJ))
#define YF ((bf16_t*)(ws_ + WS_YF))
#define HALO ((bf16_t*)(ws_ + WS_HALO))
#define CCONST ((float*)(ws_ + WS_CTL + 15360))
#define PHASE_LOCALS const Args* ap = &args; size_t zoff_ = 0; asm volatile("" : "+s"(zoff_)); unsigned char* ws_ = ws + zoff_;     int bxl = bx; asm volatile("" : "+s"(bxl)); int tidl = threadIdx.x; asm volatile("" : "+v"(tidl)); const int gtidl = bxl * 512 + tidl; (void)bxl; (void)ws_; (void)ap; (void)gtidl;
    if (EN(0) && IN(0)) REP(0) {
            PHASE_LOCALS
        LAS float* scr = (LAS float*)(lds + wave * 16384);
        constexpr int I_IN = 16 * 304, I_KV = 16 * 32, I_BR = 8 * 32, I_OUT = 16 * 32, I_FI = 16 * 176, I_FO = 44 * 32;
        constexpr int NITEMS = I_IN + I_KV + 3 * I_BR + I_OUT + I_FI + I_FO;
        for (int it = gw; it < NITEMS; it += NGW) {
            int r = it;
            if (r < I_IN) { p0_transpose_item<0>(ap->in[3], 1024, IN_COLS, WinT, 0, scr, r, lane); continue; } r -= I_IN;
            if (r < I_KV) { p0_transpose_item<0>(ap->in[9], 1024, 1024, WkvT, 0, scr, r, lane); continue; } r -= I_KV;
            if (r < I_BR) { p0_transpose_item<0>(ap->in[12], 512, 1024, WbrT, 0, scr, r, lane); continue; } r -= I_BR;
            if (r < I_BR) { p0_transpose_item<0>(ap->in[13], 512, 1024, WbrT, 1024, scr, r, lane); continue; } r -= I_BR;
            if (r < I_BR) { p0_transpose_item<0>(ap->in[14], 512, 1024, WbrT, 2048, scr, r, lane); continue; } r -= I_BR;
            if (r < I_OUT) { p0_transpose_item<0>(ap->in[15], 1024, 1024, WoutT, 0, scr, r, lane); continue; } r -= I_OUT;
            if (r < I_FI) { p0_transpose_item<1>(ap->in[17], 1024, FF2, WfiT, 0, scr, r, lane); continue; } r -= I_FI;
            p0_transpose_item<0>(ap->in[20], D_FF, 1024, WfoT, 0, scr, r, lane);
        }
        for (int i = bx * 512 + tid; i < BATCH * SEQ; i += NGT) SSQ[i] = 0.f;
        if (gw == 0) {
            float cv = 0.f;
            for (int g = 0; g < 3; ++g) { float a = fabsf(args.in[4][g * 64 + lane]), b = fabsf(args.in[5][g * 64 + lane]);
#pragma unroll
                for (int o = 1; o < 64; o <<= 1) { a = fmaxf(a, __shfl_xor(a, o)); b = fmaxf(b, __shfl_xor(b, o)); }
                if (lane == g) cv = 8.f * a * b * LOG2E; }
            { float a = fmaxf(fabsf(args.in[10][lane]), fabsf(args.in[10][64 + lane])), b = fmaxf(fabsf(args.in[11][lane]), fabsf(args.in[11][64 + lane]));
#pragma unroll
                for (int o = 1; o < 64; o <<= 1) { a = fmaxf(a, __shfl_xor(a, o)); b = fmaxf(b, __shfl_xor(b, o)); }
                if (lane == 3) cv = 11.313708499f * a * b * LOG2E; }
            if (lane < 4) CCONST[lane] = cv;
        }
        for (int m = gw; m < BATCH * SEQ; m += 2 * NGW) rms_row2_to_bf16(ap->in[0] + (size_t)m * 1024, ap->in[0] + (size_t)(m + NGW) * 1024, ap->in[2], XB + (size_t)m * 1024, XB + (size_t)(m + NGW) * 1024, lane);
        for (int m = gw; m < BATCH * N_MEM; m += NGW) rms_row_to_bf16(ap->in[1] + (size_t)m * 1024, ap->in[8], MEMB + (size_t)m * 1024, lane);
        __syncthreads();
    }
    SEAM(0);
    if (EN(1) && IN(1)) REP(1) {
            PHASE_LOCALS
        pg8::Gemm g{MEMB, WkvT, BATCH * N_MEM, 1024, 1024}; pg8::StaticOrder S; S.init(g.M, g.N, G, bxl);
        EpiPlainBf16 E{MEMKV, 1024};
        pg8::gemm_phase(lds, g, S, E);
    }
    SEAM(1);
    for (int hf = 0; hf < 2; ++hf) {
        const int P = 2 + 4 * hf;
        if (EN(2) && IN(P + 0)) REP(2) {
            PHASE_LOCALS
            pg8::Gemm g{XB + (size_t)hf * HTOK * 1024, WinT, HTOK, IN_COLS, 1024}; pg8::StaticOrder S; S.init(g.M, g.N, G, bxl);
            EpiProj E{PROJ, ap->in[4], ap->in[5]};
            pg8::gemm_phase(lds, g, S, E);
        }
        SEAM(P + 0);
        if (EN(3) && IN(P + 1)) REP(3) {
            PHASE_LOCALS
            LAS char* vl = (LAS char*)(lds + wave * 8192);
#ifndef ATT_EN
#define ATT_EN 7
#endif
            if (ATT_EN & 1) for (int it = bxl; it < HB * 4 * 16; it += G) ret_u_item(PROJ, XB + (size_t)hf * HTOK * 1024, ap->in[6], it, (LAS char*)lds, tid);
            if (ATT_EN & 2) REP(10) for (int it = gw; it < HB * 8 * 3 * 32; it += NGW) dil_wave(PROJ, ODIL, LSE, CCONST, it, vl, lane);
            __syncthreads();
            if (ATT_EN & 4) REP(11) for (int it = bxl; it < HB * 4 * 4; it += G) mem_item(PROJ, MEMKV + (size_t)hf * HB * N_MEM * 1024, Y3 + (size_t)2 * HTOK * 512, args.in[10], args.in[11], CCONST, it, (LAS char*)lds, tid);
            __syncthreads();
        }
        SEAM(P + 1);
        if (EN(4) && IN(P + 2)) REP(4) {
            PHASE_LOCALS
            for (int it = bxl; it < HB * 4 * 8; it += G) ret_chunk_item(PROJ, XB + (size_t)hf * HTOK * 1024, Y3 + (size_t)1 * HTOK * 512, ap->in[6], ap->in[7], it, (LAS char*)lds, tid);
            for (int idx = gtidl; idx < HTOK * 64; idx += NGT) {
                const int dp = idx & 7, h = (idx >> 3) & 7, tok = idx >> 6;
                const float l0 = LSE[((size_t)0 * HTOK + tok) * 8 + h], l1 = LSE[((size_t)1 * HTOK + tok) * 8 + h], l2 = LSE[((size_t)2 * HTOK + tok) * 8 + h];
                const float mx = fmaxf(l0, fmaxf(l1, l2));
                float w0 = exp2f(l0 - mx), w1 = exp2f(l1 - mx), w2 = exp2f(l2 - mx); const float inv = 1.f / (w0 + w1 + w2); w0 *= inv; w1 *= inv; w2 *= inv;
                const size_t off = (size_t)tok * 512 + h * 64 + dp * 8;
                const u32x4 a = *(const u32x4*)(ODIL + off), b = *(const u32x4*)(ODIL + (size_t)HTOK * 512 + off), c = *(const u32x4*)(ODIL + (size_t)2 * HTOK * 512 + off);
                u32x4 o;
                o.x = pk2(w0 * bflo(a.x) + w1 * bflo(b.x) + w2 * bflo(c.x), w0 * bfhi(a.x) + w1 * bfhi(b.x) + w2 * bfhi(c.x));
                o.y = pk2(w0 * bflo(a.y) + w1 * bflo(b.y) + w2 * bflo(c.y), w0 * bfhi(a.y) + w1 * bfhi(b.y) + w2 * bfhi(c.y));
                o.z = pk2(w0 * bflo(a.z) + w1 * bflo(b.z) + w2 * bflo(c.z), w0 * bfhi(a.z) + w1 * bfhi(b.z) + w2 * bfhi(c.z));
                o.w = pk2(w0 * bflo(a.w) + w1 * bflo(b.w) + w2 * bflo(c.w), w0 * bfhi(a.w) + w1 * bfhi(b.w) + w2 * bfhi(c.w));
                *(u32x4*)(Y3 + off) = o;
            }
        }
        SEAM(P + 2);
        if (EN(5) && IN(P + 3)) REP(5) {
            PHASE_LOCALS
            pg8::Gemm g{Y3, WbrT, 3 * HTOK, 3 * 1024, 512}; pg8::BranchOrder S; S.init(HTOK, 1024, G, bxl);
            EpiBranch E{MERGED + (size_t)hf * HTOK * 1024, PROJ};
            pg8::gemm_phase(lds, g, S, E);
        }
        SEAM(P + 3);
    }
    {
        constexpr int P = 6, NTOK = BATCH * SEQ;
        if (EN(6) && IN(P + 4)) REP(6) {
            PHASE_LOCALS
            pg8::Gemm g{MERGED, WoutT, NTOK, 1024, 1024}; pg8::StaticOrder S; S.init(g.M, g.N, G, bxl);
            EpiOut E{ap->in[0], ap->out, A2, ap->in[16], SSQ};
            pg8::gemm_phase(lds, g, S, E);
        }
        SEAM(P + 4);
        if (EN(7) && IN(P + 5)) REP(7) {
            PHASE_LOCALS
            pg8::Gemm g{A2, WfiT, NTOK, FF2, 1024}; pg8::StaticOrder S; S.init(g.M, g.N, G, bxl);
            EpiFfnInConv E{YF, HALO, SSQ, ap->in[18], ap->in[19]};
            pg8::gemm_phase(lds, g, S, E);
        }
        SEAM(P + 5);
        if (EN(8) && IN(P + 6)) REP(8) {
            PHASE_LOCALS
            const float* cw = ap->in[18]; const float* cb = ap->in[19];
            for (int idx = gtidl; idx < (NTOK / 64) * 2 * 352; idx += NGT) {
                const int cgp = idx % 352, rest = idx / 352, side = rest & 1, blk = rest >> 1, ch = cgp * 8;
                const int row = blk * 64 + (side ? 63 : 0), t = row & (SEQ - 1);
                const bf16_t* hb = HALO + (size_t)blk * 6 * D_FF + ch;
                u32x4 um = {0u, 0u, 0u, 0u}, un = {0u, 0u, 0u, 0u}, uc, gt;
                if (side == 0) { uc = *(const u32x4*)hb; un = *(const u32x4*)(hb + D_FF); gt = *(const u32x4*)(hb + 4 * D_FF); if (t > 0) um = *(const u32x4*)(hb - 6 * D_FF + 3 * D_FF); }
                else { um = *(const u32x4*)(hb + 2 * D_FF); uc = *(const u32x4*)(hb + 3 * D_FF); gt = *(const u32x4*)(hb + 5 * D_FF); if (t < SEQ - 1) un = *(const u32x4*)(hb + 6 * D_FF); }
                float uu[3][8], gg[8];
                const unsigned umw[4] = {um.x, um.y, um.z, um.w}, ucw[4] = {uc.x, uc.y, uc.z, uc.w}, unw[4] = {un.x, un.y, un.z, un.w}, gtw[4] = {gt.x, gt.y, gt.z, gt.w};
#pragma unroll
                for (int q = 0; q < 4; ++q) { uu[0][2 * q] = bflo(umw[q]); uu[0][2 * q + 1] = bfhi(umw[q]); uu[1][2 * q] = bflo(ucw[q]); uu[1][2 * q + 1] = bfhi(ucw[q]);
                    uu[2][2 * q] = bflo(unw[q]); uu[2][2 * q + 1] = bfhi(unw[q]); gg[2 * q] = bflo(gtw[q]); gg[2 * q + 1] = bfhi(gtw[q]); }
                float yv[8];
#pragma unroll
                for (int q2 = 0; q2 < 2; ++q2) {
                    const f32x4 w0 = *(const f32x4*)(cw + ch + 4 * q2), w1 = *(const f32x4*)(cw + D_FF + ch + 4 * q2), w2 = *(const f32x4*)(cw + 2 * D_FF + ch + 4 * q2), bb = *(const f32x4*)(cb + ch + 4 * q2);
#pragma unroll
                    for (int e = 0; e < 4; ++e) { const int k = 4 * q2 + e; const float c = bb[e] + uu[0][k] * w0[e] + uu[1][k] * w1[e] + uu[2][k] * w2[e];
                        yv[k] = gelu_exact(c) * gg[k]; }
                }
                u32x4 o; o.x = pk2(yv[0], yv[1]); o.y = pk2(yv[2], yv[3]); o.z = pk2(yv[4], yv[5]); o.w = pk2(yv[6], yv[7]);
                *(u32x4*)(YF + (size_t)row * D_FF + ch) = o;
            }
        }
        SEAM(P + 6);
        if (EN(9) && IN(P + 7)) REP(9) {
            PHASE_LOCALS
            pg8::Gemm g{YF, WfoT, NTOK, 1024, D_FF}; pg8::StaticOrder S; S.init(g.M, g.N, G, bxl);
            EpiFfnOut E{ap->out};
            pg8::gemm_phase(lds, g, S, E);
        }
    }
#undef IN
#undef SEAM
}

extern "C" void kernel_launch(void* const* d_in, const int* in_sizes, int n_in, void* d_out, int out_size, void* d_ws, size_t ws_size, hipStream_t stream) {
    static int grid = 0;
    if (grid == 0) {
        if (n_in != 21 || out_size != BATCH * SEQ * D_MODEL || ws_size < WS_END) { fprintf(stderr, "kernel_launch: unexpected shapes (n_in %d out %d ws %zu)\n", n_in, out_size, ws_size); grid = -1; return; }
        int dev = 0, cus = 0, per_cu = 0;
        hipGetDevice(&dev); hipDeviceGetAttribute(&cus, hipDeviceAttributeMultiprocessorCount, dev);
        if (hipFuncSetAttribute((const void*)mk_fwd, hipFuncAttributeMaxDynamicSharedMemorySize, LDS_BYTES) != hipSuccess) { fprintf(stderr, "kernel_launch: hipFuncSetAttribute failed\n"); grid = -1; return; }
        if (hipOccupancyMaxActiveBlocksPerMultiprocessor(&per_cu, (const void*)mk_fwd, 512, LDS_BYTES) != hipSuccess || per_cu < 1) { fprintf(stderr, "kernel_launch: occupancy query says %d\n", per_cu); per_cu = 1; }
        (void)hipGetLastError();
        grid = cus * per_cu;
    }
    if (grid < 0) return;
    Args a{};
    for (int i = 0; i < 21; ++i) a.in[i] = (const float*)d_in[i];
    a.out = (float*)d_out; a.ws = (unsigned char*)d_ws;
#if MK_MULTI_LAUNCH
    for (int ph = 0; ph < NPHASE; ++ph) {
        a.ph_lo = ph; a.ph_hi = ph + 1;
        hipLaunchKernelGGL(mk_fwd, dim3(grid), dim3(512), LDS_BYTES, stream, a);
    }
#else
    a.ph_lo = 0; a.ph_hi = NPHASE;
    if (hipMemsetAsync((char*)d_ws + WS_CTL, 0, CTL_BYTES, stream) != hipSuccess) { fprintf(stderr, "kernel_launch: memset of the barrier words failed\n"); return; }
    void* kargs[] = {&a};
    hipError_t e = hipLaunchCooperativeKernel((const void*)mk_fwd, dim3(grid), dim3(512), kargs, LDS_BYTES, stream);
    if (e != hipSuccess) fprintf(stderr, "kernel_launch: cooperative launch failed: %s (grid %d)\n", hipGetErrorString(e), grid);
#endif
}
```

```cpp
#include <hip/hip_runtime.h>
#include <hip/hip_cooperative_groups.h>
#include <cstdio>
namespace cg = cooperative_groups;

#ifndef MK_MULTI_LAUNCH
#define MK_MULTI_LAUNCH 0
#endif

#define LAS __attribute__((address_space(3)))
typedef unsigned short bf16_t;
typedef short bf16x8 __attribute__((ext_vector_type(8)));
typedef short s16x4 __attribute__((ext_vector_type(4)));
typedef float f32x2 __attribute__((ext_vector_type(2)));
typedef float f32x4 __attribute__((ext_vector_type(4)));
typedef float f32x16 __attribute__((ext_vector_type(16)));
typedef unsigned u32x2 __attribute__((ext_vector_type(2)));
typedef unsigned u32x4 __attribute__((ext_vector_type(4)));
typedef __bf16 bf16x2_t __attribute__((ext_vector_type(2)));

constexpr int D_MODEL = 1024, BATCH = 32, SEQ = 2048, N_MEM = 256;
constexpr int HB = 16, HTOK = HB * SEQ;
constexpr int IN_COLS = 9728, RET_OFF = 4608, MEMQ_OFF = 6144, GATE_OFF = 6656;
constexpr int D_FF = 2816, FF2 = 5632;
constexpr float NORM_EPS = 1e-6f;
constexpr float LOG2E = 1.4426950408889634f;
constexpr int NPHASE = 14;

constexpr size_t MiB = 1u << 20;
constexpr size_t WS_WIN = 0;
constexpr size_t WS_WKV = 19 * MiB;
constexpr size_t WS_WBR = 21 * MiB;
constexpr size_t WS_WOUT = 24 * MiB;
constexpr size_t WS_WFI = 26 * MiB;
constexpr size_t WS_WFO = 37 * MiB;
constexpr size_t WS_MEMKV = 43 * MiB;
constexpr size_t WS_XB = 60 * MiB;
constexpr size_t WS_R1 = 188 * MiB;
constexpr size_t WS_MEMB = WS_R1;
constexpr size_t WS_ODIL = WS_R1;
constexpr size_t WS_LSE = WS_R1 + 96 * MiB;
constexpr size_t WS_MERGED = WS_XB;
constexpr size_t WS_A2 = 412 * MiB;
constexpr size_t WS_Y3 = 316 * MiB;
constexpr size_t WS_SSQ = WS_R1 + 100 * MiB;
constexpr size_t WS_HALO = WS_Y3 + 4 * MiB;
constexpr size_t WS_PROJ = 412 * MiB;
constexpr size_t WS_UG = WS_PROJ;
constexpr size_t WS_YF = WS_PROJ + 128 * MiB;
constexpr size_t WS_CTL = 1020 * MiB;
constexpr size_t CTL_BYTES = 16384;
constexpr size_t WS_END = WS_CTL + CTL_BYTES;

constexpr int LDS_BYTES = 147456;

__device__ __forceinline__ unsigned pk2(float a, float b) { f32x2 f = {a, b}; bf16x2_t r = __builtin_convertvector(f, bf16x2_t); return __builtin_bit_cast(unsigned, r); }
__device__ __forceinline__ float bflo(unsigned w) { return __uint_as_float(w << 16); }
__device__ __forceinline__ float bfhi(unsigned w) { return __uint_as_float(w & 0xffff0000u); }
__device__ __forceinline__ float wave_sum(float v) {
#pragma unroll
    for (int o = 1; o < 64; o <<= 1) v += __shfl_xor(v, o);
    return v;
}
__device__ __forceinline__ bf16x8 pack8(float a0, float a1, float a2, float a3, float a4, float a5, float a6, float a7) {
    u32x4 p; p.x = pk2(a0, a1); p.y = pk2(a2, a3); p.z = pk2(a4, a5); p.w = pk2(a6, a7); return __builtin_bit_cast(bf16x8, p);
}
#define MFMA32(a, b, c) __builtin_amdgcn_mfma_f32_32x32x16_bf16((a), (b), (c), 0, 0, 0)
__device__ __forceinline__ s16x4 tr_read(LAS char* p) { return __builtin_amdgcn_ds_read_tr16_b64_v4i16((LAS s16x4*)p); }
__device__ __forceinline__ bf16x8 cat4(s16x4 lo, s16x4 hi) { return __builtin_shufflevector(lo, hi, 0, 1, 2, 3, 4, 5, 6, 7); }
__device__ __forceinline__ int slot_of(int c) { return 128 * ((c >> 5) & 1) + 32 * (c >> 6) + 16 * ((c >> 2) & 1) + 4 * ((c >> 3) & 3) + (c & 3); }

namespace pg8 {
constexpr int BM = 256, BK = 64, HALF = 128, HTB = HALF * BK * 2, NXCD = 8, WGM = 8;
__device__ __forceinline__ int lds_byte(int r, int c) { const int st = (r >> 4) * 2 + (c >> 5), rr = r & 15, cc = c & 31, ob = rr * 64 + cc * 2; return st * 1024 + (ob ^ (((ob >> 9) & 1) << 5)); }
__device__ __forceinline__ void stage_rc(int b, int& R, int& C) { const int st = b / 1024, sb = b % 1024, swz = sb ^ (((sb >> 9) & 1) << 5); R = (st >> 1) * 16 + swz / 64; C = (st & 1) * 32 + (swz % 64) / 2; }
struct Unit { int pm, pn; };
struct Gemm { const bf16_t* A; const bf16_t* Bt; int M, N, K; };
struct StaticOrder {
    int nM, nN, nwg, G, c;
    __device__ void init(int M, int N, int G_, int c_) { nM = M / BM; nN = N / BM; nwg = nM * nN; G = G_; c = c_; }
    __device__ bool next(int i, Unit& u) const {
        const long L = (long)i * G + c; if (L >= nwg) return false;
        int wgid = (int)L; { const int q = nwg / NXCD, r = nwg % NXCD, xcd = wgid % NXCD, off = wgid / NXCD; wgid = (xcd < r ? xcd * (q + 1) : r * (q + 1) + (xcd - r) * q) + off; }
        const int nig = WGM * nN, gid = wgid / nig, fm = gid * WGM, gsz = (nM - fm) < WGM ? (nM - fm) : WGM;
        u.pm = fm + ((wgid % nig) % gsz); u.pn = (wgid % nig) / gsz; return true;
    }
};
struct BranchOrder {
    StaticOrder so;
    __device__ void init(int M, int N, int G_, int c_) { so.init(M, N, G_, c_); }
    __device__ bool next(int i, Unit& u) const { Unit t; if (!so.next(i / 3, t)) return false; const int b = i % 3; u.pm = b * (HTOK / BM) + t.pm; u.pn = b * (D_MODEL / BM) + t.pn; return true; }
};

template <class Epi, class Sched>
__device__ __forceinline__ void gemm_phase(LAS unsigned char* lds, const Gemm g, const Sched& S, const Epi& E) {
    int tid = threadIdx.x; asm volatile("" : "+v"(tid));
    const int wid = __builtin_amdgcn_readfirstlane(tid >> 6), lane = tid & 63, wr = wid >> 2, wc = wid & 3, fr = lane & 15, fq = lane >> 4;
    const int K = g.K, nt = K / BK;
    unsigned voffA[2];
#pragma unroll
    for (int i = 0; i < 2; ++i) { int R, C; stage_rc(tid * 16 + i * 8192, R, C); voffA[i] = (unsigned)(R * K + C) * 2u; }
    const size_t kstep = (size_t)(BK * 2);
    const size_t hstep = (size_t)HALF * K * 2;
    const size_t tstep = 2 * hstep;
    const unsigned ldsw = (unsigned)wid * 1024u;
    const int aoff = lds_byte(wr * 64 + fr, fq * 8), boff = lds_byte(wc * 32 + fr, fq * 8);
#define PG8_SA(b, h) (((b) * 2 + (h)) * HTB)
#define PG8_SB(b, h) ((4 + (b) * 2 + (h)) * HTB)
#define PG8_STAGE(bufoff, gbase) do { _Pragma("unroll") for (int _i = 0; _i < 2; ++_i) \
        __builtin_amdgcn_global_load_lds((const unsigned*)((const char*)(gbase) + voffA[_i]), (LAS unsigned*)(lds + (bufoff) + ldsw + _i * 8192), 16, 0, 0); } while (0)
#define PG8_LDA(dst, b, h) do { _Pragma("unroll") for (int m = 0; m < 4; ++m) _Pragma("unroll") for (int k = 0; k < 2; ++k) dst[m][k] = *(const LAS bf16x8*)(lds + PG8_SA(b, h) + aoff + m * 2048 + k * 1024); } while (0)
#define PG8_LDB(dst, b, h) do { _Pragma("unroll") for (int n = 0; n < 2; ++n) _Pragma("unroll") for (int k = 0; k < 2; ++k) dst[n][k] = *(const LAS bf16x8*)(lds + PG8_SB(b, h) + boff + n * 2048 + k * 1024); } while (0)
#define PG8_MMA(ai, bj, At, Bt) do { __builtin_amdgcn_s_setprio(1); _Pragma("unroll") for (int m = 0; m < 4; ++m) _Pragma("unroll") for (int n = 0; n < 2; ++n) _Pragma("unroll") for (int k = 0; k < 2; ++k) \
        acc[ai][bj][m][n] = __builtin_amdgcn_mfma_f32_16x16x32_bf16(Bt[n][k], At[m][k], acc[ai][bj][m][n], 0, 0, 0); __builtin_amdgcn_s_setprio(0); } while (0)
#define PG8_WAIT_V(n) asm volatile("s_waitcnt vmcnt(" #n ")" ::: "memory")
#define PG8_WAIT_L(n) asm volatile("s_waitcnt lgkmcnt(" #n ")" ::: "memory")
#define PG8_BAR __builtin_amdgcn_s_barrier()
#define PG8_SCHED __builtin_amdgcn_sched_barrier(0)
    Unit cur, nxt; int ui = 0;
    if (!S.next(0, cur)) return;
    f32x4 acc[2][2][4][2];
#pragma unroll
    for (int a = 0; a < 2; ++a)
#pragma unroll
        for (int b = 0; b < 2; ++b)
#pragma unroll
            for (int m = 0; m < 4; ++m)
#pragma unroll
                for (int n = 0; n < 2; ++n) acc[a][b][m][n] = (f32x4){0.f, 0.f, 0.f, 0.f};
    bf16x8 At[4][2], B0[2][2], B1[2][2];
    const char* cA = (const char*)g.A + (size_t)cur.pm * tstep; const char* cB = (const char*)g.Bt + (size_t)cur.pn * tstep;
    PG8_STAGE(PG8_SB(0, 0), cB); PG8_STAGE(PG8_SA(0, 0), cA); PG8_STAGE(PG8_SB(0, 1), cB + hstep); PG8_STAGE(PG8_SA(0, 1), cA + hstep);
    if (wr == 1) PG8_BAR;
    PG8_WAIT_V(4); PG8_BAR;
    PG8_STAGE(PG8_SB(1, 0), cB + kstep); PG8_STAGE(PG8_SA(1, 0), cA + kstep); PG8_STAGE(PG8_SB(1, 1), cB + hstep + kstep);
    PG8_WAIT_V(6); PG8_BAR;
    for (;;) {
        const bool has_next = S.next(ui + 1, nxt);
        const char* nA = has_next ? (const char*)g.A + (size_t)nxt.pm * tstep : cA; const char* nB = has_next ? (const char*)g.Bt + (size_t)nxt.pn * tstep : cB;
        for (int t = 0; t < nt; t += 2) {
            const bool last = (t == nt - 2);
            const char* a1 = cA + (size_t)(t + 1) * kstep;
            const char* a2 = last ? nA : cA + (size_t)(t + 2) * kstep; const char* b2 = last ? nB : cB + (size_t)(t + 2) * kstep;
            const char* a3 = a2 + kstep; const char* b3 = b2 + kstep;
            PG8_LDB(B0, 0, 0); PG8_SCHED; PG8_LDA(At, 0, 0); PG8_STAGE(PG8_SA(1, 1), a1 + hstep);
            PG8_WAIT_L(8); PG8_BAR; PG8_WAIT_L(0); PG8_MMA(0, 0, At, B0); PG8_BAR; PG8_SCHED;
            PG8_LDB(B1, 0, 1); PG8_STAGE(PG8_SB(0, 0), b2);
            PG8_BAR; PG8_WAIT_L(0); PG8_MMA(0, 1, At, B1); PG8_BAR;
            PG8_LDA(At, 0, 1); PG8_STAGE(PG8_SA(0, 0), a2);
            PG8_BAR; PG8_WAIT_L(0); PG8_MMA(1, 0, At, B0); PG8_BAR; PG8_SCHED;
            PG8_STAGE(PG8_SB(0, 1), b2 + hstep);
            PG8_WAIT_V(6); PG8_BAR; PG8_MMA(1, 1, At, B1); PG8_BAR;
            PG8_LDB(B0, 1, 0); PG8_SCHED; PG8_LDA(At, 1, 0); PG8_STAGE(PG8_SA(0, 1), a2 + hstep);
            PG8_WAIT_L(8); PG8_BAR; PG8_WAIT_L(0); PG8_MMA(0, 0, At, B0); PG8_BAR; PG8_SCHED;
            PG8_LDB(B1, 1, 1); PG8_STAGE(PG8_SB(1, 0), b3);
            PG8_BAR; PG8_WAIT_L(0); PG8_MMA(0, 1, At, B1); PG8_BAR;
            PG8_LDA(At, 1, 1); PG8_STAGE(PG8_SA(1, 0), a3);
            PG8_BAR; PG8_WAIT_L(0); PG8_MMA(1, 0, At, B0); PG8_BAR; PG8_SCHED;
            PG8_STAGE(PG8_SB(1, 1), b3 + hstep);
            PG8_WAIT_V(6); PG8_BAR; PG8_MMA(1, 1, At, B1); PG8_BAR;
        }
        E(acc, cur, wr, wc, fr, fq);
        if (!has_next) break;
#pragma unroll
        for (int a = 0; a < 2; ++a)
#pragma unroll
            for (int b = 0; b < 2; ++b)
#pragma unroll
                for (int m = 0; m < 4; ++m)
#pragma unroll
                    for (int n = 0; n < 2; ++n) acc[a][b][m][n] = (f32x4){0.f, 0.f, 0.f, 0.f};
        cur = nxt; cA = nA; cB = nB; ++ui;
    }
    PG8_WAIT_V(0);
    if (wr == 0) PG8_BAR;
    PG8_BAR;
#undef PG8_SA
#undef PG8_SB
#undef PG8_STAGE
#undef PG8_LDA
#undef PG8_LDB
#undef PG8_MMA
#undef PG8_WAIT_V
#undef PG8_WAIT_L
#undef PG8_BAR
#undef PG8_SCHED
}
}
using pg8::Unit;

#define EPI_ROWS_BEGIN _Pragma("unroll") for (int ai = 0; ai < 2; ++ai) _Pragma("unroll") for (int m = 0; m < 4; ++m) { const int rloc = ai * 128 + wr * 64 + m * 16 + fr; float v[16]; \
    _Pragma("unroll") for (int bj = 0; bj < 2; ++bj) _Pragma("unroll") for (int n = 0; n < 2; ++n) _Pragma("unroll") for (int j = 0; j < 4; ++j) v[8 * bj + 4 * n + j] = acc[ai][bj][m][n][j];
#define EPI_ROWS_END }
__device__ __forceinline__ void store16_bf16(bf16_t* p, const float (&v)[16]) {
    u32x4 a, b; a.x = pk2(v[0], v[1]); a.y = pk2(v[2], v[3]); a.z = pk2(v[4], v[5]); a.w = pk2(v[6], v[7]);
    b.x = pk2(v[8], v[9]); b.y = pk2(v[10], v[11]); b.z = pk2(v[12], v[13]); b.w = pk2(v[14], v[15]);
    *(u32x4*)p = a; *(u32x4*)(p + 32) = b;
}
__device__ __forceinline__ void load16_bf16(const bf16_t* p, float (&v)[16]) {
    const u32x4 a = *(const u32x4*)p, b = *(const u32x4*)(p + 32);
    v[0] = bflo(a.x); v[1] = bfhi(a.x); v[2] = bflo(a.y); v[3] = bfhi(a.y); v[4] = bflo(a.z); v[5] = bfhi(a.z); v[6] = bflo(a.w); v[7] = bfhi(a.w);
    v[8] = bflo(b.x); v[9] = bfhi(b.x); v[10] = bflo(b.y); v[11] = bfhi(b.y); v[12] = bflo(b.z); v[13] = bfhi(b.z); v[14] = bflo(b.w); v[15] = bfhi(b.w);
}
__device__ __forceinline__ void load16_f32(const float* p, float (&v)[16]) {
#pragma unroll
    for (int q = 0; q < 4; ++q) { const f32x4 t = *(const f32x4*)(p + 4 * (q & 1) + 32 * (q >> 1)); v[4 * q] = t.x; v[4 * q + 1] = t.y; v[4 * q + 2] = t.z; v[4 * q + 3] = t.w; }
}
__device__ __forceinline__ void store16_f32(float* p, const float (&v)[16]) {
#pragma unroll
    for (int q = 0; q < 4; ++q) *(f32x4*)(p + 4 * (q & 1) + 32 * (q >> 1)) = (f32x4){v[4 * q], v[4 * q + 1], v[4 * q + 2], v[4 * q + 3]};
}
__device__ __forceinline__ void nt_store16(u32x4* p, u32x4 v) { __builtin_nontemporal_store(v, p); }
__device__ __forceinline__ void store16_bf16_nt(bf16_t* p, const float (&v)[16]) {
    u32x4 a, b; a.x = pk2(v[0], v[1]); a.y = pk2(v[2], v[3]); a.z = pk2(v[4], v[5]); a.w = pk2(v[6], v[7]);
    b.x = pk2(v[8], v[9]); b.y = pk2(v[10], v[11]); b.z = pk2(v[12], v[13]); b.w = pk2(v[14], v[15]);
    nt_store16((u32x4*)p, a); nt_store16((u32x4*)(p + 32), b);
}
__device__ __forceinline__ void store16_f32_nt(float* p, const float (&v)[16]) {
#pragma unroll
    for (int q = 0; q < 4; ++q) { f32x4 t = (f32x4){v[4 * q], v[4 * q + 1], v[4 * q + 2], v[4 * q + 3]}; __builtin_nontemporal_store(t, (f32x4*)(p + 4 * (q & 1) + 32 * (q >> 1))); }
}
__device__ __forceinline__ void load16c_bf16(const bf16_t* p, float (&v)[16]) {
    const u32x4 a = *(const u32x4*)p, b = *(const u32x4*)(p + 8);
    v[0] = bflo(a.x); v[1] = bfhi(a.x); v[2] = bflo(a.y); v[3] = bfhi(a.y); v[4] = bflo(a.z); v[5] = bfhi(a.z); v[6] = bflo(a.w); v[7] = bfhi(a.w);
    v[8] = bflo(b.x); v[9] = bfhi(b.x); v[10] = bflo(b.y); v[11] = bfhi(b.y); v[12] = bflo(b.z); v[13] = bfhi(b.z); v[14] = bflo(b.w); v[15] = bfhi(b.w);
}
__device__ __forceinline__ void load16c_f32(const float* p, float (&v)[16]) {
#pragma unroll
    for (int q = 0; q < 4; ++q) { const f32x4 t = *(const f32x4*)(p + 4 * q); v[4 * q] = t.x; v[4 * q + 1] = t.y; v[4 * q + 2] = t.z; v[4 * q + 3] = t.w; }
}

__device__ __forceinline__ size_t pofs(int row, int col) { return ((size_t)((row >> 8) * (IN_COLS / 256) + (col >> 8)) << 16) + (size_t)(((row & 255) << 8) + (col & 255)); }
constexpr float QSCALE_DIL = 0.125f * LOG2E;

struct EpiProj {
    bf16_t* P; const float* gq; const float* gk;
    __device__ __forceinline__ void operator()(const f32x4 (&acc)[2][2][4][2], const Unit& u, int wr, int wc, int fr, int fq) const {
        const int pn = u.pn; int mode = 0; const float* gain = gq; float sc = 1.f;
        if (pn < 18) { const int g = pn / 6, t = (pn % 6) >> 1; if (t == 0) { mode = 1; gain = gq + g * 64; sc = QSCALE_DIL; } else if (t == 1) { mode = 1; gain = gk + g * 64; } }
        else if (pn == 19) { mode = 2; sc = 0.125f; }
        else if (pn == 22 || pn == 23) mode = 4;
        else if (pn >= 26) mode = 3;
        float gv[16];
#pragma unroll
        for (int e = 0; e < 16; ++e) gv[e] = 1.f;
        if (mode == 1) load16_f32(gain + fq * 8, gv);
        const int col0 = pn * 256 + wc * 64 + fq * 8;
        EPI_ROWS_BEGIN
            if (mode == 1) {
                float ss = 0.f;
#pragma unroll
                for (int e = 0; e < 16; ++e) ss += v[e] * v[e];
                ss += __shfl_xor(ss, 16); ss += __shfl_xor(ss, 32);
                const float rs = rsqrtf(ss * (1.f / 64.f) + NORM_EPS) * sc;
#pragma unroll
                for (int e = 0; e < 16; ++e) v[e] = v[e] * rs * gv[e];
            } else if (mode == 2) {
#pragma unroll
                for (int e = 0; e < 16; ++e) v[e] *= sc;
            } else if (mode == 3) {
#pragma unroll
                for (int e = 0; e < 16; ++e) v[e] = __builtin_amdgcn_rcpf(1.f + __builtin_amdgcn_exp2f(-LOG2E * v[e]));
            } else if (mode == 4) {
#pragma unroll
                for (int e = 0; e < 16; ++e) v[e] = v[e] * __builtin_amdgcn_rcpf(1.f + __builtin_amdgcn_exp2f(-LOG2E * v[e]));
            }
            store16_bf16_nt(P + pofs(u.pm * 256 + rloc, col0), v);
        EPI_ROWS_END
    }
};
struct EpiPlainBf16 {
    bf16_t* O; int ldc;
    __device__ __forceinline__ void operator()(const f32x4 (&acc)[2][2][4][2], const Unit& u, int wr, int wc, int fr, int fq) const {
        const int col0 = u.pn * 256 + wc * 64 + fq * 8;
        EPI_ROWS_BEGIN
            store16_bf16(O + (size_t)(u.pm * 256 + rloc) * ldc + col0, v);
        EPI_ROWS_END
    }
};
struct EpiBranch {
    bf16_t* Mg; const bf16_t* P;
    __device__ __forceinline__ void operator()(const f32x4 (&acc)[2][2][4][2], const Unit& u, int wr, int wc, int fr, int fq) const {
        const int b = u.pn >> 2, pn = u.pn & 3, pm = u.pm - b * (HTOK / 256);
        const int col0 = pn * 256 + wc * 64 + fq * 8;
        const float keepw = b == 0 ? 0.f : 1.f;
#pragma unroll
        for (int ai = 0; ai < 2; ++ai)
#pragma unroll
            for (int mp2 = 0; mp2 < 2; ++mp2) {
                u32x4 ga[2][2], oa[2][2];
#pragma unroll
                for (int mm = 0; mm < 2; ++mm) { const int rloc = ai * 128 + wr * 64 + (2 * mp2 + mm) * 16 + fr; const int row = pm * 256 + rloc;
                    const bf16_t* gp = P + pofs(row, GATE_OFF + b * 1024 + col0); const bf16_t* mq = Mg + (size_t)row * D_MODEL + col0;
                    ga[mm][0] = *(const u32x4*)gp; ga[mm][1] = *(const u32x4*)(gp + 32);
                    if (b != 0) { oa[mm][0] = *(const u32x4*)mq; oa[mm][1] = *(const u32x4*)(mq + 32); } else { oa[mm][0] = (u32x4){0u, 0u, 0u, 0u}; oa[mm][1] = (u32x4){0u, 0u, 0u, 0u}; } }
#pragma unroll
                for (int mm = 0; mm < 2; ++mm) { const int m = 2 * mp2 + mm; const int row = pm * 256 + ai * 128 + wr * 64 + m * 16 + fr;
                    bf16_t* mq = Mg + (size_t)row * D_MODEL + col0;
#pragma unroll
                    for (int bj = 0; bj < 2; ++bj) { const u32x4 g = ga[mm][bj], o = oa[mm][bj]; const f32x4 a0 = acc[ai][bj][m][0], a1 = acc[ai][bj][m][1]; u32x4 w;
                        w.x = pk2(keepw * bflo(o.x) + a0[0] * bflo(g.x), keepw * bfhi(o.x) + a0[1] * bfhi(g.x));
                        w.y = pk2(keepw * bflo(o.y) + a0[2] * bflo(g.y), keepw * bfhi(o.y) + a0[3] * bfhi(g.y));
                        w.z = pk2(keepw * bflo(o.z) + a1[0] * bflo(g.z), keepw * bfhi(o.z) + a1[1] * bfhi(g.z));
                        w.w = pk2(keepw * bflo(o.w) + a1[2] * bflo(g.w), keepw * bfhi(o.w) + a1[3] * bfhi(g.w));
                        *(u32x4*)(mq + 32 * bj) = w; } }
            }
    }
};
struct EpiOut {
    const float* X; float* Out; bf16_t* A2; const float* g2; float* ssq;
    __device__ __forceinline__ void operator()(const f32x4 (&acc)[2][2][4][2], const Unit& u, int wr, int wc, int fr, int fq) const {
        const int col0 = u.pn * 256 + wc * 64 + fq * 8;
        float gv[16]; load16_f32(g2 + col0, gv);
#pragma unroll
        for (int ai = 0; ai < 2; ++ai)
#pragma unroll
            for (int mp2 = 0; mp2 < 2; ++mp2) {
                float xv[2][16];
#pragma unroll
                for (int mm = 0; mm < 2; ++mm) load16_f32(X + (size_t)(u.pm * 256 + ai * 128 + wr * 64 + (2 * mp2 + mm) * 16 + fr) * D_MODEL + col0, xv[mm]);
#pragma unroll
                for (int mm = 0; mm < 2; ++mm) { const int m = 2 * mp2 + mm; const size_t row = (size_t)(u.pm * 256 + ai * 128 + wr * 64 + m * 16 + fr);
                    float v[16]; float ss = 0.f;
#pragma unroll
                    for (int bj = 0; bj < 2; ++bj)
#pragma unroll
                        for (int n = 0; n < 2; ++n)
#pragma unroll
                            for (int j = 0; j < 4; ++j) { const int e = 8 * bj + 4 * n + j; v[e] = acc[ai][bj][m][n][j] + xv[mm][e]; ss += v[e] * v[e]; }
                    store16_f32_nt(Out + row * D_MODEL + col0, v);
#pragma unroll
                    for (int e = 0; e < 16; ++e) v[e] *= gv[e];
                    store16_bf16_nt(A2 + row * D_MODEL + col0, v);
                    ss += __shfl_xor(ss, 16); ss += __shfl_xor(ss, 32);
                    if (fq == 0) (void)__hip_atomic_fetch_add(ssq + row, ss, __ATOMIC_RELAXED, __HIP_MEMORY_SCOPE_AGENT); }
            }
    }
};
struct EpiFfnIn {
    bf16_t* UG; const float* ssq;
    __device__ __forceinline__ void operator()(const f32x4 (&acc)[2][2][4][2], const Unit& u, int wr, int wc, int fr, int fq) const {
        const int col0 = u.pn * 256 + wc * 64 + fq * 8;
        EPI_ROWS_BEGIN
            const size_t row = (size_t)(u.pm * 256 + rloc);
            float sp[16]; load16c_f32(ssq + row * 16, sp);
            float ss = 0.f;
#pragma unroll
            for (int e = 0; e < 16; ++e) ss += sp[e];
            const float rs = rsqrtf(ss * (1.f / 1024.f) + NORM_EPS);
#pragma unroll
            for (int e = 0; e < 16; ++e) v[e] *= rs;
            store16_bf16(UG + row * FF2 + col0, v);
        EPI_ROWS_END
    }
};
__device__ __forceinline__ float gelu_exact(float v) {
    const float t = __builtin_amdgcn_rcpf(fabsf(v) * 0.2316418882f + 1.0f);
    float q = t * 0.5307027145f + (-0.7265760135f); q = q * t + 0.7107068705f; q = q * t + (-0.142248368f); q = q * t + 0.127414796f; q = q * t;
    const float e = __builtin_amdgcn_exp2f(v * v * (-0.72134752044f));
    const float m = v * (q * e);
    return v < 0.f ? m : v - m;
}
__device__ __forceinline__ f32x2 gelu_pk(f32x2 v) {
    const f32x2 av = __builtin_elementwise_abs(v), d = av * 0.2316418882f + 1.0f;
    f32x2 t; t.x = __builtin_amdgcn_rcpf(d.x); t.y = __builtin_amdgcn_rcpf(d.y);
    f32x2 q = t * 0.5307027145f + (-0.7265760135f); q = q * t + 0.7107068705f; q = q * t + (-0.142248368f); q = q * t + 0.127414796f; q = q * t;
    const f32x2 sq = (v * v) * (-0.72134752044f);
    f32x2 e; e.x = __builtin_amdgcn_exp2f(sq.x); e.y = __builtin_amdgcn_exp2f(sq.y);
    const f32x2 m = v * (q * e), r = v - m;
    f32x2 o; o.x = v.x < 0.f ? m.x : r.x; o.y = v.y < 0.f ? m.y : r.y; return o;
}
struct EpiFfnInConv {
    bf16_t* YF; bf16_t* HALO; const float* ssq; const float* cw; const float* cb;
    __device__ __forceinline__ void operator()(const f32x4 (&acc)[2][2][4][2], const Unit& u, int wr, int wc, int fr, int fq) const {
        const int lane = fq * 16 + fr, chb = u.pn * 128 + wc * 32 + fq * 8;
        (void)lane;
        float rsa[2][4]; f32x4 wv[2][4];
#pragma unroll
        for (int ai = 0; ai < 2; ++ai)
#pragma unroll
            for (int m = 0; m < 4; ++m) rsa[ai][m] = ssq[(unsigned)(u.pm * 256 + ai * 128 + wr * 64 + m * 16 + fr)];
#pragma unroll
        for (int n = 0; n < 2; ++n) { wv[n][0] = *(const f32x4*)(cw + chb + 4 * n); wv[n][1] = *(const f32x4*)(cw + D_FF + chb + 4 * n); wv[n][2] = *(const f32x4*)(cw + 2 * D_FF + chb + 4 * n); wv[n][3] = *(const f32x4*)(cb + chb + 4 * n); }
#pragma unroll
        for (int ai = 0; ai < 2; ++ai) {
            float rs[4];
#pragma unroll
            for (int m = 0; m < 4; ++m) rs[m] = rsqrtf(rsa[ai][m] * (1.f / 1024.f) + NORM_EPS);
            const int blk = u.pm * 4 + 2 * ai + wr;
            u32x2 keep[4];
#pragma unroll
            for (int n = 0; n < 2; ++n) {
                const f32x4 w0 = wv[n][0], w1 = wv[n][1], w2 = wv[n][2], bb = wv[n][3];
#pragma unroll
                for (int m = 0; m < 4; ++m) {
                    float yv[4], uc[4], gc[4];
#pragma unroll
                    for (int j = 0; j < 4; ++j) {
                        const float ucur = acc[ai][0][m][n][j] * rs[m];
                        const float um1 = m > 0 ? acc[ai][0][m > 0 ? m - 1 : 0][n][j] * rs[m > 0 ? m - 1 : 0] : 0.f;
                        const float up1 = m < 3 ? acc[ai][0][m < 3 ? m + 1 : 3][n][j] * rs[m < 3 ? m + 1 : 3] : 0.f;
                        const float uprev = __builtin_bit_cast(float, __builtin_amdgcn_update_dpp(0, __builtin_bit_cast(int, fr == 15 ? um1 : ucur), 0x121, 0xf, 0xf, false));
                        const float unext = __builtin_bit_cast(float, __builtin_amdgcn_update_dpp(0, __builtin_bit_cast(int, fr == 0 ? up1 : ucur), 0x12F, 0xf, 0xf, false));
                        yv[j] = bb[j] + w0[j] * uprev + w1[j] * ucur + w2[j] * unext;
                        uc[j] = ucur; gc[j] = acc[ai][1][m][n][j] * rs[m];
                    }
                    { const f32x2 g01 = gelu_pk((f32x2){yv[0], yv[1]}), g23 = gelu_pk((f32x2){yv[2], yv[3]});
                      yv[0] = g01.x * gc[0]; yv[1] = g01.y * gc[1]; yv[2] = g23.x * gc[2]; yv[3] = g23.y * gc[3]; }
                    const unsigned row = (unsigned)(u.pm * 256 + ai * 128 + wr * 64 + m * 16 + fr);
                    const bool e0 = (m == 0 && fr == 0), e63 = (m == 3 && fr == 15);
                    { u32x2 o; o.x = pk2(yv[0], yv[1]); o.y = pk2(yv[2], yv[3]);
                      if (n == 0) keep[m] = o;
                      else if (!(e0 || e63)) { u32x4 o4; o4.x = keep[m].x; o4.y = keep[m].y; o4.z = o.x; o4.w = o.y; __builtin_nontemporal_store(o4, (u32x4*)(YF + (row * (unsigned)D_FF + (unsigned)chb))); } }
                    if (m == 0 || m == 3) {
                        const int hs = m == 0 ? (fr == 0 ? 0 : (fr == 1 ? 1 : -1)) : (fr == 14 ? 2 : (fr == 15 ? 3 : -1));
                        if (hs >= 0) { u32x2 o; o.x = pk2(uc[0], uc[1]); o.y = pk2(uc[2], uc[3]); *(u32x2*)(HALO + ((unsigned)(blk * 6 + hs) * (unsigned)D_FF + (unsigned)(chb + 4 * n))) = o; }
                        if (e0 || e63) { u32x2 o; o.x = pk2(gc[0], gc[1]); o.y = pk2(gc[2], gc[3]); *(u32x2*)(HALO + ((unsigned)(blk * 6 + (e0 ? 4 : 5)) * (unsigned)D_FF + (unsigned)(chb + 4 * n))) = o; }
                    }
                    asm volatile("" ::: "memory");
                }
            }
        }
    }
};
struct EpiFfnOut {
    float* Out;
    __device__ __forceinline__ void operator()(const f32x4 (&acc)[2][2][4][2], const Unit& u, int wr, int wc, int fr, int fq) const {
        const int col0 = u.pn * 256 + wc * 64 + fq * 8;
#pragma unroll
        for (int ai = 0; ai < 2; ++ai)
#pragma unroll
            for (int mp2 = 0; mp2 < 2; ++mp2) {
                float xv[2][16];
#pragma unroll
                for (int mm = 0; mm < 2; ++mm) load16_f32(Out + (size_t)(u.pm * 256 + ai * 128 + wr * 64 + (2 * mp2 + mm) * 16 + fr) * D_MODEL + col0, xv[mm]);
#pragma unroll
                for (int mm = 0; mm < 2; ++mm) { const int m = 2 * mp2 + mm; float v[16];
#pragma unroll
                    for (int bj = 0; bj < 2; ++bj)
#pragma unroll
                        for (int n = 0; n < 2; ++n)
#pragma unroll
                            for (int j = 0; j < 4; ++j) { const int e = 8 * bj + 4 * n + j; v[e] = acc[ai][bj][m][n][j] + xv[mm][e]; }
                    store16_f32_nt(Out + (size_t)(u.pm * 256 + ai * 128 + wr * 64 + m * 16 + fr) * D_MODEL + col0, v); }
            }
    }
};

__device__ __forceinline__ int ffn_row_of(int ng) { const int gate = ng >= D_FF ? 1 : 0, ch = ng - gate * D_FF, c7 = ch & 127;
    return (ch >> 7) * 256 + 128 * gate + 32 * (c7 >> 5) + 16 * ((c7 >> 2) & 1) + 4 * ((c7 >> 3) & 3) + (c7 & 3); }
template <int PERMMODE>
__device__ __forceinline__ void p0_transpose_item(const float* W, int K, int N, bf16_t* WT, int row_off, LAS float* scr, int item, int lane) {
    const int nblk = N / 32, kb = item / nblk, nb = item % nblk, k0 = 64 * kb, n0 = 32 * nb;
#pragma unroll 8
    for (int i = 0; i < 32; ++i) { const int kk = 2 * i + (lane >> 5); scr[kk * 33 + (lane & 31)] = W[(size_t)(k0 + kk) * N + n0 + (lane & 31)]; }
    asm volatile("s_waitcnt lgkmcnt(0)" ::: "memory");
    const int c = lane & 7;
#pragma unroll
    for (int j = 0; j < 4; ++j) { const int n = (lane >> 3) + 8 * j; const LAS float* s = scr + (8 * c) * 33 + n;
        u32x4 o; o.x = pk2(s[0 * 33], s[1 * 33]); o.y = pk2(s[2 * 33], s[3 * 33]); o.z = pk2(s[4 * 33], s[5 * 33]); o.w = pk2(s[6 * 33], s[7 * 33]);
        const int ng = n0 + n, nrow = PERMMODE == 1 ? ffn_row_of(ng) : (ng & ~255) + slot_of(ng & 255);
        *(u32x4*)(WT + (size_t)(row_off + nrow) * K + k0 + 8 * c) = o; }
    asm volatile("s_waitcnt lgkmcnt(0)" ::: "memory");
}
__device__ __forceinline__ void rms_row_to_bf16(const float* xrow, const float* g, bf16_t* orow, int lane) {
    const f32x4* xr = (const f32x4*)xrow + lane; const f32x4* gr = (const f32x4*)g + lane;
    f32x4 v[4]; float s = 0.f;
#pragma unroll
    for (int j = 0; j < 4; ++j) { v[j] = xr[64 * j]; s += (v[j].x * v[j].x + v[j].y * v[j].y) + (v[j].z * v[j].z + v[j].w * v[j].w); }
    const float rs = rsqrtf(wave_sum(s) * (1.f / 1024.f) + NORM_EPS);
    u32x2* o8 = (u32x2*)orow + lane;
#pragma unroll
    for (int j = 0; j < 4; ++j) { const f32x4 gg = gr[64 * j]; u32x2 w; w.x = pk2(v[j].x * rs * gg.x, v[j].y * rs * gg.y); w.y = pk2(v[j].z * rs * gg.z, v[j].w * rs * gg.w); o8[64 * j] = w; }
}

__device__ __forceinline__ void rms_row2_to_bf16(const float* xa, const float* xb, const float* g, bf16_t* oa, bf16_t* ob, int lane) {
    const f32x4* ra = (const f32x4*)xa + lane; const f32x4* rb = (const f32x4*)xb + lane; const f32x4* gr = (const f32x4*)g + lane;
    f32x4 va[4], vb[4]; float sa = 0.f, sb = 0.f;
#pragma unroll
    for (int j = 0; j < 4; ++j) { va[j] = ra[64 * j]; vb[j] = rb[64 * j]; }
#pragma unroll
    for (int j = 0; j < 4; ++j) { sa += (va[j].x * va[j].x + va[j].y * va[j].y) + (va[j].z * va[j].z + va[j].w * va[j].w); sb += (vb[j].x * vb[j].x + vb[j].y * vb[j].y) + (vb[j].z * vb[j].z + vb[j].w * vb[j].w); }
#pragma unroll
    for (int o = 1; o < 64; o <<= 1) { sa += __shfl_xor(sa, o); sb += __shfl_xor(sb, o); }
    const float rsa = rsqrtf(sa * (1.f / 1024.f) + NORM_EPS), rsb = rsqrtf(sb * (1.f / 1024.f) + NORM_EPS);
    u32x2* o8a = (u32x2*)oa + lane; u32x2* o8b = (u32x2*)ob + lane;
#pragma unroll
    for (int j = 0; j < 4; ++j) { const f32x4 gg = gr[64 * j]; u32x2 w;
        w.x = pk2(va[j].x * rsa * gg.x, va[j].y * rsa * gg.y); w.y = pk2(va[j].z * rsa * gg.z, va[j].w * rsa * gg.w); o8a[64 * j] = w;
        w.x = pk2(vb[j].x * rsb * gg.x, vb[j].y * rsb * gg.y); w.y = pk2(vb[j].z * rsb * gg.z, vb[j].w * rsb * gg.w); o8b[64 * j] = w; }
}


__device__ __forceinline__ void dil_wave(const bf16_t* proj, bf16_t* odil, float* lse, const float* cconst, int item, LAS char* vl, int lane) {
    asm volatile("" : "+v"(lane));
    const int qb = item & 31; int t = item >> 5; const int g = t % 3; t /= 3; const int h = t & 7, b = t >> 3;
    const float cshift = cconst[g];
    const int lr = 2 * g, r = 1 << lr, nsub = SEQ >> lr, nblk = nsub >> 6;
    const int c = qb / nblk, nb = qb % nblk, i0 = nb * 64;
    const int rr = lane & 31, hh = lane >> 5;
    const int rowb = b * SEQ;
    const int qcol = g * 1536 + h * 64, kcol = qcol + 512, vcol = qcol + 1024;
    const int kt_lo = i0 == 0 ? 2 : 0, kt_hi = (i0 == nsub - 64) ? 4 : 6;
    bf16x8 kn[4];
#define DIL_ISSUE(KT) do { const int j0_ = i0 - 64 + 32 * (KT); \
        { int jr = j0_ + rr; jr = jr < 0 ? 0 : (jr >= nsub ? nsub - 1 : jr); const bf16_t* p = proj + pofs(rowb + jr * r + c, kcol + 32 * hh); \
          _Pragma("unroll") for (int ks = 0; ks < 4; ++ks) kn[ks] = *(const bf16x8*)(p + 8 * ks); } \
        _Pragma("unroll") for (int q = 0; q < 4; ++q) { int jv = j0_ + 8 * q + (lane >> 3); jv = jv < 0 ? 0 : (jv >= nsub ? nsub - 1 : jv); \
          __builtin_amdgcn_global_load_lds((const unsigned*)(proj + pofs(rowb + jv * r + c, vcol + 8 * (lane & 7))), (LAS unsigned*)(vl + 4096 * ((KT) & 1) + 1024 * q), 16, 0, 0); } } while (0)
    DIL_ISSUE(kt_lo);
    bf16x8 qf[2][4];
#pragma unroll
    for (int qt = 0; qt < 2; ++qt) { const int tok = (i0 + 32 * qt + rr) * r + c; const bf16_t* p = proj + pofs(rowb + tok, qcol + 32 * hh);
#pragma unroll
        for (int ks = 0; ks < 4; ++ks) qf[qt][ks] = *(const bf16x8*)(p + 8 * ks); }
    f32x16 o[2][2];
#pragma unroll
    for (int a = 0; a < 2; ++a)
#pragma unroll
        for (int q = 0; q < 2; ++q)
#pragma unroll
            for (int e = 0; e < 16; ++e) o[a][q][e] = 0.f;
    float lrun[2] = {0.f, 0.f};
    const float slope2 = exp2f(-(float)(h + 1)) * (float)r * LOG2E;
    const int blk = (lane >> 4) & 1, q4 = (lane & 15) >> 2, p4 = lane & 3;
    float fd[16];
#pragma unroll
    for (int e = 0; e < 16; ++e) fd[e] = (float)(rr - 4 * hh - ((e & 3) + 8 * (e >> 2)));
#ifdef PROBE_DILLOOP
    for (int rep = 0; rep < 2; ++rep) {
    if (rep) { DIL_ISSUE(kt_lo); lrun[0] = 0.f; lrun[1] = 0.f;
        _Pragma("unroll") for (int a = 0; a < 2; ++a) _Pragma("unroll") for (int q = 0; q < 2; ++q) _Pragma("unroll") for (int e = 0; e < 16; ++e) o[a][q][e] = 0.f; }
#endif
    for (int kt = kt_lo; kt < kt_hi; ++kt) {
        asm volatile("s_waitcnt vmcnt(0)" ::: "memory");
        bf16x8 kf[4];
#pragma unroll
        for (int ks = 0; ks < 4; ++ks) kf[ks] = kn[ks];
        if (kt + 1 < kt_hi) DIL_ISSUE(kt + 1);
        asm volatile("" ::: "memory");
        LAS char* vb = vl + 4096 * (kt & 1);
        bf16x8 pf[2][2];
        bool act[2];
#pragma unroll
        for (int qt = 0; qt < 2; ++qt) {
            const int mrel = kt - qt;
            act[qt] = !(mrel == 5 || mrel == -1);
            if (!act[qt]) continue;
            f32x16 s;
#pragma unroll
            for (int e = 0; e < 16; ++e) s[e] = -cshift;
#pragma unroll
            for (int ks = 0; ks < 4; ++ks) s = MFMA32(kf[ks], qf[qt][ks], s);
            const float Df = 64.f - 32.f * (float)mrel;
            const bool edge = (mrel == 0) || (mrel == 4);
            float rs = 0.f;
#pragma unroll
            for (int e = 0; e < 16; ++e) { const float tt = Df + fd[e]; float sv = fmaf(-slope2, fabsf(tt), s[e]);
                if (edge) sv = fabsf(tt) <= 64.f ? sv : -INFINITY;
                const float p = __builtin_amdgcn_exp2f(sv); s[e] = p; rs += p; }
            lrun[qt] += rs;
#pragma unroll
            for (int s2 = 0; s2 < 2; ++s2) pf[qt][s2] = pack8(s[8 * s2], s[8 * s2 + 1], s[8 * s2 + 2], s[8 * s2 + 3], s[8 * s2 + 4], s[8 * s2 + 5], s[8 * s2 + 6], s[8 * s2 + 7]);
        }
#pragma unroll
        for (int dt = 0; dt < 2; ++dt)
#pragma unroll
            for (int s2 = 0; s2 < 2; ++s2) {
                LAS char* a = vb + (16 * s2 + 4 * hh + q4) * 128 + (32 * dt + 16 * blk + 4 * p4) * 2;
                const bf16x8 vf = cat4(tr_read(a), tr_read(a + 8 * 128));
#pragma unroll
                for (int qt = 0; qt < 2; ++qt) if (act[qt]) o[dt][qt] = MFMA32(vf, pf[qt][s2], o[dt][qt]);
            }
        asm volatile("" ::: "memory");
    }
#ifdef PROBE_DILLOOP
    }
#endif
#undef DIL_ISSUE
#pragma unroll
    for (int qt = 0; qt < 2; ++qt) {
        const float lt = lrun[qt] + __shfl_xor(lrun[qt], 32);
        const int row = 32 * qt + rr; const float inv = __builtin_amdgcn_rcpf(lt);
#pragma unroll
        for (int dt = 0; dt < 2; ++dt)
#pragma unroll
            for (int gq = 0; gq < 4; ++gq) { u32x2 w; w.x = pk2(o[dt][qt][4 * gq] * inv, o[dt][qt][4 * gq + 1] * inv); w.y = pk2(o[dt][qt][4 * gq + 2] * inv, o[dt][qt][4 * gq + 3] * inv);
                *(LAS u32x2*)(vl + row * 128 + 16 * ((4 * dt + gq) ^ (row & 7)) + 8 * hh) = w; }
        if (hh == 0) lse[((size_t)g * HTOK + (size_t)b * SEQ + (i0 + row) * r + c) * 8 + h] = log2f(lt) + cshift;
    }
    asm volatile("" ::: "memory");
    { bf16_t* ob = odil + ((size_t)g * HTOK + (size_t)b * SEQ) * 512 + h * 64;
#pragma unroll
        for (int q = 0; q < 8; ++q) { const int row = 8 * q + (lane >> 3), pos = lane & 7, ch = pos ^ (row & 7);
            const u32x4 v = *(const LAS u32x4*)(vl + row * 128 + 16 * pos);
            *(u32x4*)(ob + (size_t)((i0 + row) * r + c) * 512 + 8 * ch) = v; } }
    asm volatile("" ::: "memory");
}

__device__ __forceinline__ void ret_u_item(const bf16_t* proj, bf16_t* U, const float* decay_logit, int item, LAS char* L, int tid) {
    asm volatile("" : "+v"(tid));
    const int n = item & 15, h = (item >> 4) & 3, b = item >> 6;
    const int lane = tid & 63, wave = tid >> 6, rr = lane & 31, hh = lane >> 5, blk = (lane >> 4) & 1, q4 = (lane & 15) >> 2, p4 = lane & 3;
    const float Lf = -log1pf(expf(-decay_logit[h])) * LOG2E, Lb = -log1pf(expf(-decay_logit[4 + h])) * LOG2E;
    const int rowb = b * SEQ + 128 * n;
    { const int row = tid >> 2, pc = tid & 3; const bf16_t* p = proj + pofs(rowb + row, RET_OFF + 256 + h * 64 + 16 * pc);
        const u32x4 a = *(const u32x4*)p, c = *(const u32x4*)(p + 8);
        const float wf = exp2f(Lf * (float)(127 - row)), wb = exp2f(Lb * (float)row);
        u32x4 o;
        o.x = pk2(bflo(a.x) * wf, bfhi(a.x) * wf); o.y = pk2(bflo(a.y) * wf, bfhi(a.y) * wf); o.z = pk2(bflo(a.z) * wf, bfhi(a.z) * wf); o.w = pk2(bflo(a.w) * wf, bfhi(a.w) * wf);
        *(LAS u32x4*)(L + row * 128 + 32 * pc) = o;
        o.x = pk2(bflo(c.x) * wf, bfhi(c.x) * wf); o.y = pk2(bflo(c.y) * wf, bfhi(c.y) * wf); o.z = pk2(bflo(c.z) * wf, bfhi(c.z) * wf); o.w = pk2(bflo(c.w) * wf, bfhi(c.w) * wf);
        *(LAS u32x4*)(L + row * 128 + 32 * pc + 16) = o;
        o.x = pk2(bflo(a.x) * wb, bfhi(a.x) * wb); o.y = pk2(bflo(a.y) * wb, bfhi(a.y) * wb); o.z = pk2(bflo(a.z) * wb, bfhi(a.z) * wb); o.w = pk2(bflo(a.w) * wb, bfhi(a.w) * wb);
        *(LAS u32x4*)(L + 16384 + row * 128 + 32 * pc) = o;
        o.x = pk2(bflo(c.x) * wb, bfhi(c.x) * wb); o.y = pk2(bflo(c.y) * wb, bfhi(c.y) * wb); o.z = pk2(bflo(c.z) * wb, bfhi(c.z) * wb); o.w = pk2(bflo(c.w) * wb, bfhi(c.w) * wb);
        *(LAS u32x4*)(L + 16384 + row * 128 + 32 * pc + 16) = o; }
#pragma unroll
    for (int q = 0; q < 4; ++q) { const int idx = tid + 512 * q, row = idx >> 4, pc = idx & 15;
        *(LAS u32x4*)(L + 32768 + row * 256 + 16 * pc) = *(const u32x4*)(proj + pofs(rowb + row, RET_OFF + 512 + h * 128 + 8 * pc)); }
    __syncthreads();
    const int dir = wave >> 2, vt = wave & 3;
    f32x16 acc[2];
#pragma unroll
    for (int a = 0; a < 2; ++a)
#pragma unroll
        for (int e = 0; e < 16; ++e) acc[a][e] = 0.f;
    LAS char* KI = L + 16384 * dir; LAS char* VI = L + 32768;
#pragma unroll
    for (int ks = 0; ks < 8; ++ks) {
        const int jrow = 16 * ks + 8 * hh + q4;
        LAS char* vb = VI + jrow * 256 + (32 * vt + 16 * blk + 4 * p4) * 2;
        const bf16x8 bfr = cat4(tr_read(vb), tr_read(vb + 4 * 256));
#pragma unroll
        for (int dt = 0; dt < 2; ++dt) { LAS char* ka = KI + jrow * 128 + (32 * dt + 16 * blk + 4 * p4) * 2;
            const bf16x8 afr = cat4(tr_read(ka), tr_read(ka + 4 * 128));
            acc[dt] = MFMA32(afr, bfr, acc[dt]); }
    }
    bf16_t* up = U + ((size_t)((b * 4 + h) * 16 + n) * 2 + dir) * 8192;
#pragma unroll
    for (int dt = 0; dt < 2; ++dt)
#pragma unroll
        for (int e = 0; e < 16; ++e) up[(32 * dt + (e & 3) + 8 * (e >> 2) + 4 * hh) * 128 + 32 * vt + rr] = (bf16_t)(pk2(acc[dt][e], 0.f) & 0xffffu);
    __syncthreads();
}
__device__ __forceinline__ bf16x8 scale_frag(bf16x8 f, float sc) {
    const u32x4 w = __builtin_bit_cast(u32x4, f);
    return pack8(bflo(w.x) * sc, bfhi(w.x) * sc, bflo(w.y) * sc, bfhi(w.y) * sc, bflo(w.z) * sc, bfhi(w.z) * sc, bflo(w.w) * sc, bfhi(w.w) * sc);
}
__device__ __forceinline__ void st16_lds_bf16(LAS char* p, const float (&v)[16]) {
    u32x4 a, b; a.x = pk2(v[0], v[1]); a.y = pk2(v[2], v[3]); a.z = pk2(v[4], v[5]); a.w = pk2(v[6], v[7]);
    b.x = pk2(v[8], v[9]); b.y = pk2(v[10], v[11]); b.z = pk2(v[12], v[13]); b.w = pk2(v[14], v[15]);
    *(LAS u32x4*)p = a; *(LAS u32x4*)(p + 16) = b;
}
__device__ __forceinline__ void ret_chunk_item(const bf16_t* proj, const bf16_t* U, bf16_t* yret, const float* decay_logit, const float* gn_g, int item, LAS char* L, int tid) {
    asm volatile("" : "+v"(tid));
    const int pr = item & 7, h = (item >> 3) & 3, b = item >> 5, n = 2 * pr;
    const int lane = tid & 63, wave = tid >> 6, rr = lane & 31, hh = lane >> 5, blk = (lane >> 4) & 1, q4 = (lane & 15) >> 2, p4 = lane & 3;
    const float Lf = -log1pf(expf(-decay_logit[h])) * LOG2E, Lb = -log1pf(expf(-decay_logit[4 + h])) * LOG2E;
    const int rowb = b * SEQ + 128 * n;
#pragma unroll
    for (int q = 0; q < 8; ++q) { const int idx = tid + 512 * q, row = idx >> 4, pc = idx & 15;
        *(LAS u32x4*)(L + row * 256 + 16 * pc) = *(const u32x4*)(proj + pofs(rowb + row, RET_OFF + 512 + h * 128 + 8 * pc)); }
    { const bf16_t* Ub = U + (size_t)((b * 4 + h) * 16) * 2 * 8192 + tid * 16;
        const float wf = exp2f(128.f * Lf), wb = exp2f(128.f * Lb);
        const int d = tid >> 3, v0 = (tid & 7) * 16;
        LAS char* S = L + 65536 + d * 256 + v0 * 2;
        float acc[16], t[16];
#pragma unroll
        for (int e = 0; e < 16; ++e) acc[e] = 0.f;
        for (int m0 = n - 4 * ((n + 3) >> 2); m0 < n; m0 += 4) {
            float t4[4][16];
#pragma unroll
            for (int u4 = 0; u4 < 4; ++u4) { const int m = m0 + u4; load16c_bf16(Ub + (size_t)((m < 0 ? 0 : m) * 2) * 8192, t4[u4]); }
#pragma unroll
            for (int u4 = 0; u4 < 4; ++u4) { const float msk = (m0 + u4) < 0 ? 0.f : 1.f;
#pragma unroll
                for (int e = 0; e < 16; ++e) acc[e] = acc[e] * wf + t4[u4][e] * msk; } }
        st16_lds_bf16(S, acc);
        load16c_bf16(Ub + (size_t)(n * 2) * 8192, t);
#pragma unroll
        for (int e = 0; e < 16; ++e) acc[e] = acc[e] * wf + t[e];
        st16_lds_bf16(S + 2 * 16384, acc);
#pragma unroll
        for (int e = 0; e < 16; ++e) acc[e] = 0.f;
        { const int cnt = 14 - n;
          for (int m0 = 15 + 4 * ((cnt + 3) >> 2) - cnt; m0 > 15 - cnt; m0 -= 4) {
            float t4[4][16];
#pragma unroll
            for (int u4 = 0; u4 < 4; ++u4) { const int m = m0 - u4; load16c_bf16(Ub + (size_t)((m > 15 ? 15 : m) * 2 + 1) * 8192, t4[u4]); }
#pragma unroll
            for (int u4 = 0; u4 < 4; ++u4) { const float msk = (m0 - u4) > 15 ? 0.f : 1.f;
#pragma unroll
                for (int e = 0; e < 16; ++e) acc[e] = acc[e] * wb + t4[u4][e] * msk; } } }
        st16_lds_bf16(S + 3 * 16384, acc);
        load16c_bf16(Ub + (size_t)((n + 1) * 2 + 1) * 8192, t);
#pragma unroll
        for (int e = 0; e < 16; ++e) acc[e] = acc[e] * wb + t[e];
        st16_lds_bf16(S + 1 * 16384, acc);
    }
    __syncthreads();
    const int cw = wave >> 2, i = 32 * (wave & 3) + rr;
    const int crow = rowb + 128 * cw;
    bf16x8 qf[4];
    { const bf16_t* p = proj + pofs(crow + i, RET_OFF + h * 64 + 32 * hh);
#pragma unroll
        for (int ks = 0; ks < 4; ++ks) qf[ks] = *(const bf16x8*)(p + 8 * ks); }
    f32x16 y[4];
#pragma unroll
    for (int a = 0; a < 4; ++a)
#pragma unroll
        for (int e = 0; e < 16; ++e) y[a][e] = 0.f;
    LAS char* VI = L + cw * 32768;
#pragma unroll
    for (int kt = 0; kt < 4; ++kt) {
        const int j0 = 32 * kt;
        bf16x8 kf[4];
        { const bf16_t* p = proj + pofs(crow + j0 + rr, RET_OFF + 256 + h * 64 + 32 * hh);
#pragma unroll
            for (int ks = 0; ks < 4; ++ks) kf[ks] = *(const bf16x8*)(p + 8 * ks); }
        f32x16 s;
#pragma unroll
        for (int e = 0; e < 16; ++e) s[e] = 0.f;
#pragma unroll
        for (int ks = 0; ks < 4; ++ks) s = MFMA32(kf[ks], qf[ks], s);
#pragma unroll
        for (int e = 0; e < 16; ++e) { const int j = j0 + (e & 3) + 8 * (e >> 2) + 4 * hh; const int dd = i - j;
            const float w = dd >= 0 ? exp2f(Lf * (float)dd) : exp2f(Lb * (float)(-dd)); s[e] *= w; }
        bf16x8 pf[2];
#pragma unroll
        for (int s2 = 0; s2 < 2; ++s2) pf[s2] = pack8(s[8 * s2], s[8 * s2 + 1], s[8 * s2 + 2], s[8 * s2 + 3], s[8 * s2 + 4], s[8 * s2 + 5], s[8 * s2 + 6], s[8 * s2 + 7]);
#pragma unroll
        for (int vt = 0; vt < 4; ++vt)
#pragma unroll
            for (int s2 = 0; s2 < 2; ++s2) {
                LAS char* a = VI + (j0 + 16 * s2 + 4 * hh + q4) * 256 + (32 * vt + 16 * blk + 4 * p4) * 2;
                const bf16x8 vf = cat4(tr_read(a), tr_read(a + 8 * 256));
                y[vt] = MFMA32(vf, pf[s2], y[vt]);
            }
    }
#pragma unroll
    for (int dir = 0; dir < 2; ++dir) {
        const float sc = dir == 0 ? exp2f(Lf * (float)(i + 1)) : exp2f(Lb * (float)(128 - i));
        LAS char* SI = L + 65536 + (cw * 2 + dir) * 16384;
#pragma unroll
        for (int ks = 0; ks < 4; ++ks) {
            const bf16x8 qs = scale_frag(qf[ks], sc);
#pragma unroll
            for (int vt = 0; vt < 4; ++vt) {
                LAS char* a = SI + (32 * hh + 8 * ks + q4) * 256 + (32 * vt + 16 * blk + 4 * p4) * 2;
                const bf16x8 af = cat4(tr_read(a), tr_read(a + 4 * 256));
                y[vt] = MFMA32(af, qs, y[vt]);
            }
        }
    }
    float sm = 0.f;
#pragma unroll
    for (int vt = 0; vt < 4; ++vt)
#pragma unroll
        for (int e = 0; e < 16; ++e) sm += y[vt][e];
    sm += __shfl_xor(sm, 32);
    const float mu = sm * (1.f / 128.f);
    float sq = 0.f;
#pragma unroll
    for (int vt = 0; vt < 4; ++vt)
#pragma unroll
        for (int e = 0; e < 16; ++e) { const float dlt = y[vt][e] - mu; sq += dlt * dlt; }
    sq += __shfl_xor(sq, 32);
    const float rs = rsqrtf(sq * (1.f / 128.f) + NORM_EPS);
    const bf16_t* gp = proj + pofs(crow + i, RET_OFF + 1024 + h * 128);
    bf16_t* op = yret + ((size_t)b * SEQ + 128 * (n + cw) + i) * 512 + h * 128;
    const float* gg = gn_g + h * 128;
#pragma unroll
    for (int vt = 0; vt < 4; ++vt)
#pragma unroll
        for (int gq = 0; gq < 4; ++gq) { const int vi = 32 * vt + 8 * gq + 4 * hh;
            const u32x2 gw = *(const u32x2*)(gp + vi); const f32x4 g4 = *(const f32x4*)(gg + vi);
            u32x2 w; w.x = pk2((y[vt][4 * gq] - mu) * rs * g4.x * bflo(gw.x), (y[vt][4 * gq + 1] - mu) * rs * g4.y * bfhi(gw.x));
            w.y = pk2((y[vt][4 * gq + 2] - mu) * rs * g4.z * bflo(gw.y), (y[vt][4 * gq + 3] - mu) * rs * g4.w * bfhi(gw.y));
            *(u32x2*)(op + vi) = w; }
    __syncthreads();
}

__device__ __forceinline__ bf16x8 scale8(u32x4 w, float rs, const float* g) {
    const f32x4 g0 = *(const f32x4*)g, g1 = *(const f32x4*)(g + 4);
    return pack8(bflo(w.x) * rs * g0.x, bfhi(w.x) * rs * g0.y, bflo(w.y) * rs * g0.z, bfhi(w.y) * rs * g0.w, bflo(w.z) * rs * g1.x, bfhi(w.z) * rs * g1.y, bflo(w.w) * rs * g1.z, bfhi(w.w) * rs * g1.w);
}
__device__ __forceinline__ float ssq8(u32x4 w) {
    const float a = bflo(w.x), b = bfhi(w.x), c = bflo(w.y), d = bfhi(w.y), e = bflo(w.z), f = bfhi(w.z), g = bflo(w.w), h = bfhi(w.w);
    return ((a * a + b * b) + (c * c + d * d)) + ((e * e + f * f) + (g * g + h * h));
}
constexpr int MEM_PITCH = 272;
__device__ __forceinline__ void mem_item(const bf16_t* proj, const bf16_t* memkv  , bf16_t* ymem, const float* gqn, const float* gkn, const float* cconst, int item, LAS char* L, int tid) {
    asm volatile("" : "+v"(tid));
    const float cshift = cconst[3];
    const int qr = item & 3, hd = (item >> 2) & 3, b = item >> 4;
    const int lane = tid & 63, wave = tid >> 6, rr = lane & 31, hh = lane >> 5, blk = (lane >> 4) & 1, q4 = (lane & 15) >> 2, p4 = lane & 3;
    const bf16_t* kvb = memkv + (size_t)b * N_MEM * 1024 + hd * 128;
    LAS char* KI = L; LAS char* VI = L + 256 * MEM_PITCH;
#pragma unroll
    for (int q = 0; q < 8; ++q) {
        const int idx = tid + 512 * q, row = idx >> 4, pc = idx & 15;
        const u32x4 kw = *(const u32x4*)(kvb + (size_t)row * 1024 + 8 * pc), vw = *(const u32x4*)(kvb + (size_t)row * 1024 + 512 + 8 * pc);
        float ss = ssq8(kw);
        ss += __shfl_xor(ss, 1); ss += __shfl_xor(ss, 2); ss += __shfl_xor(ss, 4); ss += __shfl_xor(ss, 8);
        const float rs = rsqrtf(ss * (1.f / 128.f) + NORM_EPS);
        *(LAS bf16x8*)(KI + row * MEM_PITCH + 16 * pc) = scale8(kw, rs, gkn + 8 * pc);
        *(LAS u32x4*)(VI + row * MEM_PITCH + 16 * pc) = vw;
    }
    __syncthreads();
#pragma unroll 1
    for (int tq = 0; tq < 2; ++tq) {
        const int i = 512 * qr + 32 * (wave * 2 + tq) + rr;
        bf16x8 qf[8];
        { const bf16_t* p = proj + pofs(b * SEQ + i, MEMQ_OFF + hd * 128 + 64 * hh);
            u32x4 raw[8]; float ss = 0.f;
#pragma unroll
            for (int ks = 0; ks < 8; ++ks) { raw[ks] = *(const u32x4*)(p + 8 * ks); ss += ssq8(raw[ks]); }
            ss += __shfl_xor(ss, 32);
            const float rs = rsqrtf(ss * (1.f / 128.f) + NORM_EPS) * (0.08838834764831845f * LOG2E);
#pragma unroll
            for (int ks = 0; ks < 8; ++ks) qf[ks] = scale8(raw[ks], rs, gqn + 64 * hh + 8 * ks); }
        f32x16 o[4];
#pragma unroll
        for (int a = 0; a < 4; ++a)
#pragma unroll
            for (int e = 0; e < 16; ++e) o[a][e] = 0.f;
        float lrun = 0.f;
#pragma unroll 2
        for (int kt = 0; kt < 8; ++kt) {
            const int j0 = 32 * kt;
            f32x16 s;
#pragma unroll
            for (int e = 0; e < 16; ++e) s[e] = -cshift;
#pragma unroll
            for (int ks = 0; ks < 8; ++ks) { const bf16x8 kf = *(const LAS bf16x8*)(KI + (j0 + rr) * MEM_PITCH + (64 * hh + 8 * ks) * 2); s = MFMA32(kf, qf[ks], s); }
#pragma unroll
            for (int e = 0; e < 16; ++e) { const float p = __builtin_amdgcn_exp2f(s[e]); s[e] = p; lrun += p; }
            bf16x8 pf[2];
#pragma unroll
            for (int s2 = 0; s2 < 2; ++s2) pf[s2] = pack8(s[8 * s2], s[8 * s2 + 1], s[8 * s2 + 2], s[8 * s2 + 3], s[8 * s2 + 4], s[8 * s2 + 5], s[8 * s2 + 6], s[8 * s2 + 7]);
#pragma unroll
            for (int vt = 0; vt < 4; ++vt)
#pragma unroll
                for (int s2 = 0; s2 < 2; ++s2) {
                    LAS char* a = VI + (j0 + 16 * s2 + 4 * hh + q4) * MEM_PITCH + (32 * vt + 16 * blk + 4 * p4) * 2;
                    const bf16x8 vf = cat4(tr_read(a), tr_read(a + 8 * MEM_PITCH));
                    o[vt] = MFMA32(vf, pf[s2], o[vt]);
                }
        }
        const float inv = __builtin_amdgcn_rcpf(lrun + __shfl_xor(lrun, 32));
        bf16_t* op = ymem + ((size_t)b * SEQ + i) * 512 + hd * 128;
#pragma unroll
        for (int vt = 0; vt < 4; ++vt)
#pragma unroll
            for (int gq = 0; gq < 4; ++gq) { u32x2 w; w.x = pk2(o[vt][4 * gq] * inv, o[vt][4 * gq + 1] * inv); w.y = pk2(o[vt][4 * gq + 2] * inv, o[vt][4 * gq + 3] * inv);
                *(u32x2*)(op + 32 * vt + 8 * gq + 4 * hh) = w; }
    }
    __syncthreads();
}

#define XB_TMO      128
#define XB_XCNT(j)  (256  + 64 * (j))
#define XB_XSUB(j)  (1280 + 64 * (j))
#define XB_XGEN(j)  (2304 + 64 * (j))
#define XB_TOP      3328
#define XB_TOPGEN   3392
#define XCD_BAR_WORDS 3456
#define XB_SPIN_CAP (1u << 22)
__device__ __forceinline__ unsigned xb_ld(unsigned* p)              { return __hip_atomic_load(p, __ATOMIC_RELAXED, __HIP_MEMORY_SCOPE_AGENT); }
__device__ __forceinline__ unsigned xb_add(unsigned* p, unsigned v) { return __hip_atomic_fetch_add(p, v, __ATOMIC_RELAXED, __HIP_MEMORY_SCOPE_AGENT); }
__device__ __forceinline__ unsigned xb_xcc_id() { return (unsigned)__builtin_amdgcn_s_getreg((3 << 11) | 20) & 0xFu; }
#define XB_SPIN(cond, bar) do { unsigned _sp = 0; while (cond) { __builtin_amdgcn_s_sleep(1); \
    if ((++_sp & 255u) == 0u) { if (xb_ld(&(bar)[XB_TMO])) break; if (_sp > XB_SPIN_CAP) { atomicAdd(&(bar)[XB_TMO], 1u); break; } } } } while (0)
struct XcdBarrier { unsigned* bar; unsigned x; volatile LAS unsigned* st; };
__device__ __forceinline__ XcdBarrier xcd_barrier_post(unsigned* bar, volatile LAS unsigned* st) {
    XcdBarrier b; b.bar = bar; b.x = xb_xcc_id(); b.st = st;
    if (threadIdx.x == 0) (void)xb_add(&bar[XB_XCNT(b.x)], 1u);
    return b;
}
__device__ __forceinline__ void xcd_barrier_complete(unsigned* bar, unsigned x, unsigned& nloc, unsigned& nx) {
    const unsigned G = gridDim.x * gridDim.y * gridDim.z;
    unsigned sum, cnt, mine, sp = 0u;
    for (;;) {
        sum = 0u; cnt = 0u; mine = 0u;
#pragma unroll
        for (unsigned j = 0; j < 16; ++j) { const unsigned c = xb_ld(&bar[XB_XCNT(j)]); sum += c; cnt += (c > 0u) ? 1u : 0u; mine = (j == x) ? c : mine; }
        if (sum == G) break;
        __builtin_amdgcn_s_sleep(1);
        if ((++sp & 255u) == 0u) { if (xb_ld(&bar[XB_TMO])) break; if (sp > XB_SPIN_CAP) { atomicAdd(&bar[XB_TMO], 1u); break; } }
    }
    nloc = mine > 0u ? mine : 1u; nx = cnt > 0u ? cnt : 1u;
}
__device__ __forceinline__ void xcd_barrier(const XcdBarrier& b) {
    asm volatile("s_waitcnt vmcnt(0)" ::: "memory");
    __syncthreads();
    if (threadIdx.x == 0) {
        unsigned* bar = b.bar;
        __builtin_amdgcn_s_waitcnt(0);
        unsigned nloc = b.st[0], nx = b.st[1];
        if (nloc == 0u) { xcd_barrier_complete(bar, b.x, nloc, nx); b.st[0] = nloc; b.st[1] = nx; }
        const unsigned old = xb_add(&bar[XB_XSUB(b.x)], 1u);
        const unsigned gen = old / nloc;
        if (old + 1u == (gen + 1u) * nloc) {
            __builtin_amdgcn_fence(__ATOMIC_RELEASE, "agent");
            asm volatile("s_waitcnt vmcnt(0)" ::: "memory");
            const unsigned og = xb_add(&bar[XB_TOP], 1u);
            const unsigned tg = og / nx;
            if (og + 1u == (tg + 1u) * nx) xb_add(&bar[XB_TOPGEN], 1u);
            else XB_SPIN(xb_ld(&bar[XB_TOPGEN]) == tg, bar);
            __builtin_amdgcn_fence(__ATOMIC_ACQUIRE, "agent");
            xb_add(&bar[XB_XGEN(b.x)], 1u);
            asm volatile("s_waitcnt vmcnt(0)" ::: "memory");
        } else {
            XB_SPIN(xb_ld(&bar[XB_XGEN(b.x)]) == gen, bar);
            __builtin_amdgcn_fence(__ATOMIC_ACQUIRE, "agent");
            asm volatile("s_waitcnt vmcnt(0)" ::: "memory");
        }
    }
    __syncthreads();
}

struct Args { const float* in[21]; float* out; unsigned char* ws; int ph_lo, ph_hi; };

__global__ void __launch_bounds__(512, 2) mk_fwd(Args args) {
    extern __shared__ __attribute__((aligned(16))) unsigned char lds_raw[];
    LAS unsigned char* lds = (LAS unsigned char*)lds_raw;
    cg::grid_group grid = cg::this_grid();
    const int tid = threadIdx.x, lane = tid & 63, wave = __builtin_amdgcn_readfirstlane(tid >> 6);
    const int G = gridDim.x, bx = blockIdx.x;
    const int gw = bx * 8 + wave, NGW = G * 8;
    const int NGT = G * 512;
    unsigned char* ws = args.ws;
    const int lo = args.ph_lo, hi = args.ph_hi;
    volatile LAS unsigned* xst = (volatile LAS unsigned*)(lds + LDS_BYTES - 64);
    if (tid < 2) xst[tid] = 0u;
    __syncthreads();
    XcdBarrier xbar; xbar.bar = (unsigned*)(ws + WS_CTL); xbar.x = 0; xbar.st = xst;
    if (!MK_MULTI_LAUNCH) xbar = xcd_barrier_post((unsigned*)(ws + WS_CTL), xst);
#ifndef PH_EN
#define PH_EN 0x3ff
#endif
#ifndef PROBE_REP
#define PROBE_REP 0
#endif
#define REP(b) for (int rep_ = 0; rep_ < 1 + (((PROBE_REP) >> (b)) & 1); ++rep_)
#define IN(k) (lo <= (k) && (k) < hi)
#define EN(b) (((PH_EN) >> (b)) & 1)
#define SEAM(k) do { if (IN(k) && IN((k) + 1)) { if ((k) == 0 || MK_MULTI_LAUNCH) grid.sync(); else xcd_barrier(xbar); } } while (0)

#define WinT ((bf16_t*)(ws_ + WS_WIN))
#define WkvT ((bf16_t*)(ws_ + WS_WKV))
#define WbrT ((bf16_t*)(ws_ + WS_WBR))
#define WoutT ((bf16_t*)(ws_ + WS_WOUT))
#define WfiT ((bf16_t*)(ws_ + WS_WFI))
#define WfoT ((bf16_t*)(ws_ + WS_WFO))
#define MEMKV ((bf16_t*)(ws_ + WS_MEMKV))
#define XB ((bf16_t*)(ws_ + WS_XB))
#define MEMB ((bf16_t*)(ws_ + WS_MEMB))
#define ODIL ((bf16_t*)(ws_ + WS_ODIL))
#define LSE ((float*)(ws_ + WS_LSE))
#define MERGED ((bf16_t*)(ws_ + WS_MERGED))
#define A2 ((bf16_t*)(ws_ + WS_A2))
#define Y3 ((bf16_t*)(ws_ + WS_Y3))
#define SSQ ((float*)(ws_ + WS_SSQ))
#define PROJ ((bf16_t*)(ws_ + WS_PROJ))
#define YF ((bf16_t*)(ws_ + WS_YF))
#define HALO ((bf16_t*)(ws_ + WS_HALO))
#define CCONST ((float*)(ws_ + WS_CTL + 15360))
#define PHASE_LOCALS const Args* ap = &args; size_t zoff_ = 0; asm volatile("" : "+s"(zoff_)); unsigned char* ws_ = ws + zoff_;     int bxl = bx; asm volatile("" : "+s"(bxl)); int tidl = threadIdx.x; asm volatile("" : "+v"(tidl)); const int gtidl = bxl * 512 + tidl; (void)bxl; (void)ws_; (void)ap; (void)gtidl;
    if (EN(0) && IN(0)) REP(0) {
            PHASE_LOCALS
        LAS float* scr = (LAS float*)(lds + wave * 16384);
        constexpr int I_IN = 16 * 304, I_KV = 16 * 32, I_BR = 8 * 32, I_OUT = 16 * 32, I_FI = 16 * 176, I_FO = 44 * 32;
        constexpr int NITEMS = I_IN + I_KV + 3 * I_BR + I_OUT + I_FI + I_FO;
        for (int it = gw; it < NITEMS; it += NGW) {
            int r = it;
            if (r < I_IN) { p0_transpose_item<0>(ap->in[3], 1024, IN_COLS, WinT, 0, scr, r, lane); continue; } r -= I_IN;
            if (r < I_KV) { p0_transpose_item<0>(ap->in[9], 1024, 1024, WkvT, 0, scr, r, lane); continue; } r -= I_KV;
            if (r < I_BR) { p0_transpose_item<0>(ap->in[12], 512, 1024, WbrT, 0, scr, r, lane); continue; } r -= I_BR;
            if (r < I_BR) { p0_transpose_item<0>(ap->in[13], 512, 1024, WbrT, 1024, scr, r, lane); continue; } r -= I_BR;
            if (r < I_BR) { p0_transpose_item<0>(ap->in[14], 512, 1024, WbrT, 2048, scr, r, lane); continue; } r -= I_BR;
            if (r < I_OUT) { p0_transpose_item<0>(ap->in[15], 1024, 1024, WoutT, 0, scr, r, lane); continue; } r -= I_OUT;
            if (r < I_FI) { p0_transpose_item<1>(ap->in[17], 1024, FF2, WfiT, 0, scr, r, lane); continue; } r -= I_FI;
            p0_transpose_item<0>(ap->in[20], D_FF, 1024, WfoT, 0, scr, r, lane);
        }
        for (int i = bx * 512 + tid; i < BATCH * SEQ; i += NGT) SSQ[i] = 0.f;
        if (gw == 0) {
            float cv = 0.f;
            for (int g = 0; g < 3; ++g) { float a = fabsf(args.in[4][g * 64 + lane]), b = fabsf(args.in[5][g * 64 + lane]);
#pragma unroll
                for (int o = 1; o < 64; o <<= 1) { a = fmaxf(a, __shfl_xor(a, o)); b = fmaxf(b, __shfl_xor(b, o)); }
                if (lane == g) cv = 8.f * a * b * LOG2E; }
            { float a = fmaxf(fabsf(args.in[10][lane]), fabsf(args.in[10][64 + lane])), b = fmaxf(fabsf(args.in[11][lane]), fabsf(args.in[11][64 + lane]));
#pragma unroll
                for (int o = 1; o < 64; o <<= 1) { a = fmaxf(a, __shfl_xor(a, o)); b = fmaxf(b, __shfl_xor(b, o)); }
                if (lane == 3) cv = 11.313708499f * a * b * LOG2E; }
            if (lane < 4) CCONST[lane] = cv;
        }
        for (int m = gw; m < BATCH * SEQ; m += 2 * NGW) rms_row2_to_bf16(ap->in[0] + (size_t)m * 1024, ap->in[0] + (size_t)(m + NGW) * 1024, ap->in[2], XB + (size_t)m * 1024, XB + (size_t)(m + NGW) * 1024, lane);
        for (int m = gw; m < BATCH * N_MEM; m += NGW) rms_row_to_bf16(ap->in[1] + (size_t)m * 1024, ap->in[8], MEMB + (size_t)m * 1024, lane);
        __syncthreads();
    }
    SEAM(0);
    if (EN(1) && IN(1)) REP(1) {
            PHASE_LOCALS
        pg8::Gemm g{MEMB, WkvT, BATCH * N_MEM, 1024, 1024}; pg8::StaticOrder S; S.init(g.M, g.N, G, bxl);
        EpiPlainBf16 E{MEMKV, 1024};
        pg8::gemm_phase(lds, g, S, E);
    }
    SEAM(1);
    for (int hf = 0; hf < 2; ++hf) {
        const int P = 2 + 4 * hf;
        if (EN(2) && IN(P + 0)) REP(2) {
            PHASE_LOCALS
            pg8::Gemm g{XB + (size_t)hf * HTOK * 1024, WinT, HTOK, IN_COLS, 1024}; pg8::StaticOrder S; S.init(g.M, g.N, G, bxl);
            EpiProj E{PROJ, ap->in[4], ap->in[5]};
            pg8::gemm_phase(lds, g, S, E);
        }
        SEAM(P + 0);
        if (EN(3) && IN(P + 1)) REP(3) {
            PHASE_LOCALS
            LAS char* vl = (LAS char*)(lds + wave * 8192);
#ifndef ATT_EN
#define ATT_EN 7
#endif
            if (ATT_EN & 1) for (int it = bxl; it < HB * 4 * 16; it += G) ret_u_item(PROJ, XB + (size_t)hf * HTOK * 1024, ap->in[6], it, (LAS char*)lds, tid);
            if (ATT_EN & 2) REP(10) for (int it = gw; it < HB * 8 * 3 * 32; it += NGW) dil_wave(PROJ, ODIL, LSE, CCONST, it, vl, lane);
            __syncthreads();
            if (ATT_EN & 4) REP(11) for (int it = bxl; it < HB * 4 * 4; it += G) mem_item(PROJ, MEMKV + (size_t)hf * HB * N_MEM * 1024, Y3 + (size_t)2 * HTOK * 512, args.in[10], args.in[11], CCONST, it, (LAS char*)lds, tid);
            __syncthreads();
        }
        SEAM(P + 1);
        if (EN(4) && IN(P + 2)) REP(4) {
            PHASE_LOCALS
            for (int it = bxl; it < HB * 4 * 8; it += G) ret_chunk_item(PROJ, XB + (size_t)hf * HTOK * 1024, Y3 + (size_t)1 * HTOK * 512, ap->in[6], ap->in[7], it, (LAS char*)lds, tid);
            for (int idx = gtidl; idx < HTOK * 64; idx += NGT) {
                const int dp = idx & 7, h = (idx >> 3) & 7, tok = idx >> 6;
                const float l0 = LSE[((size_t)0 * HTOK + tok) * 8 + h], l1 = LSE[((size_t)1 * HTOK + tok) * 8 + h], l2 = LSE[((size_t)2 * HTOK + tok) * 8 + h];
                const float mx = fmaxf(l0, fmaxf(l1, l2));
                float w0 = exp2f(l0 - mx), w1 = exp2f(l1 - mx), w2 = exp2f(l2 - mx); const float inv = 1.f / (w0 + w1 + w2); w0 *= inv; w1 *= inv; w2 *= inv;
                const size_t off = (size_t)tok * 512 + h * 64 + dp * 8;
                const u32x4 a = *(const u32x4*)(ODIL + off), b = *(const u32x4*)(ODIL + (size_t)HTOK * 512 + off), c = *(const u32x4*)(ODIL + (size_t)2 * HTOK * 512 + off);
                u32x4 o;
                o.x = pk2(w0 * bflo(a.x) + w1 * bflo(b.x) + w2 * bflo(c.x), w0 * bfhi(a.x) + w1 * bfhi(b.x) + w2 * bfhi(c.x));
                o.y = pk2(w0 * bflo(a.y) + w1 * bflo(b.y) + w2 * bflo(c.y), w0 * bfhi(a.y) + w1 * bfhi(b.y) + w2 * bfhi(c.y));
                o.z = pk2(w0 * bflo(a.z) + w1 * bflo(b.z) + w2 * bflo(c.z), w0 * bfhi(a.z) + w1 * bfhi(b.z) + w2 * bfhi(c.z));
                o.w = pk2(w0 * bflo(a.w) + w1 * bflo(b.w) + w2 * bflo(c.w), w0 * bfhi(a.w) + w1 * bfhi(b.w) + w2 * bfhi(c.w));
                *(u32x4*)(Y3 + off) = o;
            }
        }
        SEAM(P + 2);
        if (EN(5) && IN(P + 3)) REP(5) {
            PHASE_LOCALS
            pg8::Gemm g{Y3, WbrT, 3 * HTOK, 3 * 1024, 512}; pg8::BranchOrder S; S.init(HTOK, 1024, G, bxl);
            EpiBranch E{MERGED + (size_t)hf * HTOK * 1024, PROJ};
            pg8::gemm_phase(lds, g, S, E);
        }
        SEAM(P + 3);
    }
    {
        constexpr int P = 6, NTOK = BATCH * SEQ;
        if (EN(6) && IN(P + 4)) REP(6) {
            PHASE_LOCALS
            pg8::Gemm g{MERGED, WoutT, NTOK, 1024, 1024}; pg8::StaticOrder S; S.init(g.M, g.N, G, bxl);
            EpiOut E{ap->in[0], ap->out, A2, ap->in[16], SSQ};
            pg8::gemm_phase(lds, g, S, E);
        }
        SEAM(P + 4);
        if (EN(7) && IN(P + 5)) REP(7) {
            PHASE_LOCALS
            pg8::Gemm g{A2, WfiT, NTOK, FF2, 1024}; pg8::StaticOrder S; S.init(g.M, g.N, G, bxl);
            EpiFfnInConv E{YF, HALO, SSQ, ap->in[18], ap->in[19]};
            pg8::gemm_phase(lds, g, S, E);
        }
        SEAM(P + 5);
        if (EN(8) && IN(P + 6)) REP(8) {
            PHASE_LOCALS
            const float* cw = ap->in[18]; const float* cb = ap->in[19];
            for (int idx = gtidl; idx < (NTOK / 64) * 2 * 352; idx += NGT) {
                const int cgp = idx % 352, rest = idx / 352, side = rest & 1, blk = rest >> 1, ch = cgp * 8;
                const int row = blk * 64 + (side ? 63 : 0), t = row & (SEQ - 1);
                const bf16_t* hb = HALO + (size_t)blk * 6 * D_FF + ch;
                u32x4 um = {0u, 0u, 0u, 0u}, un = {0u, 0u, 0u, 0u}, uc, gt;
                if (side == 0) { uc = *(const u32x4*)hb; un = *(const u32x4*)(hb + D_FF); gt = *(const u32x4*)(hb + 4 * D_FF); if (t > 0) um = *(const u32x4*)(hb - 6 * D_FF + 3 * D_FF); }
                else { um = *(const u32x4*)(hb + 2 * D_FF); uc = *(const u32x4*)(hb + 3 * D_FF); gt = *(const u32x4*)(hb + 5 * D_FF); if (t < SEQ - 1) un = *(const u32x4*)(hb + 6 * D_FF); }
                float uu[3][8], gg[8];
                const unsigned umw[4] = {um.x, um.y, um.z, um.w}, ucw[4] = {uc.x, uc.y, uc.z, uc.w}, unw[4] = {un.x, un.y, un.z, un.w}, gtw[4] = {gt.x, gt.y, gt.z, gt.w};
#pragma unroll
                for (int q = 0; q < 4; ++q) { uu[0][2 * q] = bflo(umw[q]); uu[0][2 * q + 1] = bfhi(umw[q]); uu[1][2 * q] = bflo(ucw[q]); uu[1][2 * q + 1] = bfhi(ucw[q]);
                    uu[2][2 * q] = bflo(unw[q]); uu[2][2 * q + 1] = bfhi(unw[q]); gg[2 * q] = bflo(gtw[q]); gg[2 * q + 1] = bfhi(gtw[q]); }
                float yv[8];
#pragma unroll
                for (int q2 = 0; q2 < 2; ++q2) {
                    const f32x4 w0 = *(const f32x4*)(cw + ch + 4 * q2), w1 = *(const f32x4*)(cw + D_FF + ch + 4 * q2), w2 = *(const f32x4*)(cw + 2 * D_FF + ch + 4 * q2), bb = *(const f32x4*)(cb + ch + 4 * q2);
#pragma unroll
                    for (int e = 0; e < 4; ++e) { const int k = 4 * q2 + e; const float c = bb[e] + uu[0][k] * w0[e] + uu[1][k] * w1[e] + uu[2][k] * w2[e];
                        yv[k] = gelu_exact(c) * gg[k]; }
                }
                u32x4 o; o.x = pk2(yv[0], yv[1]); o.y = pk2(yv[2], yv[3]); o.z = pk2(yv[4], yv[5]); o.w = pk2(yv[6], yv[7]);
                *(u32x4*)(YF + (size_t)row * D_FF + ch) = o;
            }
        }
        SEAM(P + 6);
        if (EN(9) && IN(P + 7)) REP(9) {
            PHASE_LOCALS
            pg8::Gemm g{YF, WfoT, NTOK, 1024, D_FF}; pg8::StaticOrder S; S.init(g.M, g.N, G, bxl);
            EpiFfnOut E{ap->out};
            pg8::gemm_phase(lds, g, S, E);
        }
    }
#undef IN
#undef SEAM
}

extern "C" void kernel_launch(void* const* d_in, const int* in_sizes, int n_in, void* d_out, int out_size, void* d_ws, size_t ws_size, hipStream_t stream) {
    static int grid = 0;
    if (grid == 0) {
        if (n_in != 21 || out_size != BATCH * SEQ * D_MODEL || ws_size < WS_END) { fprintf(stderr, "kernel_launch: unexpected shapes (n_in %d out %d ws %zu)\n", n_in, out_size, ws_size); grid = -1; return; }
        int dev = 0, cus = 0, per_cu = 0;
        hipGetDevice(&dev); hipDeviceGetAttribute(&cus, hipDeviceAttributeMultiprocessorCount, dev);
        if (hipFuncSetAttribute((const void*)mk_fwd, hipFuncAttributeMaxDynamicSharedMemorySize, LDS_BYTES) != hipSuccess) { fprintf(stderr, "kernel_launch: hipFuncSetAttribute failed\n"); grid = -1; return; }
        if (hipOccupancyMaxActiveBlocksPerMultiprocessor(&per_cu, (const void*)mk_fwd, 512, LDS_BYTES) != hipSuccess || per_cu < 1) { fprintf(stderr, "kernel_launch: occupancy query says %d\n", per_cu); per_cu = 1; }
        (void)hipGetLastError();
        grid = cus * per_cu;
    }
    if (grid < 0) return;
    Args a{};
    for (int i = 0; i < 21; ++i) a.in[i] = (const float*)d_in[i];
    a.out = (float*)d_out; a.ws = (unsigned char*)d_ws;
#if MK_MULTI_LAUNCH
    for (int ph = 0; ph < NPHASE; ++ph) {
        a.ph_lo = ph; a.ph_hi = ph + 1;
        hipLaunchKernelGGL(mk_fwd, dim3(grid), dim3(512), LDS_BYTES, stream, a);
    }
#else
    a.ph_lo = 0; a.ph_hi = NPHASE;
    if (hipMemsetAsync((char*)d_ws + WS_CTL, 0, CTL_BYTES, stream) != hipSuccess) { fprintf(stderr, "kernel_launch: memset of the barrier words failed\n"); return; }
    void* kargs[] = {&a};
    hipError_t e = hipLaunchCooperativeKernel((const void*)mk_fwd, dim3(grid), dim3(512), kargs, LDS_BYTES, stream);
    if (e != hipSuccess) fprintf(stderr, "kernel_launch: cooperative launch failed: %s (grid %d)\n", hipGetErrorString(e), grid);
#endif
}
```

```cpp
#include <hip/hip_runtime.h>
#include <hip/hip_cooperative_groups.h>
#include <cstdio>
namespace cg = cooperative_groups;

#ifndef MK_MULTI_LAUNCH
#define MK_MULTI_LAUNCH 0
#endif

#define LAS __attribute__((address_space(3)))
typedef unsigned short bf16_t;
typedef short bf16x8 __attribute__((ext_vector_type(8)));
typedef short s16x4 __attribute__((ext_vector_type(4)));
typedef float f32x2 __attribute__((ext_vector_type(2)));
typedef float f32x4 __attribute__((ext_vector_type(4)));
typedef float f32x16 __attribute__((ext_vector_type(16)));
typedef unsigned u32x2 __attribute__((ext_vector_type(2)));
typedef unsigned u32x4 __attribute__((ext_vector_type(4)));
typedef __bf16 bf16x2_t __attribute__((ext_vector_type(2)));

constexpr int D_MODEL = 1024, BATCH = 32, SEQ = 2048, N_MEM = 256;
constexpr int HB = 16, HTOK = HB * SEQ;
constexpr int IN_COLS = 9728, RET_OFF = 4608, MEMQ_OFF = 6144, GATE_OFF = 6656;
constexpr int D_FF = 2816, FF2 = 5632;
constexpr float NORM_EPS = 1e-6f;
constexpr float LOG2E = 1.4426950408889634f;
constexpr int NPHASE = 14;

constexpr size_t MiB = 1u << 20;
constexpr size_t WS_WIN = 0;
constexpr size_t WS_WKV = 19 * MiB;
constexpr size_t WS_WBR = 21 * MiB;
constexpr size_t WS_WOUT = 24 * MiB;
constexpr size_t WS_WFI = 26 * MiB;
constexpr size_t WS_WFO = 37 * MiB;
constexpr size_t WS_MEMKV = 43 * MiB;
constexpr size_t WS_XB = 60 * MiB;
constexpr size_t WS_R1 = 188 * MiB;
constexpr size_t WS_MEMB = WS_R1;
constexpr size_t WS_ODIL = WS_R1;
constexpr size_t WS_LSE = WS_R1 + 96 * MiB;
constexpr size_t WS_MERGED = WS_XB;
constexpr size_t WS_A2 = 412 * MiB;
constexpr size_t WS_Y3 = 316 * MiB;
constexpr size_t WS_SSQ = WS_R1 + 100 * MiB;
constexpr size_t WS_HALO = WS_Y3 + 4 * MiB;
constexpr size_t WS_PROJ = 412 * MiB;
constexpr size_t WS_UG = WS_PROJ;
constexpr size_t WS_YF = WS_PROJ + 128 * MiB;
constexpr size_t WS_CTL = 1020 * MiB;
constexpr size_t CTL_BYTES = 16384;
constexpr size_t WS_END = WS_CTL + CTL_BYTES;

constexpr int LDS_BYTES = 147456;

__device__ __forceinline__ unsigned pk2(float a, float b) { f32x2 f = {a, b}; bf16x2_t r = __builtin_convertvector(f, bf16x2_t); return __builtin_bit_cast(unsigned, r); }
__device__ __forceinline__ float bflo(unsigned w) { return __uint_as_float(w << 16); }
__device__ __forceinline__ float bfhi(unsigned w) { return __uint_as_float(w & 0xffff0000u); }
__device__ __forceinline__ float wave_sum(float v) {
#pragma unroll
    for (int o = 1; o < 64; o <<= 1) v += __shfl_xor(v, o);
    return v;
}
__device__ __forceinline__ bf16x8 pack8(float a0, float a1, float a2, float a3, float a4, float a5, float a6, float a7) {
    u32x4 p; p.x = pk2(a0, a1); p.y = pk2(a2, a3); p.z = pk2(a4, a5); p.w = pk2(a6, a7); return __builtin_bit_cast(bf16x8, p);
}
#define MFMA32(a, b, c) __builtin_amdgcn_mfma_f32_32x32x16_bf16((a), (b), (c), 0, 0, 0)
__device__ __forceinline__ s16x4 tr_read(LAS char* p) { return __builtin_amdgcn_ds_read_tr16_b64_v4i16((LAS s16x4*)p); }
__device__ __forceinline__ bf16x8 cat4(s16x4 lo, s16x4 hi) { return __builtin_shufflevector(lo, hi, 0, 1, 2, 3, 4, 5, 6, 7); }
__device__ __forceinline__ int slot_of(int c) { return 128 * ((c >> 5) & 1) + 32 * (c >> 6) + 16 * ((c >> 2) & 1) + 4 * ((c >> 3) & 3) + (c & 3); }

namespace pg8 {
constexpr int BM = 256, BK = 64, HALF = 128, HTB = HALF * BK * 2, NXCD = 8, WGM = 8;
__device__ __forceinline__ int lds_byte(int r, int c) { const int st = (r >> 4) * 2 + (c >> 5), rr = r & 15, cc = c & 31, ob = rr * 64 + cc * 2; return st * 1024 + (ob ^ (((ob >> 9) & 1) << 5)); }
__device__ __forceinline__ void stage_rc(int b, int& R, int& C) { const int st = b / 1024, sb = b % 1024, swz = sb ^ (((sb >> 9) & 1) << 5); R = (st >> 1) * 16 + swz / 64; C = (st & 1) * 32 + (swz % 64) / 2; }
struct Unit { int pm, pn; };
struct Gemm { const bf16_t* A; const bf16_t* Bt; int M, N, K; };
struct StaticOrder {
    int nM, nN, nwg, G, c;
    __device__ void init(int M, int N, int G_, int c_) { nM = M / BM; nN = N / BM; nwg = nM * nN; G = G_; c = c_; }
    __device__ bool next(int i, Unit& u) const {
        const long L = (long)i * G + c; if (L >= nwg) return false;
        int wgid = (int)L; { const int q = nwg / NXCD, r = nwg % NXCD, xcd = wgid % NXCD, off = wgid / NXCD; wgid = (xcd < r ? xcd * (q + 1) : r * (q + 1) + (xcd - r) * q) + off; }
        const int nig = WGM * nN, gid = wgid / nig, fm = gid * WGM, gsz = (nM - fm) < WGM ? (nM - fm) : WGM;
        u.pm = fm + ((wgid % nig) % gsz); u.pn = (wgid % nig) / gsz; return true;
    }
};
struct BranchOrder {
    StaticOrder so;
    __device__ void init(int M, int N, int G_, int c_) { so.init(M, N, G_, c_); }
    __device__ bool next(int i, Unit& u) const { Unit t; if (!so.next(i / 3, t)) return false; const int b = i % 3; u.pm = b * (HTOK / BM) + t.pm; u.pn = b * (D_MODEL / BM) + t.pn; return true; }
};

template <class Epi, class Sched>
__device__ __forceinline__ void gemm_phase(LAS unsigned char* lds, const Gemm g, const Sched& S, const Epi& E) {
    int tid = threadIdx.x; asm volatile("" : "+v"(tid));
    const int wid = __builtin_amdgcn_readfirstlane(tid >> 6), lane = tid & 63, wr = wid >> 2, wc = wid & 3, fr = lane & 15, fq = lane >> 4;
    const int K = g.K, nt = K / BK;
    unsigned voffA[2];
#pragma unroll
    for (int i = 0; i < 2; ++i) { int R, C; stage_rc(tid * 16 + i * 8192, R, C); voffA[i] = (unsigned)(R * K + C) * 2u; }
    const size_t kstep = (size_t)(BK * 2);
    const size_t hstep = (size_t)HALF * K * 2;
    const size_t tstep = 2 * hstep;
    const unsigned ldsw = (unsigned)wid * 1024u;
    const int aoff = lds_byte(wr * 64 + fr, fq * 8), boff = lds_byte(wc * 32 + fr, fq * 8);
#define PG8_SA(b, h) (((b) * 2 + (h)) * HTB)
#define PG8_SB(b, h) ((4 + (b) * 2 + (h)) * HTB)
#define PG8_STAGE(bufoff, gbase) do { _Pragma("unroll") for (int _i = 0; _i < 2; ++_i) \
        __builtin_amdgcn_global_load_lds((const unsigned*)((const char*)(gbase) + voffA[_i]), (LAS unsigned*)(lds + (bufoff) + ldsw + _i * 8192), 16, 0, 0); } while (0)
#define PG8_LDA(dst, b, h) do { _Pragma("unroll") for (int m = 0; m < 4; ++m) _Pragma("unroll") for (int k = 0; k < 2; ++k) dst[m][k] = *(const LAS bf16x8*)(lds + PG8_SA(b, h) + aoff + m * 2048 + k * 1024); } while (0)
#define PG8_LDB(dst, b, h) do { _Pragma("unroll") for (int n = 0; n < 2; ++n) _Pragma("unroll") for (int k = 0; k < 2; ++k) dst[n][k] = *(const LAS bf16x8*)(lds + PG8_SB(b, h) + boff + n * 2048 + k * 1024); } while (0)
#define PG8_MMA(ai, bj, At, Bt) do { __builtin_amdgcn_s_setprio(1); _Pragma("unroll") for (int m = 0; m < 4; ++m) _Pragma("unroll") for (int n = 0; n < 2; ++n) _Pragma("unroll") for (int k = 0; k < 2; ++k) \
        acc[ai][bj][m][n] = __builtin_amdgcn_mfma_f32_16x16x32_bf16(Bt[n][k], At[m][k], acc[ai][bj][m][n], 0, 0, 0); __builtin_amdgcn_s_setprio(0); } while (0)
#define PG8_WAIT_V(n) asm volatile("s_waitcnt vmcnt(" #n ")" ::: "memory")
#define PG8_WAIT_L(n) asm volatile("s_waitcnt lgkmcnt(" #n ")" ::: "memory")
#define PG8_BAR __builtin_amdgcn_s_barrier()
#define PG8_SCHED __builtin_amdgcn_sched_barrier(0)
    Unit cur, nxt; int ui = 0;
    if (!S.next(0, cur)) return;
    f32x4 acc[2][2][4][2];
#pragma unroll
    for (int a = 0; a < 2; ++a)
#pragma unroll
        for (int b = 0; b < 2; ++b)
#pragma unroll
            for (int m = 0; m < 4; ++m)
#pragma unroll
                for (int n = 0; n < 2; ++n) acc[a][b][m][n] = (f32x4){0.f, 0.f, 0.f, 0.f};
    bf16x8 At[4][2], B0[2][2], B1[2][2];
    const char* cA = (const char*)g.A + (size_t)cur.pm * tstep; const char* cB = (const char*)g.Bt + (size_t)cur.pn * tstep;
    PG8_STAGE(PG8_SB(0, 0), cB); PG8_STAGE(PG8_SA(0, 0), cA); PG8_STAGE(PG8_SB(0, 1), cB + hstep); PG8_STAGE(PG8_SA(0, 1), cA + hstep);
    if (wr == 1) PG8_BAR;
    PG8_WAIT_V(4); PG8_BAR;
    PG8_STAGE(PG8_SB(1, 0), cB + kstep); PG8_STAGE(PG8_SA(1, 0), cA + kstep); PG8_STAGE(PG8_SB(1, 1), cB + hstep + kstep);
    PG8_WAIT_V(6); PG8_BAR;
    for (;;) {
        const bool has_next = S.next(ui + 1, nxt);
        const char* nA = has_next ? (const char*)g.A + (size_t)nxt.pm * tstep : cA; const char* nB = has_next ? (const char*)g.Bt + (size_t)nxt.pn * tstep : cB;
        for (int t = 0; t < nt; t += 2) {
            const bool last = (t == nt - 2);
            const char* a1 = cA + (size_t)(t + 1) * kstep;
            const char* a2 = last ? nA : cA + (size_t)(t + 2) * kstep; const char* b2 = last ? nB : cB + (size_t)(t + 2) * kstep;
            const char* a3 = a2 + kstep; const char* b3 = b2 + kstep;
            PG8_LDB(B0, 0, 0); PG8_SCHED; PG8_LDA(At, 0, 0); PG8_STAGE(PG8_SA(1, 1), a1 + hstep);
            PG8_WAIT_L(8); PG8_BAR; PG8_WAIT_L(0); PG8_MMA(0, 0, At, B0); PG8_BAR; PG8_SCHED;
            PG8_LDB(B1, 0, 1); PG8_STAGE(PG8_SB(0, 0), b2);
            PG8_BAR; PG8_WAIT_L(0); PG8_MMA(0, 1, At, B1); PG8_BAR;
            PG8_LDA(At, 0, 1); PG8_STAGE(PG8_SA(0, 0), a2);
            PG8_BAR; PG8_WAIT_L(0); PG8_MMA(1, 0, At, B0); PG8_BAR; PG8_SCHED;
            PG8_STAGE(PG8_SB(0, 1), b2 + hstep);
            PG8_WAIT_V(6); PG8_BAR; PG8_MMA(1, 1, At, B1); PG8_BAR;
            PG8_LDB(B0, 1, 0); PG8_SCHED; PG8_LDA(At, 1, 0); PG8_STAGE(PG8_SA(0, 1), a2 + hstep);
            PG8_WAIT_L(8); PG8_BAR; PG8_WAIT_L(0); PG8_MMA(0, 0, At, B0); PG8_BAR; PG8_SCHED;
            PG8_LDB(B1, 1, 1); PG8_STAGE(PG8_SB(1, 0), b3);
            PG8_BAR; PG8_WAIT_L(0); PG8_MMA(0, 1, At, B1); PG8_BAR;
            PG8_LDA(At, 1, 1); PG8_STAGE(PG8_SA(1, 0), a3);
            PG8_BAR; PG8_WAIT_L(0); PG8_MMA(1, 0, At, B0); PG8_BAR; PG8_SCHED;
            PG8_STAGE(PG8_SB(1, 1), b3 + hstep);
            PG8_WAIT_V(6); PG8_BAR; PG8_MMA(1, 1, At, B1); PG8_BAR;
        }
        E(acc, cur, wr, wc, fr, fq);
        if (!has_next) break;
#pragma unroll
        for (int a = 0; a < 2; ++a)
#pragma unroll
            for (int b = 0; b < 2; ++b)
#pragma unroll
                for (int m = 0; m < 4; ++m)
#pragma unroll
                    for (int n = 0; n < 2; ++n) acc[a][b][m][n] = (f32x4){0.f, 0.f, 0.f, 0.f};
        cur = nxt; cA = nA; cB = nB; ++ui;
    }
    PG8_WAIT_V(0);
    if (wr == 0) PG8_BAR;
    PG8_BAR;
#undef PG8_SA
#undef PG8_SB
#undef PG8_STAGE
#undef PG8_LDA
#undef PG8_LDB
#undef PG8_MMA
#undef PG8_WAIT_V
#undef PG8_WAIT_L
#undef PG8_BAR
#undef PG8_SCHED
}
}
using pg8::Unit;

#define EPI_ROWS_BEGIN _Pragma("unroll") for (int ai = 0; ai < 2; ++ai) _Pragma("unroll") for (int m = 0; m < 4; ++m) { const int rloc = ai * 128 + wr * 64 + m * 16 + fr; float v[16]; \
    _Pragma("unroll") for (int bj = 0; bj < 2; ++bj) _Pragma("unroll") for (int n = 0; n < 2; ++n) _Pragma("unroll") for (int j = 0; j < 4; ++j) v[8 * bj + 4 * n + j] = acc[ai][bj][m][n][j];
#define EPI_ROWS_END }
__device__ __forceinline__ void store16_bf16(bf16_t* p, const float (&v)[16]) {
    u32x4 a, b; a.x = pk2(v[0], v[1]); a.y = pk2(v[2], v[3]); a.z = pk2(v[4], v[5]); a.w = pk2(v[6], v[7]);
    b.x = pk2(v[8], v[9]); b.y = pk2(v[10], v[11]); b.z = pk2(v[12], v[13]); b.w = pk2(v[14], v[15]);
    *(u32x4*)p = a; *(u32x4*)(p + 32) = b;
}
__device__ __forceinline__ void load16_bf16(const bf16_t* p, float (&v)[16]) {
    const u32x4 a = *(const u32x4*)p, b = *(const u32x4*)(p + 32);
    v[0] = bflo(a.x); v[1] = bfhi(a.x); v[2] = bflo(a.y); v[3] = bfhi(a.y); v[4] = bflo(a.z); v[5] = bfhi(a.z); v[6] = bflo(a.w); v[7] = bfhi(a.w);
    v[8] = bflo(b.x); v[9] = bfhi(b.x); v[10] = bflo(b.y); v[11] = bfhi(b.y); v[12] = bflo(b.z); v[13] = bfhi(b.z); v[14] = bflo(b.w); v[15] = bfhi(b.w);
}
__device__ __forceinline__ void load16_f32(const float* p, float (&v)[16]) {
#pragma unroll
    for (int q = 0; q < 4; ++q) { const f32x4 t = *(const f32x4*)(p + 4 * (q & 1) + 32 * (q >> 1)); v[4 * q] = t.x; v[4 * q + 1] = t.y; v[4 * q + 2] = t.z; v[4 * q + 3] = t.w; }
}
__device__ __forceinline__ void store16_f32(float* p, const float (&v)[16]) {
#pragma unroll
    for (int q = 0; q < 4; ++q) *(f32x4*)(p + 4 * (q & 1) + 32 * (q >> 1)) = (f32x4){v[4 * q], v[4 * q + 1], v[4 * q + 2], v[4 * q + 3]};
}
__device__ __forceinline__ void nt_store16(u32x4* p, u32x4 v) { __builtin_nontemporal_store(v, p); }
__device__ __forceinline__ void store16_bf16_nt(bf16_t* p, const float (&v)[16]) {
    u32x4 a, b; a.x = pk2(v[0], v[1]); a.y = pk2(v[2], v[3]); a.z = pk2(v[4], v[5]); a.w = pk2(v[6], v[7]);
    b.x = pk2(v[8], v[9]); b.y = pk2(v[10], v[11]); b.z = pk2(v[12], v[13]); b.w = pk2(v[14], v[15]);
    nt_store16((u32x4*)p, a); nt_store16((u32x4*)(p + 32), b);
}
__device__ __forceinline__ void store16_f32_nt(float* p, const float (&v)[16]) {
#pragma unroll
    for (int q = 0; q < 4; ++q) { f32x4 t = (f32x4){v[4 * q], v[4 * q + 1], v[4 * q + 2], v[4 * q + 3]}; __builtin_nontemporal_store(t, (f32x4*)(p + 4 * (q & 1) + 32 * (q >> 1))); }
}
__device__ __forceinline__ void load16c_bf16(const bf16_t* p, float (&v)[16]) {
    const u32x4 a = *(const u32x4*)p, b = *(const u32x4*)(p + 8);
    v[0] = bflo(a.x); v[1] = bfhi(a.x); v[2] = bflo(a.y); v[3] = bfhi(a.y); v[4] = bflo(a.z); v[5] = bfhi(a.z); v[6] = bflo(a.w); v[7] = bfhi(a.w);
    v[8] = bflo(b.x); v[9] = bfhi(b.x); v[10] = bflo(b.y); v[11] = bfhi(b.y); v[12] = bflo(b.z); v[13] = bfhi(b.z); v[14] = bflo(b.w); v[15] = bfhi(b.w);
}
__device__ __forceinline__ void load16c_f32(const float* p, float (&v)[16]) {
#pragma unroll
    for (int q = 0; q < 4; ++q) { const f32x4 t = *(const f32x4*)(p + 4 * q); v[4 * q] = t.x; v[4 * q + 1] = t.y; v[4 * q + 2] = t.z; v[4 * q + 3] = t.w; }
}

__device__ __forceinline__ size_t pofs(int row, int col) { return ((size_t)((row >> 8) * (IN_COLS / 256) + (col >> 8)) << 16) + (size_t)(((row & 255) << 8) + (col & 255)); }
constexpr float QSCALE_DIL = 0.125f * LOG2E;

struct EpiProj {
    static constexpr int NSTX = 16;
    bf16_t* P; const LAS float* lgain;
    __device__ __forceinline__ void operator()(const f32x4 (&acc)[2][2][4][2], const Unit& u, int wr, int wc, int fr, int fq) const {
        const int pn = u.pn; int mode = 0; int goff = 0; float sc = 1.f;
        if (pn < 18) { const int g = pn / 6, t = (pn % 6) >> 1; if (t == 0) { mode = 1; goff = g * 64; sc = QSCALE_DIL; } else if (t == 1) { mode = 1; goff = 192 + g * 64; } }
        else if (pn == 19) { mode = 2; sc = 0.125f; }
        else if (pn == 22 || pn == 23) mode = 4;
        else if (pn >= 26) mode = 3;
        const int col0 = pn * 256 + wc * 64 + fq * 8;
        if (mode == 1) {
            float gv[16];
            { const LAS f32x4* gp = (const LAS f32x4*)(lgain + goff + fq * 8); const f32x4 g0 = gp[0], g1 = gp[1], g2 = gp[8], g3 = gp[9];
              gv[0] = g0.x; gv[1] = g0.y; gv[2] = g0.z; gv[3] = g0.w; gv[4] = g1.x; gv[5] = g1.y; gv[6] = g1.z; gv[7] = g1.w;
              gv[8] = g2.x; gv[9] = g2.y; gv[10] = g2.z; gv[11] = g2.w; gv[12] = g3.x; gv[13] = g3.y; gv[14] = g3.z; gv[15] = g3.w; }
            float ssv[2][4];
#pragma unroll
            for (int ai = 0; ai < 2; ++ai)
#pragma unroll
                for (int m = 0; m < 4; ++m) { float ss = 0.f;
#pragma unroll
                    for (int bj = 0; bj < 2; ++bj)
#pragma unroll
                        for (int n = 0; n < 2; ++n)
#pragma unroll
                            for (int j = 0; j < 4; ++j) ss += acc[ai][bj][m][n][j] * acc[ai][bj][m][n][j];
                    ssv[ai][m] = ss; }
#pragma unroll
            for (int ai = 0; ai < 2; ++ai)
#pragma unroll
                for (int m = 0; m < 4; ++m) ssv[ai][m] += __shfl_xor(ssv[ai][m], 16);
#pragma unroll
            for (int ai = 0; ai < 2; ++ai)
#pragma unroll
                for (int m = 0; m < 4; ++m) ssv[ai][m] += __shfl_xor(ssv[ai][m], 32);
#pragma unroll
            for (int ai = 0; ai < 2; ++ai)
#pragma unroll
                for (int m = 0; m < 4; ++m) { const int rloc = ai * 128 + wr * 64 + m * 16 + fr; const float rs = rsqrtf(ssv[ai][m] * (1.f / 64.f) + NORM_EPS) * sc; float v[16];
#pragma unroll
                    for (int bj = 0; bj < 2; ++bj)
#pragma unroll
                        for (int n = 0; n < 2; ++n)
#pragma unroll
                            for (int j = 0; j < 4; ++j) { const int e = 8 * bj + 4 * n + j; v[e] = acc[ai][bj][m][n][j] * rs * gv[e]; }
                    store16_bf16_nt(P + pofs(u.pm * 256 + rloc, col0), v); }
            return;
        }
        EPI_ROWS_BEGIN
            if (mode == 2) {
#pragma unroll
                for (int e = 0; e < 16; ++e) v[e] *= sc;
            } else if (mode == 3) {
#pragma unroll
                for (int e = 0; e < 16; ++e) v[e] = __builtin_amdgcn_rcpf(1.f + __builtin_amdgcn_exp2f(-LOG2E * v[e]));
            } else if (mode == 4) {
#pragma unroll
                for (int e = 0; e < 16; ++e) v[e] = v[e] * __builtin_amdgcn_rcpf(1.f + __builtin_amdgcn_exp2f(-LOG2E * v[e]));
            }
            store16_bf16_nt(P + pofs(u.pm * 256 + rloc, col0), v);
        EPI_ROWS_END
    }
};
struct EpiPlainBf16 {
    bf16_t* O; int ldc;
    __device__ __forceinline__ void operator()(const f32x4 (&acc)[2][2][4][2], const Unit& u, int wr, int wc, int fr, int fq) const {
        const int col0 = u.pn * 256 + wc * 64 + fq * 8;
        EPI_ROWS_BEGIN
            store16_bf16(O + (size_t)(u.pm * 256 + rloc) * ldc + col0, v);
        EPI_ROWS_END
    }
};
struct EpiBranch {
    bf16_t* Mg; const bf16_t* P;
    __device__ __forceinline__ void operator()(const f32x4 (&acc)[2][2][4][2], const Unit& u, int wr, int wc, int fr, int fq) const {
        const int b = u.pn >> 2, pn = u.pn & 3, pm = u.pm - b * (HTOK / 256);
        const int col0 = pn * 256 + wc * 64 + fq * 8;
        const float keepw = b == 0 ? 0.f : 1.f;
#pragma unroll
        for (int ai = 0; ai < 2; ++ai)
#pragma unroll
            for (int mp2 = 0; mp2 < 2; ++mp2) {
                u32x4 ga[2][2], oa[2][2];
#pragma unroll
                for (int mm = 0; mm < 2; ++mm) { const int rloc = ai * 128 + wr * 64 + (2 * mp2 + mm) * 16 + fr; const int row = pm * 256 + rloc;
                    const bf16_t* gp = P + pofs(row, GATE_OFF + b * 1024 + col0); const bf16_t* mq = Mg + (size_t)row * D_MODEL + col0;
                    ga[mm][0] = *(const u32x4*)gp; ga[mm][1] = *(const u32x4*)(gp + 32);
                    if (b != 0) { oa[mm][0] = *(const u32x4*)mq; oa[mm][1] = *(const u32x4*)(mq + 32); } else { oa[mm][0] = (u32x4){0u, 0u, 0u, 0u}; oa[mm][1] = (u32x4){0u, 0u, 0u, 0u}; } }
#pragma unroll
                for (int mm = 0; mm < 2; ++mm) { const int m = 2 * mp2 + mm; const int row = pm * 256 + ai * 128 + wr * 64 + m * 16 + fr;
                    bf16_t* mq = Mg + (size_t)row * D_MODEL + col0;
#pragma unroll
                    for (int bj = 0; bj < 2; ++bj) { const u32x4 g = ga[mm][bj], o = oa[mm][bj]; const f32x4 a0 = acc[ai][bj][m][0], a1 = acc[ai][bj][m][1]; u32x4 w;
                        w.x = pk2(keepw * bflo(o.x) + a0[0] * bflo(g.x), keepw * bfhi(o.x) + a0[1] * bfhi(g.x));
                        w.y = pk2(keepw * bflo(o.y) + a0[2] * bflo(g.y), keepw * bfhi(o.y) + a0[3] * bfhi(g.y));
                        w.z = pk2(keepw * bflo(o.z) + a1[0] * bflo(g.z), keepw * bfhi(o.z) + a1[1] * bfhi(g.z));
                        w.w = pk2(keepw * bflo(o.w) + a1[2] * bflo(g.w), keepw * bfhi(o.w) + a1[3] * bfhi(g.w));
                        *(u32x4*)(mq + 32 * bj) = w; } }
            }
    }
};
struct EpiOut {
    const float* X; float* Out; bf16_t* A2; const float* g2; float* ssq;
    __device__ __forceinline__ void operator()(const f32x4 (&acc)[2][2][4][2], const Unit& u, int wr, int wc, int fr, int fq) const {
        const int col0 = u.pn * 256 + wc * 64 + fq * 8;
        float gv[16]; load16_f32(g2 + col0, gv);
#pragma unroll
        for (int ai = 0; ai < 2; ++ai)
#pragma unroll
            for (int mp2 = 0; mp2 < 2; ++mp2) {
                float xv[2][16];
#pragma unroll
                for (int mm = 0; mm < 2; ++mm) load16_f32(X + (size_t)(u.pm * 256 + ai * 128 + wr * 64 + (2 * mp2 + mm) * 16 + fr) * D_MODEL + col0, xv[mm]);
#pragma unroll
                for (int mm = 0; mm < 2; ++mm) { const int m = 2 * mp2 + mm; const size_t row = (size_t)(u.pm * 256 + ai * 128 + wr * 64 + m * 16 + fr);
                    float v[16]; float ss = 0.f;
#pragma unroll
                    for (int bj = 0; bj < 2; ++bj)
#pragma unroll
                        for (int n = 0; n < 2; ++n)
#pragma unroll
                            for (int j = 0; j < 4; ++j) { const int e = 8 * bj + 4 * n + j; v[e] = acc[ai][bj][m][n][j] + xv[mm][e]; ss += v[e] * v[e]; }
                    store16_f32_nt(Out + row * D_MODEL + col0, v);
#pragma unroll
                    for (int e = 0; e < 16; ++e) v[e] *= gv[e];
                    store16_bf16_nt(A2 + row * D_MODEL + col0, v);
                    ss += __shfl_xor(ss, 16); ss += __shfl_xor(ss, 32);
                    if (fq == 0) (void)__hip_atomic_fetch_add(ssq + row, ss, __ATOMIC_RELAXED, __HIP_MEMORY_SCOPE_AGENT); }
            }
    }
};
struct EpiFfnIn {
    bf16_t* UG; const float* ssq;
    __device__ __forceinline__ void operator()(const f32x4 (&acc)[2][2][4][2], const Unit& u, int wr, int wc, int fr, int fq) const {
        const int col0 = u.pn * 256 + wc * 64 + fq * 8;
        EPI_ROWS_BEGIN
            const size_t row = (size_t)(u.pm * 256 + rloc);
            float sp[16]; load16c_f32(ssq + row * 16, sp);
            float ss = 0.f;
#pragma unroll
            for (int e = 0; e < 16; ++e) ss += sp[e];
            const float rs = rsqrtf(ss * (1.f / 1024.f) + NORM_EPS);
#pragma unroll
            for (int e = 0; e < 16; ++e) v[e] *= rs;
            store16_bf16(UG + row * FF2 + col0, v);
        EPI_ROWS_END
    }
};
__device__ __forceinline__ float gelu_exact(float v) {
    const float t = __builtin_amdgcn_rcpf(fabsf(v) * 0.2316418882f + 1.0f);
    float q = t * 0.5307027145f + (-0.7265760135f); q = q * t + 0.7107068705f; q = q * t + (-0.142248368f); q = q * t + 0.127414796f; q = q * t;
    const float e = __builtin_amdgcn_exp2f(v * v * (-0.72134752044f));
    const float m = v * (q * e);
    return v < 0.f ? m : v - m;
}
__device__ __forceinline__ f32x2 gelu_pk(f32x2 v) {
    const f32x2 av = __builtin_elementwise_abs(v), d = av * 0.2316418882f + 1.0f;
    f32x2 t; t.x = __builtin_amdgcn_rcpf(d.x); t.y = __builtin_amdgcn_rcpf(d.y);
    f32x2 q = t * 0.5307027145f + (-0.7265760135f); q = q * t + 0.7107068705f; q = q * t + (-0.142248368f); q = q * t + 0.127414796f; q = q * t;
    const f32x2 sq = (v * v) * (-0.72134752044f);
    f32x2 e; e.x = __builtin_amdgcn_exp2f(sq.x); e.y = __builtin_amdgcn_exp2f(sq.y);
    const f32x2 m = v * (q * e), r = v - m;
    f32x2 o; o.x = v.x < 0.f ? m.x : r.x; o.y = v.y < 0.f ? m.y : r.y; return o;
}
struct EpiFfnInConv {
    bf16_t* YF; bf16_t* HALO; const float* ssq; const float* cw; const float* cb;
    __device__ __forceinline__ void operator()(const f32x4 (&acc)[2][2][4][2], const Unit& u, int wr, int wc, int fr, int fq) const {
        const int lane = fq * 16 + fr, chb = u.pn * 128 + wc * 32 + fq * 8;
        (void)lane;
        float rsa[2][4]; f32x4 wv[2][4];
#pragma unroll
        for (int ai = 0; ai < 2; ++ai)
#pragma unroll
            for (int m = 0; m < 4; ++m) rsa[ai][m] = ssq[(unsigned)(u.pm * 256 + ai * 128 + wr * 64 + m * 16 + fr)];
#pragma unroll
        for (int n = 0; n < 2; ++n) { wv[n][0] = *(const f32x4*)(cw + chb + 4 * n); wv[n][1] = *(const f32x4*)(cw + D_FF + chb + 4 * n); wv[n][2] = *(const f32x4*)(cw + 2 * D_FF + chb + 4 * n); wv[n][3] = *(const f32x4*)(cb + chb + 4 * n); }
#pragma unroll
        for (int ai = 0; ai < 2; ++ai) {
            float rs[4];
#pragma unroll
            for (int m = 0; m < 4; ++m) rs[m] = rsqrtf(rsa[ai][m] * (1.f / 1024.f) + NORM_EPS);
            const int blk = u.pm * 4 + 2 * ai + wr;
            u32x2 keep[4];
#pragma unroll
            for (int n = 0; n < 2; ++n) {
                const f32x4 w0 = wv[n][0], w1 = wv[n][1], w2 = wv[n][2], bb = wv[n][3];
#pragma unroll
                for (int m = 0; m < 4; ++m) {
                    float yv[4], uc[4], gc[4];
#pragma unroll
                    for (int j = 0; j < 4; ++j) {
                        const float ucur = acc[ai][0][m][n][j] * rs[m];
                        const float um1 = m > 0 ? acc[ai][0][m > 0 ? m - 1 : 0][n][j] * rs[m > 0 ? m - 1 : 0] : 0.f;
                        const float up1 = m < 3 ? acc[ai][0][m < 3 ? m + 1 : 3][n][j] * rs[m < 3 ? m + 1 : 3] : 0.f;
                        const float uprev = __builtin_bit_cast(float, __builtin_amdgcn_update_dpp(0, __builtin_bit_cast(int, fr == 15 ? um1 : ucur), 0x121, 0xf, 0xf, false));
                        const float unext = __builtin_bit_cast(float, __builtin_amdgcn_update_dpp(0, __builtin_bit_cast(int, fr == 0 ? up1 : ucur), 0x12F, 0xf, 0xf, false));
                        yv[j] = bb[j] + w0[j] * uprev + w1[j] * ucur + w2[j] * unext;
                        uc[j] = ucur; gc[j] = acc[ai][1][m][n][j] * rs[m];
                    }
                    { const f32x2 g01 = gelu_pk((f32x2){yv[0], yv[1]}), g23 = gelu_pk((f32x2){yv[2], yv[3]});
                      yv[0] = g01.x * gc[0]; yv[1] = g01.y * gc[1]; yv[2] = g23.x * gc[2]; yv[3] = g23.y * gc[3]; }
                    const unsigned row = (unsigned)(u.pm * 256 + ai * 128 + wr * 64 + m * 16 + fr);
                    const bool e0 = (m == 0 && fr == 0), e63 = (m == 3 && fr == 15);
                    { u32x2 o; o.x = pk2(yv[0], yv[1]); o.y = pk2(yv[2], yv[3]);
                      if (n == 0) keep[m] = o;
                      else if (!(e0 || e63)) { u32x4 o4; o4.x = keep[m].x; o4.y = keep[m].y; o4.z = o.x; o4.w = o.y; __builtin_nontemporal_store(o4, (u32x4*)(YF + (row * (unsigned)D_FF + (unsigned)chb))); } }
                    if (m == 0 || m == 3) {
                        const int hs = m == 0 ? (fr == 0 ? 0 : (fr == 1 ? 1 : -1)) : (fr == 14 ? 2 : (fr == 15 ? 3 : -1));
                        if (hs >= 0) { u32x2 o; o.x = pk2(uc[0], uc[1]); o.y = pk2(uc[2], uc[3]); *(u32x2*)(HALO + ((unsigned)(blk * 6 + hs) * (unsigned)D_FF + (unsigned)(chb + 4 * n))) = o; }
                        if (e0 || e63) { u32x2 o; o.x = pk2(gc[0], gc[1]); o.y = pk2(gc[2], gc[3]); *(u32x2*)(HALO + ((unsigned)(blk * 6 + (e0 ? 4 : 5)) * (unsigned)D_FF + (unsigned)(chb + 4 * n))) = o; }
                    }
                    asm volatile("" ::: "memory");
                }
            }
        }
    }
};
struct EpiFfnOut {
    float* Out;
    __device__ __forceinline__ void operator()(const f32x4 (&acc)[2][2][4][2], const Unit& u, int wr, int wc, int fr, int fq) const {
        const int col0 = u.pn * 256 + wc * 64 + fq * 8;
#pragma unroll
        for (int ai = 0; ai < 2; ++ai)
#pragma unroll
            for (int mp2 = 0; mp2 < 2; ++mp2) {
                float xv[2][16];
#pragma unroll
                for (int mm = 0; mm < 2; ++mm) load16_f32(Out + (size_t)(u.pm * 256 + ai * 128 + wr * 64 + (2 * mp2 + mm) * 16 + fr) * D_MODEL + col0, xv[mm]);
#pragma unroll
                for (int mm = 0; mm < 2; ++mm) { const int m = 2 * mp2 + mm; float v[16];
#pragma unroll
                    for (int bj = 0; bj < 2; ++bj)
#pragma unroll
                        for (int n = 0; n < 2; ++n)
#pragma unroll
                            for (int j = 0; j < 4; ++j) { const int e = 8 * bj + 4 * n + j; v[e] = acc[ai][bj][m][n][j] + xv[mm][e]; }
                    store16_f32_nt(Out + (size_t)(u.pm * 256 + ai * 128 + wr * 64 + m * 16 + fr) * D_MODEL + col0, v); }
            }
    }
};

__device__ __forceinline__ int ffn_row_of(int ng) { const int gate = ng >= D_FF ? 1 : 0, ch = ng - gate * D_FF, c7 = ch & 127;
    return (ch >> 7) * 256 + 128 * gate + 32 * (c7 >> 5) + 16 * ((c7 >> 2) & 1) + 4 * ((c7 >> 3) & 3) + (c7 & 3); }
template <int PERMMODE>
__device__ __forceinline__ void p0_transpose_item(const float* W, int K, int N, bf16_t* WT, int row_off, LAS float* scr, int item, int lane) {
    const int nblk = N / 32, kb = item / nblk, nb = item % nblk, k0 = 64 * kb, n0 = 32 * nb;
#pragma unroll 8
    for (int i = 0; i < 32; ++i) { const int kk = 2 * i + (lane >> 5); scr[kk * 33 + (lane & 31)] = W[(size_t)(k0 + kk) * N + n0 + (lane & 31)]; }
    asm volatile("s_waitcnt lgkmcnt(0)" ::: "memory");
    const int c = lane & 7;
#pragma unroll
    for (int j = 0; j < 4; ++j) { const int n = (lane >> 3) + 8 * j; const LAS float* s = scr + (8 * c) * 33 + n;
        u32x4 o; o.x = pk2(s[0 * 33], s[1 * 33]); o.y = pk2(s[2 * 33], s[3 * 33]); o.z = pk2(s[4 * 33], s[5 * 33]); o.w = pk2(s[6 * 33], s[7 * 33]);
        const int ng = n0 + n, nrow = PERMMODE == 1 ? ffn_row_of(ng) : (ng & ~255) + slot_of(ng & 255);
        *(u32x4*)(WT + (size_t)(row_off + nrow) * K + k0 + 8 * c) = o; }
    asm volatile("s_waitcnt lgkmcnt(0)" ::: "memory");
}
__device__ __forceinline__ void rms_row_to_bf16(const float* xrow, const float* g, bf16_t* orow, int lane) {
    const f32x4* xr = (const f32x4*)xrow + lane; const f32x4* gr = (const f32x4*)g + lane;
    f32x4 v[4]; float s = 0.f;
#pragma unroll
    for (int j = 0; j < 4; ++j) { v[j] = xr[64 * j]; s += (v[j].x * v[j].x + v[j].y * v[j].y) + (v[j].z * v[j].z + v[j].w * v[j].w); }
    const float rs = rsqrtf(wave_sum(s) * (1.f / 1024.f) + NORM_EPS);
    u32x2* o8 = (u32x2*)orow + lane;
#pragma unroll
    for (int j = 0; j < 4; ++j) { const f32x4 gg = gr[64 * j]; u32x2 w; w.x = pk2(v[j].x * rs * gg.x, v[j].y * rs * gg.y); w.y = pk2(v[j].z * rs * gg.z, v[j].w * rs * gg.w); o8[64 * j] = w; }
}

__device__ __forceinline__ void rms_row2_to_bf16(const float* xa, const float* xb, const float* g, bf16_t* oa, bf16_t* ob, int lane) {
    const f32x4* ra = (const f32x4*)xa + lane; const f32x4* rb = (const f32x4*)xb + lane; const f32x4* gr = (const f32x4*)g + lane;
    f32x4 va[4], vb[4]; float sa = 0.f, sb = 0.f;
#pragma unroll
    for (int j = 0; j < 4; ++j) { va[j] = ra[64 * j]; vb[j] = rb[64 * j]; }
#pragma unroll
    for (int j = 0; j < 4; ++j) { sa += (va[j].x * va[j].x + va[j].y * va[j].y) + (va[j].z * va[j].z + va[j].w * va[j].w); sb += (vb[j].x * vb[j].x + vb[j].y * vb[j].y) + (vb[j].z * vb[j].z + vb[j].w * vb[j].w); }
#pragma unroll
    for (int o = 1; o < 64; o <<= 1) { sa += __shfl_xor(sa, o); sb += __shfl_xor(sb, o); }
    const float rsa = rsqrtf(sa * (1.f / 1024.f) + NORM_EPS), rsb = rsqrtf(sb * (1.f / 1024.f) + NORM_EPS);
    u32x2* o8a = (u32x2*)oa + lane; u32x2* o8b = (u32x2*)ob + lane;
#pragma unroll
    for (int j = 0; j < 4; ++j) { const f32x4 gg = gr[64 * j]; u32x2 w;
        w.x = pk2(va[j].x * rsa * gg.x, va[j].y * rsa * gg.y); w.y = pk2(va[j].z * rsa * gg.z, va[j].w * rsa * gg.w); o8a[64 * j] = w;
        w.x = pk2(vb[j].x * rsb * gg.x, vb[j].y * rsb * gg.y); w.y = pk2(vb[j].z * rsb * gg.z, vb[j].w * rsb * gg.w); o8b[64 * j] = w; }
}


__device__ __forceinline__ void dil_wave(const bf16_t* proj, bf16_t* odil, float* lse, const float* cconst, int item, LAS char* vl, int lane) {
    asm volatile("" : "+v"(lane));
    const int qb = item & 31; int t = item >> 5; const int g = t % 3; t /= 3; const int h = t & 7, b = t >> 3;
    const float cshift = cconst[g];
    const int lr = 2 * g, r = 1 << lr, nsub = SEQ >> lr, nblk = nsub >> 6;
    const int c = qb / nblk, nb = qb % nblk, i0 = nb * 64;
    const int rr = lane & 31, hh = lane >> 5;
    const int rowb = b * SEQ;
    const int qcol = g * 1536 + h * 64, kcol = qcol + 512, vcol = qcol + 1024;
    const int kt_lo = i0 == 0 ? 2 : 0, kt_hi = (i0 == nsub - 64) ? 4 : 6;
    bf16x8 kn[4];
#define DIL_ISSUE(KT) do { const int j0_ = i0 - 64 + 32 * (KT); \
        { int jr = j0_ + rr; jr = jr < 0 ? 0 : (jr >= nsub ? nsub - 1 : jr); const bf16_t* p = proj + pofs(rowb + jr * r + c, kcol + 32 * hh); \
          _Pragma("unroll") for (int ks = 0; ks < 4; ++ks) kn[ks] = *(const bf16x8*)(p + 8 * ks); } \
        _Pragma("unroll") for (int q = 0; q < 4; ++q) { int jv = j0_ + 8 * q + (lane >> 3); jv = jv < 0 ? 0 : (jv >= nsub ? nsub - 1 : jv); \
          __builtin_amdgcn_global_load_lds((const unsigned*)(proj + pofs(rowb + jv * r + c, vcol + 8 * (lane & 7))), (LAS unsigned*)(vl + 4096 * ((KT) & 1) + 1024 * q), 16, 0, 0); } } while (0)
    DIL_ISSUE(kt_lo);
    bf16x8 qf[2][4];
#pragma unroll
    for (int qt = 0; qt < 2; ++qt) { const int tok = (i0 + 32 * qt + rr) * r + c; const bf16_t* p = proj + pofs(rowb + tok, qcol + 32 * hh);
#pragma unroll
        for (int ks = 0; ks < 4; ++ks) qf[qt][ks] = *(const bf16x8*)(p + 8 * ks); }
    f32x16 o[2][2];
#pragma unroll
    for (int a = 0; a < 2; ++a)
#pragma unroll
        for (int q = 0; q < 2; ++q)
#pragma unroll
            for (int e = 0; e < 16; ++e) o[a][q][e] = 0.f;
    float lrun[2] = {0.f, 0.f};
    const float slope2 = exp2f(-(float)(h + 1)) * (float)r * LOG2E;
    const int blk = (lane >> 4) & 1, q4 = (lane & 15) >> 2, p4 = lane & 3;
    float fd[16];
#pragma unroll
    for (int e = 0; e < 16; ++e) fd[e] = (float)(rr - 4 * hh - ((e & 3) + 8 * (e >> 2)));
#ifdef PROBE_DILLOOP
    for (int rep = 0; rep < 2; ++rep) {
    if (rep) { DIL_ISSUE(kt_lo); lrun[0] = 0.f; lrun[1] = 0.f;
        _Pragma("unroll") for (int a = 0; a < 2; ++a) _Pragma("unroll") for (int q = 0; q < 2; ++q) _Pragma("unroll") for (int e = 0; e < 16; ++e) o[a][q][e] = 0.f; }
#endif
    for (int kt = kt_lo; kt < kt_hi; ++kt) {
        asm volatile("s_waitcnt vmcnt(0)" ::: "memory");
        bf16x8 kf[4];
#pragma unroll
        for (int ks = 0; ks < 4; ++ks) kf[ks] = kn[ks];
        if (kt + 1 < kt_hi) DIL_ISSUE(kt + 1);
        asm volatile("" ::: "memory");
        LAS char* vb = vl + 4096 * (kt & 1);
        bf16x8 pf[2][2];
        bool act[2];
#pragma unroll
        for (int qt = 0; qt < 2; ++qt) {
            const int mrel = kt - qt;
            act[qt] = !(mrel == 5 || mrel == -1);
            if (!act[qt]) continue;
            f32x16 s;
#pragma unroll
            for (int e = 0; e < 16; ++e) s[e] = -cshift;
#pragma unroll
            for (int ks = 0; ks < 4; ++ks) s = MFMA32(kf[ks], qf[qt][ks], s);
            const float Df = 64.f - 32.f * (float)mrel;
            const bool edge = (mrel == 0) || (mrel == 4);
            float rs = 0.f;
#pragma unroll
            for (int e = 0; e < 16; ++e) { const float tt = Df + fd[e]; float sv = fmaf(-slope2, fabsf(tt), s[e]);
                if (edge) sv = fabsf(tt) <= 64.f ? sv : -INFINITY;
                const float p = __builtin_amdgcn_exp2f(sv); s[e] = p; rs += p; }
            lrun[qt] += rs;
#pragma unroll
            for (int s2 = 0; s2 < 2; ++s2) pf[qt][s2] = pack8(s[8 * s2], s[8 * s2 + 1], s[8 * s2 + 2], s[8 * s2 + 3], s[8 * s2 + 4], s[8 * s2 + 5], s[8 * s2 + 6], s[8 * s2 + 7]);
        }
#pragma unroll
        for (int dt = 0; dt < 2; ++dt)
#pragma unroll
            for (int s2 = 0; s2 < 2; ++s2) {
                LAS char* a = vb + (16 * s2 + 4 * hh + q4) * 128 + (32 * dt + 16 * blk + 4 * p4) * 2;
                const bf16x8 vf = cat4(tr_read(a), tr_read(a + 8 * 128));
#pragma unroll
                for (int qt = 0; qt < 2; ++qt) if (act[qt]) o[dt][qt] = MFMA32(vf, pf[qt][s2], o[dt][qt]);
            }
        asm volatile("" ::: "memory");
    }
#ifdef PROBE_DILLOOP
    }
#endif
#undef DIL_ISSUE
#pragma unroll
    for (int qt = 0; qt < 2; ++qt) {
        const float lt = lrun[qt] + __shfl_xor(lrun[qt], 32);
        const int row = 32 * qt + rr; const float inv = __builtin_amdgcn_rcpf(lt);
#pragma unroll
        for (int dt = 0; dt < 2; ++dt)
#pragma unroll
            for (int gq = 0; gq < 4; ++gq) { u32x2 w; w.x = pk2(o[dt][qt][4 * gq] * inv, o[dt][qt][4 * gq + 1] * inv); w.y = pk2(o[dt][qt][4 * gq + 2] * inv, o[dt][qt][4 * gq + 3] * inv);
                *(LAS u32x2*)(vl + row * 128 + 16 * ((4 * dt + gq) ^ (row & 7)) + 8 * hh) = w; }
        if (hh == 0) lse[((size_t)g * HTOK + (size_t)b * SEQ + (i0 + row) * r + c) * 8 + h] = log2f(lt) + cshift;
    }
    asm volatile("" ::: "memory");
    { bf16_t* ob = odil + ((size_t)g * HTOK + (size_t)b * SEQ) * 512 + h * 64;
#pragma unroll
        for (int q = 0; q < 8; ++q) { const int row = 8 * q + (lane >> 3), pos = lane & 7, ch = pos ^ (row & 7);
            const u32x4 v = *(const LAS u32x4*)(vl + row * 128 + 16 * pos);
            *(u32x4*)(ob + (size_t)((i0 + row) * r + c) * 512 + 8 * ch) = v; } }
    asm volatile("" ::: "memory");
}

__device__ __forceinline__ void ret_u_item(const bf16_t* proj, bf16_t* U, const float* decay_logit, int item, LAS char* L, int tid) {
    asm volatile("" : "+v"(tid));
    const int n = item & 15, h = (item >> 4) & 3, b = item >> 6;
    const int lane = tid & 63, wave = tid >> 6, rr = lane & 31, hh = lane >> 5, blk = (lane >> 4) & 1, q4 = (lane & 15) >> 2, p4 = lane & 3;
    const float Lf = -log1pf(expf(-decay_logit[h])) * LOG2E, Lb = -log1pf(expf(-decay_logit[4 + h])) * LOG2E;
    const int rowb = b * SEQ + 128 * n;
    { const int row = tid >> 2, pc = tid & 3; const bf16_t* p = proj + pofs(rowb + row, RET_OFF + 256 + h * 64 + 16 * pc);
        const u32x4 a = *(const u32x4*)p, c = *(const u32x4*)(p + 8);
        const float wf = exp2f(Lf * (float)(127 - row)), wb = exp2f(Lb * (float)row);
        u32x4 o;
        o.x = pk2(bflo(a.x) * wf, bfhi(a.x) * wf); o.y = pk2(bflo(a.y) * wf, bfhi(a.y) * wf); o.z = pk2(bflo(a.z) * wf, bfhi(a.z) * wf); o.w = pk2(bflo(a.w) * wf, bfhi(a.w) * wf);
        *(LAS u32x4*)(L + row * 128 + 32 * pc) = o;
        o.x = pk2(bflo(c.x) * wf, bfhi(c.x) * wf); o.y = pk2(bflo(c.y) * wf, bfhi(c.y) * wf); o.z = pk2(bflo(c.z) * wf, bfhi(c.z) * wf); o.w = pk2(bflo(c.w) * wf, bfhi(c.w) * wf);
        *(LAS u32x4*)(L + row * 128 + 32 * pc + 16) = o;
        o.x = pk2(bflo(a.x) * wb, bfhi(a.x) * wb); o.y = pk2(bflo(a.y) * wb, bfhi(a.y) * wb); o.z = pk2(bflo(a.z) * wb, bfhi(a.z) * wb); o.w = pk2(bflo(a.w) * wb, bfhi(a.w) * wb);
        *(LAS u32x4*)(L + 16384 + row * 128 + 32 * pc) = o;
        o.x = pk2(bflo(c.x) * wb, bfhi(c.x) * wb); o.y = pk2(bflo(c.y) * wb, bfhi(c.y) * wb); o.z = pk2(bflo(c.z) * wb, bfhi(c.z) * wb); o.w = pk2(bflo(c.w) * wb, bfhi(c.w) * wb);
        *(LAS u32x4*)(L + 16384 + row * 128 + 32 * pc + 16) = o; }
#pragma unroll
    for (int q = 0; q < 4; ++q) { const int idx = tid + 512 * q, row = idx >> 4, pc = idx & 15;
        *(LAS u32x4*)(L + 32768 + row * 256 + 16 * pc) = *(const u32x4*)(proj + pofs(rowb + row, RET_OFF + 512 + h * 128 + 8 * pc)); }
    __syncthreads();
    const int dir = wave >> 2, vt = wave & 3;
    f32x16 acc[2];
#pragma unroll
    for (int a = 0; a < 2; ++a)
#pragma unroll
        for (int e = 0; e < 16; ++e) acc[a][e] = 0.f;
    LAS char* KI = L + 16384 * dir; LAS char* VI = L + 32768;
#pragma unroll
    for (int ks = 0; ks < 8; ++ks) {
        const int jrow = 16 * ks + 8 * hh + q4;
        LAS char* vb = VI + jrow * 256 + (32 * vt + 16 * blk + 4 * p4) * 2;
        const bf16x8 bfr = cat4(tr_read(vb), tr_read(vb + 4 * 256));
#pragma unroll
        for (int dt = 0; dt < 2; ++dt) { LAS char* ka = KI + jrow * 128 + (32 * dt + 16 * blk + 4 * p4) * 2;
            const bf16x8 afr = cat4(tr_read(ka), tr_read(ka + 4 * 128));
            acc[dt] = MFMA32(afr, bfr, acc[dt]); }
    }
    bf16_t* up = U + ((size_t)((b * 4 + h) * 16 + n) * 2 + dir) * 8192;
#pragma unroll
    for (int dt = 0; dt < 2; ++dt)
#pragma unroll
        for (int e = 0; e < 16; ++e) up[(32 * dt + (e & 3) + 8 * (e >> 2) + 4 * hh) * 128 + 32 * vt + rr] = (bf16_t)(pk2(acc[dt][e], 0.f) & 0xffffu);
    __syncthreads();
}
__device__ __forceinline__ bf16x8 scale_frag(bf16x8 f, float sc) {
    const u32x4 w = __builtin_bit_cast(u32x4, f);
    return pack8(bflo(w.x) * sc, bfhi(w.x) * sc, bflo(w.y) * sc, bfhi(w.y) * sc, bflo(w.z) * sc, bfhi(w.z) * sc, bflo(w.w) * sc, bfhi(w.w) * sc);
}
__device__ __forceinline__ void st16_lds_bf16(LAS char* p, const float (&v)[16]) {
    u32x4 a, b; a.x = pk2(v[0], v[1]); a.y = pk2(v[2], v[3]); a.z = pk2(v[4], v[5]); a.w = pk2(v[6], v[7]);
    b.x = pk2(v[8], v[9]); b.y = pk2(v[10], v[11]); b.z = pk2(v[12], v[13]); b.w = pk2(v[14], v[15]);
    *(LAS u32x4*)p = a; *(LAS u32x4*)(p + 16) = b;
}
__device__ __forceinline__ void ret_chunk_item(const bf16_t* proj, const bf16_t* U, bf16_t* yret, const float* decay_logit, const float* gn_g, int item, LAS char* L, int tid) {
    asm volatile("" : "+v"(tid));
    const int pr = item & 7, h = (item >> 3) & 3, b = item >> 5, n = 2 * pr;
    const int lane = tid & 63, wave = tid >> 6, rr = lane & 31, hh = lane >> 5, blk = (lane >> 4) & 1, q4 = (lane & 15) >> 2, p4 = lane & 3;
    const float Lf = -log1pf(expf(-decay_logit[h])) * LOG2E, Lb = -log1pf(expf(-decay_logit[4 + h])) * LOG2E;
    const int rowb = b * SEQ + 128 * n;
#pragma unroll
    for (int q = 0; q < 8; ++q) { const int idx = tid + 512 * q, row = idx >> 4, pc = idx & 15;
        *(LAS u32x4*)(L + row * 256 + 16 * pc) = *(const u32x4*)(proj + pofs(rowb + row, RET_OFF + 512 + h * 128 + 8 * pc)); }
    { const bf16_t* Ub = U + (size_t)((b * 4 + h) * 16) * 2 * 8192 + tid * 16;
        const float wf = exp2f(128.f * Lf), wb = exp2f(128.f * Lb);
        const int d = tid >> 3, v0 = (tid & 7) * 16;
        LAS char* S = L + 65536 + d * 256 + v0 * 2;
        float acc[16], t[16];
#pragma unroll
        for (int e = 0; e < 16; ++e) acc[e] = 0.f;
        for (int m0 = n - 4 * ((n + 3) >> 2); m0 < n; m0 += 4) {
            float t4[4][16];
#pragma unroll
            for (int u4 = 0; u4 < 4; ++u4) { const int m = m0 + u4; load16c_bf16(Ub + (size_t)((m < 0 ? 0 : m) * 2) * 8192, t4[u4]); }
#pragma unroll
            for (int u4 = 0; u4 < 4; ++u4) { const float msk = (m0 + u4) < 0 ? 0.f : 1.f;
#pragma unroll
                for (int e = 0; e < 16; ++e) acc[e] = acc[e] * wf + t4[u4][e] * msk; } }
        st16_lds_bf16(S, acc);
        load16c_bf16(Ub + (size_t)(n * 2) * 8192, t);
#pragma unroll
        for (int e = 0; e < 16; ++e) acc[e] = acc[e] * wf + t[e];
        st16_lds_bf16(S + 2 * 16384, acc);
#pragma unroll
        for (int e = 0; e < 16; ++e) acc[e] = 0.f;
        { const int cnt = 14 - n;
          for (int m0 = 15 + 4 * ((cnt + 3) >> 2) - cnt; m0 > 15 - cnt; m0 -= 4) {
            float t4[4][16];
#pragma unroll
            for (int u4 = 0; u4 < 4; ++u4) { const int m = m0 - u4; load16c_bf16(Ub + (size_t)((m > 15 ? 15 : m) * 2 + 1) * 8192, t4[u4]); }
#pragma unroll
            for (int u4 = 0; u4 < 4; ++u4) { const float msk = (m0 - u4) > 15 ? 0.f : 1.f;
#pragma unroll
                for (int e = 0; e < 16; ++e) acc[e] = acc[e] * wb + t4[u4][e] * msk; } } }
        st16_lds_bf16(S + 3 * 16384, acc);
        load16c_bf16(Ub + (size_t)((n + 1) * 2 + 1) * 8192, t);
#pragma unroll
        for (int e = 0; e < 16; ++e) acc[e] = acc[e] * wb + t[e];
        st16_lds_bf16(S + 1 * 16384, acc);
    }
    __syncthreads();
    const int cw = wave >> 2, i = 32 * (wave & 3) + rr;
    const int crow = rowb + 128 * cw;
    bf16x8 qf[4];
    { const bf16_t* p = proj + pofs(crow + i, RET_OFF + h * 64 + 32 * hh);
#pragma unroll
        for (int ks = 0; ks < 4; ++ks) qf[ks] = *(const bf16x8*)(p + 8 * ks); }
    f32x16 y[4];
#pragma unroll
    for (int a = 0; a < 4; ++a)
#pragma unroll
        for (int e = 0; e < 16; ++e) y[a][e] = 0.f;
    LAS char* VI = L + cw * 32768;
#pragma unroll
    for (int kt = 0; kt < 4; ++kt) {
        const int j0 = 32 * kt;
        bf16x8 kf[4];
        { const bf16_t* p = proj + pofs(crow + j0 + rr, RET_OFF + 256 + h * 64 + 32 * hh);
#pragma unroll
            for (int ks = 0; ks < 4; ++ks) kf[ks] = *(const bf16x8*)(p + 8 * ks); }
        f32x16 s;
#pragma unroll
        for (int e = 0; e < 16; ++e) s[e] = 0.f;
#pragma unroll
        for (int ks = 0; ks < 4; ++ks) s = MFMA32(kf[ks], qf[ks], s);
#pragma unroll
        for (int e = 0; e < 16; ++e) { const int j = j0 + (e & 3) + 8 * (e >> 2) + 4 * hh; const int dd = i - j;
            const float w = dd >= 0 ? exp2f(Lf * (float)dd) : exp2f(Lb * (float)(-dd)); s[e] *= w; }
        bf16x8 pf[2];
#pragma unroll
        for (int s2 = 0; s2 < 2; ++s2) pf[s2] = pack8(s[8 * s2], s[8 * s2 + 1], s[8 * s2 + 2], s[8 * s2 + 3], s[8 * s2 + 4], s[8 * s2 + 5], s[8 * s2 + 6], s[8 * s2 + 7]);
#pragma unroll
        for (int vt = 0; vt < 4; ++vt)
#pragma unroll
            for (int s2 = 0; s2 < 2; ++s2) {
                LAS char* a = VI + (j0 + 16 * s2 + 4 * hh + q4) * 256 + (32 * vt + 16 * blk + 4 * p4) * 2;
                const bf16x8 vf = cat4(tr_read(a), tr_read(a + 8 * 256));
                y[vt] = MFMA32(vf, pf[s2], y[vt]);
            }
    }
#pragma unroll
    for (int dir = 0; dir < 2; ++dir) {
        const float sc = dir == 0 ? exp2f(Lf * (float)(i + 1)) : exp2f(Lb * (float)(128 - i));
        LAS char* SI = L + 65536 + (cw * 2 + dir) * 16384;
#pragma unroll
        for (int ks = 0; ks < 4; ++ks) {
            const bf16x8 qs = scale_frag(qf[ks], sc);
#pragma unroll
            for (int vt = 0; vt < 4; ++vt) {
                LAS char* a = SI + (32 * hh + 8 * ks + q4) * 256 + (32 * vt + 16 * blk + 4 * p4) * 2;
                const bf16x8 af = cat4(tr_read(a), tr_read(a + 4 * 256));
                y[vt] = MFMA32(af, qs, y[vt]);
            }
        }
    }
    float sm = 0.f;
#pragma unroll
    for (int vt = 0; vt < 4; ++vt)
#pragma unroll
        for (int e = 0; e < 16; ++e) sm += y[vt][e];
    sm += __shfl_xor(sm, 32);
    const float mu = sm * (1.f / 128.f);
    float sq = 0.f;
#pragma unroll
    for (int vt = 0; vt < 4; ++vt)
#pragma unroll
        for (int e = 0; e < 16; ++e) { const float dlt = y[vt][e] - mu; sq += dlt * dlt; }
    sq += __shfl_xor(sq, 32);
    const float rs = rsqrtf(sq * (1.f / 128.f) + NORM_EPS);
    const bf16_t* gp = proj + pofs(crow + i, RET_OFF + 1024 + h * 128);
    bf16_t* op = yret + ((size_t)b * SEQ + 128 * (n + cw) + i) * 512 + h * 128;
    const float* gg = gn_g + h * 128;
#pragma unroll
    for (int vt = 0; vt < 4; ++vt)
#pragma unroll
        for (int gq = 0; gq < 4; ++gq) { const int vi = 32 * vt + 8 * gq + 4 * hh;
            const u32x2 gw = *(const u32x2*)(gp + vi); const f32x4 g4 = *(const f32x4*)(gg + vi);
            u32x2 w; w.x = pk2((y[vt][4 * gq] - mu) * rs * g4.x * bflo(gw.x), (y[vt][4 * gq + 1] - mu) * rs * g4.y * bfhi(gw.x));
            w.y = pk2((y[vt][4 * gq + 2] - mu) * rs * g4.z * bflo(gw.y), (y[vt][4 * gq + 3] - mu) * rs * g4.w * bfhi(gw.y));
            *(u32x2*)(op + vi) = w; }
    __syncthreads();
}

__device__ __forceinline__ bf16x8 scale8(u32x4 w, float rs, const float* g) {
    const f32x4 g0 = *(const f32x4*)g, g1 = *(const f32x4*)(g + 4);
    return pack8(bflo(w.x) * rs * g0.x, bfhi(w.x) * rs * g0.y, bflo(w.y) * rs * g0.z, bfhi(w.y) * rs * g0.w, bflo(w.z) * rs * g1.x, bfhi(w.z) * rs * g1.y, bflo(w.w) * rs * g1.z, bfhi(w.w) * rs * g1.w);
}
__device__ __forceinline__ float ssq8(u32x4 w) {
    const float a = bflo(w.x), b = bfhi(w.x), c = bflo(w.y), d = bfhi(w.y), e = bflo(w.z), f = bfhi(w.z), g = bflo(w.w), h = bfhi(w.w);
    return ((a * a + b * b) + (c * c + d * d)) + ((e * e + f * f) + (g * g + h * h));
}
constexpr int MEM_PITCH = 272;
__device__ __forceinline__ void mem_item(const bf16_t* proj, const bf16_t* memkv  , bf16_t* ymem, const float* gqn, const float* gkn, const float* cconst, int item, LAS char* L, int tid) {
    asm volatile("" : "+v"(tid));
    const float cshift = cconst[3];
    const int qr = item & 3, hd = (item >> 2) & 3, b = item >> 4;
    const int lane = tid & 63, wave = tid >> 6, rr = lane & 31, hh = lane >> 5, blk = (lane >> 4) & 1, q4 = (lane & 15) >> 2, p4 = lane & 3;
    const bf16_t* kvb = memkv + (size_t)b * N_MEM * 1024 + hd * 128;
    LAS char* KI = L; LAS char* VI = L + 256 * MEM_PITCH;
#pragma unroll
    for (int q = 0; q < 8; ++q) {
        const int idx = tid + 512 * q, row = idx >> 4, pc = idx & 15;
        const u32x4 kw = *(const u32x4*)(kvb + (size_t)row * 1024 + 8 * pc), vw = *(const u32x4*)(kvb + (size_t)row * 1024 + 512 + 8 * pc);
        float ss = ssq8(kw);
        ss += __shfl_xor(ss, 1); ss += __shfl_xor(ss, 2); ss += __shfl_xor(ss, 4); ss += __shfl_xor(ss, 8);
        const float rs = rsqrtf(ss * (1.f / 128.f) + NORM_EPS);
        *(LAS bf16x8*)(KI + row * MEM_PITCH + 16 * pc) = scale8(kw, rs, gkn + 8 * pc);
        *(LAS u32x4*)(VI + row * MEM_PITCH + 16 * pc) = vw;
    }
    __syncthreads();
#pragma unroll 1
    for (int tq = 0; tq < 2; ++tq) {
        const int i = 512 * qr + 32 * (wave * 2 + tq) + rr;
        bf16x8 qf[8];
        { const bf16_t* p = proj + pofs(b * SEQ + i, MEMQ_OFF + hd * 128 + 64 * hh);
            u32x4 raw[8]; float ss = 0.f;
#pragma unroll
            for (int ks = 0; ks < 8; ++ks) { raw[ks] = *(const u32x4*)(p + 8 * ks); ss += ssq8(raw[ks]); }
            ss += __shfl_xor(ss, 32);
            const float rs = rsqrtf(ss * (1.f / 128.f) + NORM_EPS) * (0.08838834764831845f * LOG2E);
#pragma unroll
            for (int ks = 0; ks < 8; ++ks) qf[ks] = scale8(raw[ks], rs, gqn + 64 * hh + 8 * ks); }
        f32x16 o[4];
#pragma unroll
        for (int a = 0; a < 4; ++a)
#pragma unroll
            for (int e = 0; e < 16; ++e) o[a][e] = 0.f;
        float lrun = 0.f;
#pragma unroll 2
        for (int kt = 0; kt < 8; ++kt) {
            const int j0 = 32 * kt;
            f32x16 s;
#pragma unroll
            for (int e = 0; e < 16; ++e) s[e] = -cshift;
#pragma unroll
            for (int ks = 0; ks < 8; ++ks) { const bf16x8 kf = *(const LAS bf16x8*)(KI + (j0 + rr) * MEM_PITCH + (64 * hh + 8 * ks) * 2); s = MFMA32(kf, qf[ks], s); }
#pragma unroll
            for (int e = 0; e < 16; ++e) { const float p = __builtin_amdgcn_exp2f(s[e]); s[e] = p; lrun += p; }
            bf16x8 pf[2];
#pragma unroll
            for (int s2 = 0; s2 < 2; ++s2) pf[s2] = pack8(s[8 * s2], s[8 * s2 + 1], s[8 * s2 + 2], s[8 * s2 + 3], s[8 * s2 + 4], s[8 * s2 + 5], s[8 * s2 + 6], s[8 * s2 + 7]);
#pragma unroll
            for (int vt = 0; vt < 4; ++vt)
#pragma unroll
                for (int s2 = 0; s2 < 2; ++s2) {
                    LAS char* a = VI + (j0 + 16 * s2 + 4 * hh + q4) * MEM_PITCH + (32 * vt + 16 * blk + 4 * p4) * 2;
                    const bf16x8 vf = cat4(tr_read(a), tr_read(a + 8 * MEM_PITCH));
                    o[vt] = MFMA32(vf, pf[s2], o[vt]);
                }
        }
        const float inv = __builtin_amdgcn_rcpf(lrun + __shfl_xor(lrun, 32));
        bf16_t* op = ymem + ((size_t)b * SEQ + i) * 512 + hd * 128;
#pragma unroll
        for (int vt = 0; vt < 4; ++vt)
#pragma unroll
            for (int gq = 0; gq < 4; ++gq) { u32x2 w; w.x = pk2(o[vt][4 * gq] * inv, o[vt][4 * gq + 1] * inv); w.y = pk2(o[vt][4 * gq + 2] * inv, o[vt][4 * gq + 3] * inv);
                *(u32x2*)(op + 32 * vt + 8 * gq + 4 * hh) = w; }
    }
    __syncthreads();
}

#define XB_TMO      128
#define XB_XCNT(j)  (256  + 64 * (j))
#define XB_XSUB(j)  (1280 + 64 * (j))
#define XB_XGEN(j)  (2304 + 64 * (j))
#define XB_TOP      3328
#define XB_TOPGEN   3392
#define XCD_BAR_WORDS 3456
#define XB_SPIN_CAP (1u << 22)
__device__ __forceinline__ unsigned xb_ld(unsigned* p)              { return __hip_atomic_load(p, __ATOMIC_RELAXED, __HIP_MEMORY_SCOPE_AGENT); }
__device__ __forceinline__ unsigned xb_add(unsigned* p, unsigned v) { return __hip_atomic_fetch_add(p, v, __ATOMIC_RELAXED, __HIP_MEMORY_SCOPE_AGENT); }
__device__ __forceinline__ unsigned xb_xcc_id() { return (unsigned)__builtin_amdgcn_s_getreg((3 << 11) | 20) & 0xFu; }
#define XB_SPIN(cond, bar) do { unsigned _sp = 0; while (cond) { __builtin_amdgcn_s_sleep(1); \
    if ((++_sp & 255u) == 0u) { if (xb_ld(&(bar)[XB_TMO])) break; if (_sp > XB_SPIN_CAP) { atomicAdd(&(bar)[XB_TMO], 1u); break; } } } } while (0)
struct XcdBarrier { unsigned* bar; unsigned x; volatile LAS unsigned* st; };
__device__ __forceinline__ XcdBarrier xcd_barrier_post(unsigned* bar, volatile LAS unsigned* st) {
    XcdBarrier b; b.bar = bar; b.x = xb_xcc_id(); b.st = st;
    if (threadIdx.x == 0) (void)xb_add(&bar[XB_XCNT(b.x)], 1u);
    return b;
}
__device__ __forceinline__ void xcd_barrier_complete(unsigned* bar, unsigned x, unsigned& nloc, unsigned& nx) {
    const unsigned G = gridDim.x * gridDim.y * gridDim.z;
    unsigned sum, cnt, mine, sp = 0u;
    for (;;) {
        sum = 0u; cnt = 0u; mine = 0u;
#pragma unroll
        for (unsigned j = 0; j < 16; ++j) { const unsigned c = xb_ld(&bar[XB_XCNT(j)]); sum += c; cnt += (c > 0u) ? 1u : 0u; mine = (j == x) ? c : mine; }
        if (sum == G) break;
        __builtin_amdgcn_s_sleep(1);
        if ((++sp & 255u) == 0u) { if (xb_ld(&bar[XB_TMO])) break; if (sp > XB_SPIN_CAP) { atomicAdd(&bar[XB_TMO], 1u); break; } }
    }
    nloc = mine > 0u ? mine : 1u; nx = cnt > 0u ? cnt : 1u;
}
__device__ __forceinline__ void xcd_barrier(const XcdBarrier& b) {
    asm volatile("s_waitcnt vmcnt(0)" ::: "memory");
    __syncthreads();
    if (threadIdx.x == 0) {
        unsigned* bar = b.bar;
        __builtin_amdgcn_s_waitcnt(0);
        unsigned nloc = b.st[0], nx = b.st[1];
        if (nloc == 0u) { xcd_barrier_complete(bar, b.x, nloc, nx); b.st[0] = nloc; b.st[1] = nx; }
        const unsigned old = xb_add(&bar[XB_XSUB(b.x)], 1u);
        const unsigned gen = old / nloc;
        if (old + 1u == (gen + 1u) * nloc) {
            __builtin_amdgcn_fence(__ATOMIC_RELEASE, "agent");
            asm volatile("s_waitcnt vmcnt(0)" ::: "memory");
            const unsigned og = xb_add(&bar[XB_TOP], 1u);
            const unsigned tg = og / nx;
            if (og + 1u == (tg + 1u) * nx) xb_add(&bar[XB_TOPGEN], 1u);
            else XB_SPIN(xb_ld(&bar[XB_TOPGEN]) == tg, bar);
            __builtin_amdgcn_fence(__ATOMIC_ACQUIRE, "agent");
            xb_add(&bar[XB_XGEN(b.x)], 1u);
            asm volatile("s_waitcnt vmcnt(0)" ::: "memory");
        } else {
            XB_SPIN(xb_ld(&bar[XB_XGEN(b.x)]) == gen, bar);
            __builtin_amdgcn_fence(__ATOMIC_ACQUIRE, "agent");
            asm volatile("s_waitcnt vmcnt(0)" ::: "memory");
        }
    }
    __syncthreads();
}

struct Args { const float* in[21]; float* out; unsigned char* ws; int ph_lo, ph_hi; };

__global__ void __launch_bounds__(512, 2) mk_fwd(Args args) {
    extern __shared__ __attribute__((aligned(16))) unsigned char lds_raw[];
    LAS unsigned char* lds = (LAS unsigned char*)lds_raw;
    cg::grid_group grid = cg::this_grid();
    const int tid = threadIdx.x, lane = tid & 63, wave = __builtin_amdgcn_readfirstlane(tid >> 6);
    const int G = gridDim.x, bx = blockIdx.x;
    const int gw = bx * 8 + wave, NGW = G * 8;
    const int NGT = G * 512;
    unsigned char* ws = args.ws;
    const int lo = args.ph_lo, hi = args.ph_hi;
    volatile LAS unsigned* xst = (volatile LAS unsigned*)(lds + LDS_BYTES - 64);
    if (tid < 2) xst[tid] = 0u;
    __syncthreads();
    XcdBarrier xbar; xbar.bar = (unsigned*)(ws + WS_CTL); xbar.x = 0; xbar.st = xst;
    if (!MK_MULTI_LAUNCH) xbar = xcd_barrier_post((unsigned*)(ws + WS_CTL), xst);
#ifndef PH_EN
#define PH_EN 0x3ff
#endif
#ifndef PROBE_REP
#define PROBE_REP 0
#endif
#define REP(b) for (int rep_ = 0; rep_ < 1 + (((PROBE_REP) >> (b)) & 1); ++rep_)
#define IN(k) (lo <= (k) && (k) < hi)
#define EN(b) (((PH_EN) >> (b)) & 1)
#define SEAM(k) do { if (IN(k) && IN((k) + 1)) { if ((k) == 0 || MK_MULTI_LAUNCH) grid.sync(); else xcd_barrier(xbar); } } while (0)

#define WinT ((bf16_t*)(ws_ + WS_WIN))
#define WkvT ((bf16_t*)(ws_ + WS_WKV))
#define WbrT ((bf16_t*)(ws_ + WS_WBR))
#define WoutT ((bf16_t*)(ws_ + WS_WOUT))
#define WfiT ((bf16_t*)(ws_ + WS_WFI))
#define WfoT ((bf16_t*)(ws_ + WS_WFO))
#define MEMKV ((bf16_t*)(ws_ + WS_MEMKV))
#define XB ((bf16_t*)(ws_ + WS_XB))
#define MEMB ((bf16_t*)(ws_ + WS_MEMB))
#define ODIL ((bf16_t*)(ws_ + WS_ODIL))
#define LSE ((float*)(ws_ + WS_LSE))
#define MERGED ((bf16_t*)(ws_ + WS_MERGED))
#define A2 ((bf16_t*)(ws_ + WS_A2))
#define Y3 ((bf16_t*)(ws_ + WS_Y3))
#define SSQ ((float*)(ws_ + WS_SSQ))
#define PROJ ((bf16_t*)(ws_ + WS_PROJ))
#define YF ((bf16_t*)(ws_ + WS_YF))
#define HALO ((bf16_t*)(ws_ + WS_HALO))
#define CCONST ((float*)(ws_ + WS_CTL + 15360))
#define PHASE_LOCALS const Args* ap = &args; size_t zoff_ = 0; asm volatile("" : "+s"(zoff_)); unsigned char* ws_ = ws + zoff_;     int bxl = bx; asm volatile("" : "+s"(bxl)); int tidl = threadIdx.x; asm volatile("" : "+v"(tidl)); const int gtidl = bxl * 512 + tidl; (void)bxl; (void)ws_; (void)ap; (void)gtidl;
    if (EN(0) && IN(0)) REP(0) {
            PHASE_LOCALS
        LAS float* scr = (LAS float*)(lds + wave * 16384);
        constexpr int I_IN = 16 * 304, I_KV = 16 * 32, I_BR = 8 * 32, I_OUT = 16 * 32, I_FI = 16 * 176, I_FO = 44 * 32;
        constexpr int NITEMS = I_IN + I_KV + 3 * I_BR + I_OUT + I_FI + I_FO;
        for (int it = gw; it < NITEMS; it += NGW) {
            int r = it;
            if (r < I_IN) { p0_transpose_item<0>(ap->in[3], 1024, IN_COLS, WinT, 0, scr, r, lane); continue; } r -= I_IN;
            if (r < I_KV) { p0_transpose_item<0>(ap->in[9], 1024, 1024, WkvT, 0, scr, r, lane); continue; } r -= I_KV;
            if (r < I_BR) { p0_transpose_item<0>(ap->in[12], 512, 1024, WbrT, 0, scr, r, lane); continue; } r -= I_BR;
            if (r < I_BR) { p0_transpose_item<0>(ap->in[13], 512, 1024, WbrT, 1024, scr, r, lane); continue; } r -= I_BR;
            if (r < I_BR) { p0_transpose_item<0>(ap->in[14], 512, 1024, WbrT, 2048, scr, r, lane); continue; } r -= I_BR;
            if (r < I_OUT) { p0_transpose_item<0>(ap->in[15], 1024, 1024, WoutT, 0, scr, r, lane); continue; } r -= I_OUT;
            if (r < I_FI) { p0_transpose_item<1>(ap->in[17], 1024, FF2, WfiT, 0, scr, r, lane); continue; } r -= I_FI;
            p0_transpose_item<0>(ap->in[20], D_FF, 1024, WfoT, 0, scr, r, lane);
        }
        for (int i = bx * 512 + tid; i < BATCH * SEQ; i += NGT) SSQ[i] = 0.f;
        if (gw == 0) {
            float cv = 0.f;
            for (int g = 0; g < 3; ++g) { float a = fabsf(args.in[4][g * 64 + lane]), b = fabsf(args.in[5][g * 64 + lane]);
#pragma unroll
                for (int o = 1; o < 64; o <<= 1) { a = fmaxf(a, __shfl_xor(a, o)); b = fmaxf(b, __shfl_xor(b, o)); }
                if (lane == g) cv = 8.f * a * b * LOG2E; }
            { float a = fmaxf(fabsf(args.in[10][lane]), fabsf(args.in[10][64 + lane])), b = fmaxf(fabsf(args.in[11][lane]), fabsf(args.in[11][64 + lane]));
#pragma unroll
                for (int o = 1; o < 64; o <<= 1) { a = fmaxf(a, __shfl_xor(a, o)); b = fmaxf(b, __shfl_xor(b, o)); }
                if (lane == 3) cv = 11.313708499f * a * b * LOG2E; }
            if (lane < 4) CCONST[lane] = cv;
        }
        for (int m = gw; m < BATCH * SEQ; m += 2 * NGW) rms_row2_to_bf16(ap->in[0] + (size_t)m * 1024, ap->in[0] + (size_t)(m + NGW) * 1024, ap->in[2], XB + (size_t)m * 1024, XB + (size_t)(m + NGW) * 1024, lane);
        for (int m = gw; m < BATCH * N_MEM; m += NGW) rms_row_to_bf16(ap->in[1] + (size_t)m * 1024, ap->in[8], MEMB + (size_t)m * 1024, lane);
        __syncthreads();
    }
    SEAM(0);
    if (EN(1) && IN(1)) REP(1) {
            PHASE_LOCALS
        pg8::Gemm g{MEMB, WkvT, BATCH * N_MEM, 1024, 1024}; pg8::StaticOrder S; S.init(g.M, g.N, G, bxl);
        EpiPlainBf16 E{MEMKV, 1024};
        pg8::gemm_phase(lds, g, S, E);
    }
    SEAM(1);
    for (int hf = 0; hf < 2; ++hf) {
        const int P = 2 + 4 * hf;
        if (EN(2) && IN(P + 0)) REP(2) {
            PHASE_LOCALS
            pg8::Gemm g{XB + (size_t)hf * HTOK * 1024, WinT, HTOK, IN_COLS, 1024}; pg8::StaticOrder S; S.init(g.M, g.N, G, bxl);
            { LAS float* lg = (LAS float*)(lds + 131072);
              if (tidl < 384) lg[tidl] = tidl < 192 ? ap->in[4][tidl] : ap->in[5][tidl - 192];
              __syncthreads(); }
            EpiProj E{PROJ, (const LAS float*)(lds + 131072)};
            pg8::gemm_phase(lds, g, S, E);
        }
        SEAM(P + 0);
        if (EN(3) && IN(P + 1)) REP(3) {
            PHASE_LOCALS
            LAS char* vl = (LAS char*)(lds + wave * 8192);
#ifndef ATT_EN
#define ATT_EN 7
#endif
            if (ATT_EN & 1) for (int it = bxl; it < HB * 4 * 16; it += G) ret_u_item(PROJ, XB + (size_t)hf * HTOK * 1024, ap->in[6], it, (LAS char*)lds, tid);
            if (ATT_EN & 2) REP(10) for (int it = gw; it < HB * 8 * 3 * 32; it += NGW) dil_wave(PROJ, ODIL, LSE, CCONST, it, vl, lane);
            __syncthreads();
            if (ATT_EN & 4) REP(11) for (int it = bxl; it < HB * 4 * 4; it += G) mem_item(PROJ, MEMKV + (size_t)hf * HB * N_MEM * 1024, Y3 + (size_t)2 * HTOK * 512, args.in[10], args.in[11], CCONST, it, (LAS char*)lds, tid);
            __syncthreads();
        }
        SEAM(P + 1);
        if (EN(4) && IN(P + 2)) REP(4) {
            PHASE_LOCALS
            for (int it = bxl; it < HB * 4 * 8; it += G) ret_chunk_item(PROJ, XB + (size_t)hf * HTOK * 1024, Y3 + (size_t)1 * HTOK * 512, ap->in[6], ap->in[7], it, (LAS char*)lds, tid);
            for (int idx = gtidl; idx < HTOK * 64; idx += NGT) {
                const int dp = idx & 7, h = (idx >> 3) & 7, tok = idx >> 6;
                const float l0 = LSE[((size_t)0 * HTOK + tok) * 8 + h], l1 = LSE[((size_t)1 * HTOK + tok) * 8 + h], l2 = LSE[((size_t)2 * HTOK + tok) * 8 + h];
                const float mx = fmaxf(l0, fmaxf(l1, l2));
                float w0 = exp2f(l0 - mx), w1 = exp2f(l1 - mx), w2 = exp2f(l2 - mx); const float inv = 1.f / (w0 + w1 + w2); w0 *= inv; w1 *= inv; w2 *= inv;
                const size_t off = (size_t)tok * 512 + h * 64 + dp * 8;
                const u32x4 a = *(const u32x4*)(ODIL + off), b = *(const u32x4*)(ODIL + (size_t)HTOK * 512 + off), c = *(const u32x4*)(ODIL + (size_t)2 * HTOK * 512 + off);
                u32x4 o;
                o.x = pk2(w0 * bflo(a.x) + w1 * bflo(b.x) + w2 * bflo(c.x), w0 * bfhi(a.x) + w1 * bfhi(b.x) + w2 * bfhi(c.x));
                o.y = pk2(w0 * bflo(a.y) + w1 * bflo(b.y) + w2 * bflo(c.y), w0 * bfhi(a.y) + w1 * bfhi(b.y) + w2 * bfhi(c.y));
                o.z = pk2(w0 * bflo(a.z) + w1 * bflo(b.z) + w2 * bflo(c.z), w0 * bfhi(a.z) + w1 * bfhi(b.z) + w2 * bfhi(c.z));
                o.w = pk2(w0 * bflo(a.w) + w1 * bflo(b.w) + w2 * bflo(c.w), w0 * bfhi(a.w) + w1 * bfhi(b.w) + w2 * bfhi(c.w));
                *(u32x4*)(Y3 + off) = o;
            }
        }
        SEAM(P + 2);
        if (EN(5) && IN(P + 3)) REP(5) {
            PHASE_LOCALS
            pg8::Gemm g{Y3, WbrT, 3 * HTOK, 3 * 1024, 512}; pg8::BranchOrder S; S.init(HTOK, 1024, G, bxl);
            EpiBranch E{MERGED + (size_t)hf * HTOK * 1024, PROJ};
            pg8::gemm_phase(lds, g, S, E);
        }
        SEAM(P + 3);
    }
    {
        constexpr int P = 6, NTOK = BATCH * SEQ;
        if (EN(6) && IN(P + 4)) REP(6) {
            PHASE_LOCALS
            pg8::Gemm g{MERGED, WoutT, NTOK, 1024, 1024}; pg8::StaticOrder S; S.init(g.M, g.N, G, bxl);
            EpiOut E{ap->in[0], ap->out, A2, ap->in[16], SSQ};
            pg8::gemm_phase(lds, g, S, E);
        }
        SEAM(P + 4);
        if (EN(7) && IN(P + 5)) REP(7) {
            PHASE_LOCALS
            pg8::Gemm g{A2, WfiT, NTOK, FF2, 1024}; pg8::StaticOrder S; S.init(g.M, g.N, G, bxl);
            EpiFfnInConv E{YF, HALO, SSQ, ap->in[18], ap->in[19]};
            pg8::gemm_phase(lds, g, S, E);
        }
        SEAM(P + 5);
        if (EN(8) && IN(P + 6)) REP(8) {
            PHASE_LOCALS
            const float* cw = ap->in[18]; const float* cb = ap->in[19];
            for (int idx = gtidl; idx < (NTOK / 64) * 2 * 352; idx += NGT) {
                const int cgp = idx % 352, rest = idx / 352, side = rest & 1, blk = rest >> 1, ch = cgp * 8;
                const int row = blk * 64 + (side ? 63 : 0), t = row & (SEQ - 1);
                const bf16_t* hb = HALO + (size_t)blk * 6 * D_FF + ch;
                u32x4 um = {0u, 0u, 0u, 0u}, un = {0u, 0u, 0u, 0u}, uc, gt;
                if (side == 0) { uc = *(const u32x4*)hb; un = *(const u32x4*)(hb + D_FF); gt = *(const u32x4*)(hb + 4 * D_FF); if (t > 0) um = *(const u32x4*)(hb - 6 * D_FF + 3 * D_FF); }
                else { um = *(const u32x4*)(hb + 2 * D_FF); uc = *(const u32x4*)(hb + 3 * D_FF); gt = *(const u32x4*)(hb + 5 * D_FF); if (t < SEQ - 1) un = *(const u32x4*)(hb + 6 * D_FF); }
                float uu[3][8], gg[8];
                const unsigned umw[4] = {um.x, um.y, um.z, um.w}, ucw[4] = {uc.x, uc.y, uc.z, uc.w}, unw[4] = {un.x, un.y, un.z, un.w}, gtw[4] = {gt.x, gt.y, gt.z, gt.w};
#pragma unroll
                for (int q = 0; q < 4; ++q) { uu[0][2 * q] = bflo(umw[q]); uu[0][2 * q + 1] = bfhi(umw[q]); uu[1][2 * q] = bflo(ucw[q]); uu[1][2 * q + 1] = bfhi(ucw[q]);
                    uu[2][2 * q] = bflo(unw[q]); uu[2][2 * q + 1] = bfhi(unw[q]); gg[2 * q] = bflo(gtw[q]); gg[2 * q + 1] = bfhi(gtw[q]); }
                float yv[8];
#pragma unroll
                for (int q2 = 0; q2 < 2; ++q2) {
                    const f32x4 w0 = *(const f32x4*)(cw + ch + 4 * q2), w1 = *(const f32x4*)(cw + D_FF + ch + 4 * q2), w2 = *(const f32x4*)(cw + 2 * D_FF + ch + 4 * q2), bb = *(const f32x4*)(cb + ch + 4 * q2);
#pragma unroll
                    for (int e = 0; e < 4; ++e) { const int k = 4 * q2 + e; const float c = bb[e] + uu[0][k] * w0[e] + uu[1][k] * w1[e] + uu[2][k] * w2[e];
                        yv[k] = gelu_exact(c) * gg[k]; }
                }
                u32x4 o; o.x = pk2(yv[0], yv[1]); o.y = pk2(yv[2], yv[3]); o.z = pk2(yv[4], yv[5]); o.w = pk2(yv[6], yv[7]);
                *(u32x4*)(YF + (size_t)row * D_FF + ch) = o;
            }
        }
        SEAM(P + 6);
        if (EN(9) && IN(P + 7)) REP(9) {
            PHASE_LOCALS
            pg8::Gemm g{YF, WfoT, NTOK, 1024, D_FF}; pg8::StaticOrder S; S.init(g.M, g.N, G, bxl);
            EpiFfnOut E{ap->out};
            pg8::gemm_phase(lds, g, S, E);
        }
    }
#undef IN
#undef SEAM
}

extern "C" void kernel_launch(void* const* d_in, const int* in_sizes, int n_in, void* d_out, int out_size, void* d_ws, size_t ws_size, hipStream_t stream) {
    static int grid = 0;
    if (grid == 0) {
        if (n_in != 21 || out_size != BATCH * SEQ * D_MODEL || ws_size < WS_END) { fprintf(stderr, "kernel_launch: unexpected shapes (n_in %d out %d ws %zu)\n", n_in, out_size, ws_size); grid = -1; return; }
        int dev = 0, cus = 0, per_cu = 0;
        hipGetDevice(&dev); hipDeviceGetAttribute(&cus, hipDeviceAttributeMultiprocessorCount, dev);
        if (hipFuncSetAttribute((const void*)mk_fwd, hipFuncAttributeMaxDynamicSharedMemorySize, LDS_BYTES) != hipSuccess) { fprintf(stderr, "kernel_launch: hipFuncSetAttribute failed\n"); grid = -1; return; }
        if (hipOccupancyMaxActiveBlocksPerMultiprocessor(&per_cu, (const void*)mk_fwd, 512, LDS_BYTES) != hipSuccess || per_cu < 1) { fprintf(stderr, "kernel_launch: occupancy query says %d\n", per_cu); per_cu = 1; }
        (void)hipGetLastError();
        grid = cus * per_cu;
    }
    if (grid < 0) return;
    Args a{};
    for (int i = 0; i < 21; ++i) a.in[i] = (const float*)d_in[i];
    a.out = (float*)d_out; a.ws = (unsigned char*)d_ws;
#if MK_MULTI_LAUNCH
    for (int ph = 0; ph < NPHASE; ++ph) {
        a.ph_lo = ph; a.ph_hi = ph + 1;
        hipLaunchKernelGGL(mk_fwd, dim3(grid), dim3(512), LDS_BYTES, stream, a);
    }
#else
    a.ph_lo = 0; a.ph_hi = NPHASE;
    if (hipMemsetAsync((char*)d_ws + WS_CTL, 0, CTL_BYTES, stream) != hipSuccess) { fprintf(stderr, "kernel_launch: memset of the barrier words failed\n"); return; }
    void* kargs[] = {&a};
    hipError_t e = hipLaunchCooperativeKernel((const void*)mk_fwd, dim3(grid), dim3(512), kargs, LDS_BYTES, stream);
    if (e != hipSuccess) fprintf(stderr, "kernel_launch: cooperative launch failed: %s (grid %d)\n", hipGetErrorString(e), grid);
#endif
}
```

```cpp
#include <hip/hip_runtime.h>
#include <hip/hip_cooperative_groups.h>
#include <cstdio>
namespace cg = cooperative_groups;

#ifndef MK_MULTI_LAUNCH
#define MK_MULTI_LAUNCH 0
#endif

#define LAS __attribute__((address_space(3)))
typedef unsigned short bf16_t;
typedef short bf16x8 __attribute__((ext_vector_type(8)));
typedef short s16x4 __attribute__((ext_vector_type(4)));
typedef float f32x2 __attribute__((ext_vector_type(2)));
typedef float f32x4 __attribute__((ext_vector_type(4)));
typedef float f32x16 __attribute__((ext_vector_type(16)));
typedef unsigned u32x2 __attribute__((ext_vector_type(2)));
typedef unsigned u32x4 __attribute__((ext_vector_type(4)));
typedef __bf16 bf16x2_t __attribute__((ext_vector_type(2)));

constexpr int D_MODEL = 1024, BATCH = 32, SEQ = 2048, N_MEM = 256;
constexpr int HB = 16, HTOK = HB * SEQ;
constexpr int IN_COLS = 9728, RET_OFF = 4608, MEMQ_OFF = 6144, GATE_OFF = 6656;
constexpr int D_FF = 2816, FF2 = 5632;
constexpr float NORM_EPS = 1e-6f;
constexpr float LOG2E = 1.4426950408889634f;
constexpr int NPHASE = 14;

constexpr size_t MiB = 1u << 20;
constexpr size_t WS_WIN = 0;
constexpr size_t WS_WKV = 19 * MiB;
constexpr size_t WS_WBR = 21 * MiB;
constexpr size_t WS_WOUT = 24 * MiB;
constexpr size_t WS_WFI = 26 * MiB;
constexpr size_t WS_WFO = 37 * MiB;
constexpr size_t WS_MEMKV = 43 * MiB;
constexpr size_t WS_XB = 60 * MiB;
constexpr size_t WS_R1 = 188 * MiB;
constexpr size_t WS_MEMB = WS_R1;
constexpr size_t WS_ODIL = WS_R1;
constexpr size_t WS_LSE = WS_R1 + 96 * MiB;
constexpr size_t WS_MERGED = WS_XB;
constexpr size_t WS_A2 = 412 * MiB;
constexpr size_t WS_Y3 = 316 * MiB;
constexpr size_t WS_SSQ = WS_R1 + 100 * MiB;
constexpr size_t WS_HALO = WS_Y3 + 4 * MiB;
constexpr size_t WS_PROJ = 412 * MiB;
constexpr size_t WS_UG = WS_PROJ;
constexpr size_t WS_YF = WS_PROJ + 128 * MiB;
constexpr size_t WS_CTL = 1020 * MiB;
constexpr size_t CTL_BYTES = 16384;
constexpr size_t WS_END = WS_CTL + CTL_BYTES;

constexpr int LDS_BYTES = 147456;

__device__ __forceinline__ unsigned pk2(float a, float b) { f32x2 f = {a, b}; bf16x2_t r = __builtin_convertvector(f, bf16x2_t); return __builtin_bit_cast(unsigned, r); }
__device__ __forceinline__ float bflo(unsigned w) { return __uint_as_float(w << 16); }
__device__ __forceinline__ float bfhi(unsigned w) { return __uint_as_float(w & 0xffff0000u); }
__device__ __forceinline__ float wave_sum(float v) {
#pragma unroll
    for (int o = 1; o < 64; o <<= 1) v += __shfl_xor(v, o);
    return v;
}
__device__ __forceinline__ bf16x8 pack8(float a0, float a1, float a2, float a3, float a4, float a5, float a6, float a7) {
    u32x4 p; p.x = pk2(a0, a1); p.y = pk2(a2, a3); p.z = pk2(a4, a5); p.w = pk2(a6, a7); return __builtin_bit_cast(bf16x8, p);
}
#define MFMA32(a, b, c) __builtin_amdgcn_mfma_f32_32x32x16_bf16((a), (b), (c), 0, 0, 0)
__device__ __forceinline__ s16x4 tr_read(LAS char* p) { return __builtin_amdgcn_ds_read_tr16_b64_v4i16((LAS s16x4*)p); }
__device__ __forceinline__ bf16x8 cat4(s16x4 lo, s16x4 hi) { return __builtin_shufflevector(lo, hi, 0, 1, 2, 3, 4, 5, 6, 7); }
__device__ __forceinline__ int slot_of(int c) { return 128 * ((c >> 5) & 1) + 32 * (c >> 6) + 16 * ((c >> 2) & 1) + 4 * ((c >> 3) & 3) + (c & 3); }

namespace pg8 {
constexpr int BM = 256, BK = 64, HALF = 128, HTB = HALF * BK * 2, NXCD = 8, WGM = 8;
__device__ __forceinline__ int lds_byte(int r, int c) { const int st = (r >> 4) * 2 + (c >> 5), rr = r & 15, cc = c & 31, ob = rr * 64 + cc * 2; return st * 1024 + (ob ^ (((ob >> 9) & 1) << 5)); }
__device__ __forceinline__ void stage_rc(int b, int& R, int& C) { const int st = b / 1024, sb = b % 1024, swz = sb ^ (((sb >> 9) & 1) << 5); R = (st >> 1) * 16 + swz / 64; C = (st & 1) * 32 + (swz % 64) / 2; }
struct Unit { int pm, pn; };
struct Gemm { const bf16_t* A; const bf16_t* Bt; int M, N, K; };
struct StaticOrder {
    int nM, nN, nwg, G, c;
    __device__ void init(int M, int N, int G_, int c_) { nM = M / BM; nN = N / BM; nwg = nM * nN; G = G_; c = c_; }
    __device__ bool next(int i, Unit& u) const {
        const long L = (long)i * G + c; if (L >= nwg) return false;
        int wgid = (int)L; { const int q = nwg / NXCD, r = nwg % NXCD, xcd = wgid % NXCD, off = wgid / NXCD; wgid = (xcd < r ? xcd * (q + 1) : r * (q + 1) + (xcd - r) * q) + off; }
        const int nig = WGM * nN, gid = wgid / nig, fm = gid * WGM, gsz = (nM - fm) < WGM ? (nM - fm) : WGM;
        u.pm = fm + ((wgid % nig) % gsz); u.pn = (wgid % nig) / gsz;
        if ((nwg / NXCD) % nig == 0 && nwg % NXCD == 0) u.pn = (u.pn + (int)(L % NXCD) * ((nN + NXCD - 1) / NXCD)) % nN;
        return true;
    }
};
struct BranchOrder {
    StaticOrder so;
    __device__ void init(int M, int N, int G_, int c_) { so.init(M, N, G_, c_); }
    __device__ bool next(int i, Unit& u) const { Unit t; if (!so.next(i / 3, t)) return false; const int b = i % 3; u.pm = b * (HTOK / BM) + t.pm; u.pn = b * (D_MODEL / BM) + t.pn; return true; }
};

template <class Epi, class Sched>
__device__ __forceinline__ void gemm_phase(LAS unsigned char* lds, const Gemm g, const Sched& S, const Epi& E) {
    int tid = threadIdx.x; asm volatile("" : "+v"(tid));
    const int wid = __builtin_amdgcn_readfirstlane(tid >> 6), lane = tid & 63, wr = wid >> 2, wc = wid & 3, fr = lane & 15, fq = lane >> 4;
    const int K = g.K, nt = K / BK;
    unsigned voffA[2];
#pragma unroll
    for (int i = 0; i < 2; ++i) { int R, C; stage_rc(tid * 16 + i * 8192, R, C); voffA[i] = (unsigned)(R * K + C) * 2u; }
    const size_t kstep = (size_t)(BK * 2);
    const size_t hstep = (size_t)HALF * K * 2;
    const size_t tstep = 2 * hstep;
    const unsigned ldsw = (unsigned)wid * 1024u;
    const int aoff = lds_byte(wr * 64 + fr, fq * 8), boff = lds_byte(wc * 32 + fr, fq * 8);
#define PG8_SA(b, h) (((b) * 2 + (h)) * HTB)
#define PG8_SB(b, h) ((4 + (b) * 2 + (h)) * HTB)
#define PG8_STAGE(bufoff, gbase) do { _Pragma("unroll") for (int _i = 0; _i < 2; ++_i) \
        __builtin_amdgcn_global_load_lds((const unsigned*)((const char*)(gbase) + voffA[_i]), (LAS unsigned*)(lds + (bufoff) + ldsw + _i * 8192), 16, 0, 0); } while (0)
#define PG8_LDA(dst, b, h) do { _Pragma("unroll") for (int m = 0; m < 4; ++m) _Pragma("unroll") for (int k = 0; k < 2; ++k) dst[m][k] = *(const LAS bf16x8*)(lds + PG8_SA(b, h) + aoff + m * 2048 + k * 1024); } while (0)
#define PG8_LDB(dst, b, h) do { _Pragma("unroll") for (int n = 0; n < 2; ++n) _Pragma("unroll") for (int k = 0; k < 2; ++k) dst[n][k] = *(const LAS bf16x8*)(lds + PG8_SB(b, h) + boff + n * 2048 + k * 1024); } while (0)
#define PG8_MMA(ai, bj, At, Bt) do { __builtin_amdgcn_s_setprio(1); _Pragma("unroll") for (int m = 0; m < 4; ++m) _Pragma("unroll") for (int n = 0; n < 2; ++n) _Pragma("unroll") for (int k = 0; k < 2; ++k) \
        acc[ai][bj][m][n] = __builtin_amdgcn_mfma_f32_16x16x32_bf16(Bt[n][k], At[m][k], acc[ai][bj][m][n], 0, 0, 0); __builtin_amdgcn_s_setprio(0); } while (0)
#define PG8_WAIT_V(n) asm volatile("s_waitcnt vmcnt(" #n ")" ::: "memory")
#define PG8_WAIT_L(n) asm volatile("s_waitcnt lgkmcnt(" #n ")" ::: "memory")
#define PG8_BAR __builtin_amdgcn_s_barrier()
#define PG8_SCHED __builtin_amdgcn_sched_barrier(0)
    Unit cur, nxt; int ui = 0;
    if (!S.next(0, cur)) return;
    f32x4 acc[2][2][4][2];
#pragma unroll
    for (int a = 0; a < 2; ++a)
#pragma unroll
        for (int b = 0; b < 2; ++b)
#pragma unroll
            for (int m = 0; m < 4; ++m)
#pragma unroll
                for (int n = 0; n < 2; ++n) acc[a][b][m][n] = (f32x4){0.f, 0.f, 0.f, 0.f};
    bf16x8 At[4][2], B0[2][2], B1[2][2];
    const char* cA = (const char*)g.A + (size_t)cur.pm * tstep; const char* cB = (const char*)g.Bt + (size_t)cur.pn * tstep;
    PG8_STAGE(PG8_SB(0, 0), cB); PG8_STAGE(PG8_SA(0, 0), cA); PG8_STAGE(PG8_SB(0, 1), cB + hstep); PG8_STAGE(PG8_SA(0, 1), cA + hstep);
    if (wr == 1) PG8_BAR;
    PG8_WAIT_V(4); PG8_BAR;
    PG8_STAGE(PG8_SB(1, 0), cB + kstep); PG8_STAGE(PG8_SA(1, 0), cA + kstep); PG8_STAGE(PG8_SB(1, 1), cB + hstep + kstep);
    PG8_WAIT_V(6); PG8_BAR;
    for (;;) {
        const bool has_next = S.next(ui + 1, nxt);
        const char* nA = has_next ? (const char*)g.A + (size_t)nxt.pm * tstep : cA; const char* nB = has_next ? (const char*)g.Bt + (size_t)nxt.pn * tstep : cB;
        for (int t = 0; t < nt; t += 2) {
            const bool last = (t == nt - 2);
            const char* a1 = cA + (size_t)(t + 1) * kstep;
            const char* a2 = last ? nA : cA + (size_t)(t + 2) * kstep; const char* b2 = last ? nB : cB + (size_t)(t + 2) * kstep;
            const char* a3 = a2 + kstep; const char* b3 = b2 + kstep;
            PG8_LDB(B0, 0, 0); PG8_SCHED; PG8_LDA(At, 0, 0); PG8_STAGE(PG8_SA(1, 1), a1 + hstep);
            PG8_WAIT_L(8); PG8_BAR; PG8_WAIT_L(0); PG8_MMA(0, 0, At, B0); PG8_BAR; PG8_SCHED;
            PG8_LDB(B1, 0, 1); PG8_STAGE(PG8_SB(0, 0), b2);
            PG8_BAR; PG8_WAIT_L(0); PG8_MMA(0, 1, At, B1); PG8_BAR;
            PG8_LDA(At, 0, 1); PG8_STAGE(PG8_SA(0, 0), a2);
            PG8_BAR; PG8_WAIT_L(0); PG8_MMA(1, 0, At, B0); PG8_BAR; PG8_SCHED;
            PG8_STAGE(PG8_SB(0, 1), b2 + hstep);
            PG8_WAIT_V(6); PG8_BAR; PG8_MMA(1, 1, At, B1); PG8_BAR;
            PG8_LDB(B0, 1, 0); PG8_SCHED; PG8_LDA(At, 1, 0); PG8_STAGE(PG8_SA(0, 1), a2 + hstep);
            PG8_WAIT_L(8); PG8_BAR; PG8_WAIT_L(0); PG8_MMA(0, 0, At, B0); PG8_BAR; PG8_SCHED;
            PG8_LDB(B1, 1, 1); PG8_STAGE(PG8_SB(1, 0), b3);
            PG8_BAR; PG8_WAIT_L(0); PG8_MMA(0, 1, At, B1); PG8_BAR;
            PG8_LDA(At, 1, 1); PG8_STAGE(PG8_SA(1, 0), a3);
            PG8_BAR; PG8_WAIT_L(0); PG8_MMA(1, 0, At, B0); PG8_BAR; PG8_SCHED;
            PG8_STAGE(PG8_SB(1, 1), b3 + hstep);
            PG8_WAIT_V(6); PG8_BAR; PG8_MMA(1, 1, At, B1); PG8_BAR;
        }
        E(acc, cur, wr, wc, fr, fq);
        if (!has_next) break;
#pragma unroll
        for (int a = 0; a < 2; ++a)
#pragma unroll
            for (int b = 0; b < 2; ++b)
#pragma unroll
                for (int m = 0; m < 4; ++m)
#pragma unroll
                    for (int n = 0; n < 2; ++n) acc[a][b][m][n] = (f32x4){0.f, 0.f, 0.f, 0.f};
        cur = nxt; cA = nA; cB = nB; ++ui;
    }
    PG8_WAIT_V(0);
    if (wr == 0) PG8_BAR;
    PG8_BAR;
#undef PG8_SA
#undef PG8_SB
#undef PG8_STAGE
#undef PG8_LDA
#undef PG8_LDB
#undef PG8_MMA
#undef PG8_WAIT_V
#undef PG8_WAIT_L
#undef PG8_BAR
#undef PG8_SCHED
}
}
using pg8::Unit;

#define EPI_ROWS_BEGIN _Pragma("unroll") for (int ai = 0; ai < 2; ++ai) _Pragma("unroll") for (int m = 0; m < 4; ++m) { const int rloc = ai * 128 + wr * 64 + m * 16 + fr; float v[16]; \
    _Pragma("unroll") for (int bj = 0; bj < 2; ++bj) _Pragma("unroll") for (int n = 0; n < 2; ++n) _Pragma("unroll") for (int j = 0; j < 4; ++j) v[8 * bj + 4 * n + j] = acc[ai][bj][m][n][j];
#define EPI_ROWS_END }
__device__ __forceinline__ void store16_bf16(bf16_t* p, const float (&v)[16]) {
    u32x4 a, b; a.x = pk2(v[0], v[1]); a.y = pk2(v[2], v[3]); a.z = pk2(v[4], v[5]); a.w = pk2(v[6], v[7]);
    b.x = pk2(v[8], v[9]); b.y = pk2(v[10], v[11]); b.z = pk2(v[12], v[13]); b.w = pk2(v[14], v[15]);
    *(u32x4*)p = a; *(u32x4*)(p + 32) = b;
}
__device__ __forceinline__ void load16_bf16(const bf16_t* p, float (&v)[16]) {
    const u32x4 a = *(const u32x4*)p, b = *(const u32x4*)(p + 32);
    v[0] = bflo(a.x); v[1] = bfhi(a.x); v[2] = bflo(a.y); v[3] = bfhi(a.y); v[4] = bflo(a.z); v[5] = bfhi(a.z); v[6] = bflo(a.w); v[7] = bfhi(a.w);
    v[8] = bflo(b.x); v[9] = bfhi(b.x); v[10] = bflo(b.y); v[11] = bfhi(b.y); v[12] = bflo(b.z); v[13] = bfhi(b.z); v[14] = bflo(b.w); v[15] = bfhi(b.w);
}
__device__ __forceinline__ void load16_f32(const float* p, float (&v)[16]) {
#pragma unroll
    for (int q = 0; q < 4; ++q) { const f32x4 t = *(const f32x4*)(p + 4 * (q & 1) + 32 * (q >> 1)); v[4 * q] = t.x; v[4 * q + 1] = t.y; v[4 * q + 2] = t.z; v[4 * q + 3] = t.w; }
}
__device__ __forceinline__ void store16_f32(float* p, const float (&v)[16]) {
#pragma unroll
    for (int q = 0; q < 4; ++q) *(f32x4*)(p + 4 * (q & 1) + 32 * (q >> 1)) = (f32x4){v[4 * q], v[4 * q + 1], v[4 * q + 2], v[4 * q + 3]};
}
__device__ __forceinline__ void nt_store16(u32x4* p, u32x4 v) { __builtin_nontemporal_store(v, p); }
__device__ __forceinline__ void store16_bf16_nt(bf16_t* p, const float (&v)[16]) {
    u32x4 a, b; a.x = pk2(v[0], v[1]); a.y = pk2(v[2], v[3]); a.z = pk2(v[4], v[5]); a.w = pk2(v[6], v[7]);
    b.x = pk2(v[8], v[9]); b.y = pk2(v[10], v[11]); b.z = pk2(v[12], v[13]); b.w = pk2(v[14], v[15]);
    nt_store16((u32x4*)p, a); nt_store16((u32x4*)(p + 32), b);
}
__device__ __forceinline__ void store16_f32_nt(float* p, const float (&v)[16]) {
#pragma unroll
    for (int q = 0; q < 4; ++q) { f32x4 t = (f32x4){v[4 * q], v[4 * q + 1], v[4 * q + 2], v[4 * q + 3]}; __builtin_nontemporal_store(t, (f32x4*)(p + 4 * (q & 1) + 32 * (q >> 1))); }
}
__device__ __forceinline__ void load16c_bf16(const bf16_t* p, float (&v)[16]) {
    const u32x4 a = *(const u32x4*)p, b = *(const u32x4*)(p + 8);
    v[0] = bflo(a.x); v[1] = bfhi(a.x); v[2] = bflo(a.y); v[3] = bfhi(a.y); v[4] = bflo(a.z); v[5] = bfhi(a.z); v[6] = bflo(a.w); v[7] = bfhi(a.w);
    v[8] = bflo(b.x); v[9] = bfhi(b.x); v[10] = bflo(b.y); v[11] = bfhi(b.y); v[12] = bflo(b.z); v[13] = bfhi(b.z); v[14] = bflo(b.w); v[15] = bfhi(b.w);
}
__device__ __forceinline__ void load16c_f32(const float* p, float (&v)[16]) {
#pragma unroll
    for (int q = 0; q < 4; ++q) { const f32x4 t = *(const f32x4*)(p + 4 * q); v[4 * q] = t.x; v[4 * q + 1] = t.y; v[4 * q + 2] = t.z; v[4 * q + 3] = t.w; }
}

__device__ __forceinline__ size_t pofs(int row, int col) { return ((size_t)((row >> 8) * (IN_COLS / 256) + (col >> 8)) << 16) + (size_t)(((row & 255) << 8) + (col & 255)); }
constexpr float QSCALE_DIL = 0.125f * LOG2E;

struct EpiProj {
    static constexpr int NSTX = 16;
    bf16_t* P; const LAS float* lgain;
    __device__ __forceinline__ void operator()(const f32x4 (&acc)[2][2][4][2], const Unit& u, int wr, int wc, int fr, int fq) const {
        const int pn = u.pn; int mode = 0; int goff = 0; float sc = 1.f;
        if (pn < 18) { const int g = pn / 6, t = (pn % 6) >> 1; if (t == 0) { mode = 1; goff = g * 64; sc = QSCALE_DIL; } else if (t == 1) { mode = 1; goff = 192 + g * 64; } }
        else if (pn == 19) { mode = 2; sc = 0.125f; }
        else if (pn == 22 || pn == 23) mode = 4;
        else if (pn >= 26) mode = 3;
        const int col0 = pn * 256 + wc * 64 + fq * 8;
        if (mode == 1) {
            float gv[16];
            { const LAS f32x4* gp = (const LAS f32x4*)(lgain + goff + fq * 8); const f32x4 g0 = gp[0], g1 = gp[1], g2 = gp[8], g3 = gp[9];
              gv[0] = g0.x; gv[1] = g0.y; gv[2] = g0.z; gv[3] = g0.w; gv[4] = g1.x; gv[5] = g1.y; gv[6] = g1.z; gv[7] = g1.w;
              gv[8] = g2.x; gv[9] = g2.y; gv[10] = g2.z; gv[11] = g2.w; gv[12] = g3.x; gv[13] = g3.y; gv[14] = g3.z; gv[15] = g3.w; }
            float ssv[2][4];
#pragma unroll
            for (int ai = 0; ai < 2; ++ai)
#pragma unroll
                for (int m = 0; m < 4; ++m) { float ss = 0.f;
#pragma unroll
                    for (int bj = 0; bj < 2; ++bj)
#pragma unroll
                        for (int n = 0; n < 2; ++n)
#pragma unroll
                            for (int j = 0; j < 4; ++j) ss += acc[ai][bj][m][n][j] * acc[ai][bj][m][n][j];
                    ssv[ai][m] = ss; }
#pragma unroll
            for (int ai = 0; ai < 2; ++ai)
#pragma unroll
                for (int m = 0; m < 4; ++m) ssv[ai][m] += __shfl_xor(ssv[ai][m], 16);
#pragma unroll
            for (int ai = 0; ai < 2; ++ai)
#pragma unroll
                for (int m = 0; m < 4; ++m) ssv[ai][m] += __shfl_xor(ssv[ai][m], 32);
#pragma unroll
            for (int ai = 0; ai < 2; ++ai)
#pragma unroll
                for (int m = 0; m < 4; ++m) { const int rloc = ai * 128 + wr * 64 + m * 16 + fr; const float rs = rsqrtf(ssv[ai][m] * (1.f / 64.f) + NORM_EPS) * sc; float v[16];
#pragma unroll
                    for (int bj = 0; bj < 2; ++bj)
#pragma unroll
                        for (int n = 0; n < 2; ++n)
#pragma unroll
                            for (int j = 0; j < 4; ++j) { const int e = 8 * bj + 4 * n + j; v[e] = acc[ai][bj][m][n][j] * rs * gv[e]; }
                    store16_bf16_nt(P + pofs(u.pm * 256 + rloc, col0), v); }
            return;
        }
        EPI_ROWS_BEGIN
            if (mode == 2) {
#pragma unroll
                for (int e = 0; e < 16; ++e) v[e] *= sc;
            } else if (mode == 3) {
#pragma unroll
                for (int e = 0; e < 16; ++e) v[e] = __builtin_amdgcn_rcpf(1.f + __builtin_amdgcn_exp2f(-LOG2E * v[e]));
            } else if (mode == 4) {
#pragma unroll
                for (int e = 0; e < 16; ++e) v[e] = v[e] * __builtin_amdgcn_rcpf(1.f + __builtin_amdgcn_exp2f(-LOG2E * v[e]));
            }
            store16_bf16_nt(P + pofs(u.pm * 256 + rloc, col0), v);
        EPI_ROWS_END
    }
};
struct EpiPlainBf16 {
    bf16_t* O; int ldc;
    __device__ __forceinline__ void operator()(const f32x4 (&acc)[2][2][4][2], const Unit& u, int wr, int wc, int fr, int fq) const {
        const int col0 = u.pn * 256 + wc * 64 + fq * 8;
        EPI_ROWS_BEGIN
            store16_bf16(O + (size_t)(u.pm * 256 + rloc) * ldc + col0, v);
        EPI_ROWS_END
    }
};
struct EpiBranch {
    bf16_t* Mg; const bf16_t* P;
    __device__ __forceinline__ void operator()(const f32x4 (&acc)[2][2][4][2], const Unit& u, int wr, int wc, int fr, int fq) const {
        const int b = u.pn >> 2, pn = u.pn & 3, pm = u.pm - b * (HTOK / 256);
        const int col0 = pn * 256 + wc * 64 + fq * 8;
        const float keepw = b == 0 ? 0.f : 1.f;
#pragma unroll
        for (int ai = 0; ai < 2; ++ai)
#pragma unroll
            for (int mp2 = 0; mp2 < 2; ++mp2) {
                u32x4 ga[2][2], oa[2][2];
#pragma unroll
                for (int mm = 0; mm < 2; ++mm) { const int rloc = ai * 128 + wr * 64 + (2 * mp2 + mm) * 16 + fr; const int row = pm * 256 + rloc;
                    const bf16_t* gp = P + pofs(row, GATE_OFF + b * 1024 + col0); const bf16_t* mq = Mg + (size_t)row * D_MODEL + col0;
                    ga[mm][0] = *(const u32x4*)gp; ga[mm][1] = *(const u32x4*)(gp + 32);
                    if (b != 0) { oa[mm][0] = *(const u32x4*)mq; oa[mm][1] = *(const u32x4*)(mq + 32); } else { oa[mm][0] = (u32x4){0u, 0u, 0u, 0u}; oa[mm][1] = (u32x4){0u, 0u, 0u, 0u}; } }
#pragma unroll
                for (int mm = 0; mm < 2; ++mm) { const int m = 2 * mp2 + mm; const int row = pm * 256 + ai * 128 + wr * 64 + m * 16 + fr;
                    bf16_t* mq = Mg + (size_t)row * D_MODEL + col0;
#pragma unroll
                    for (int bj = 0; bj < 2; ++bj) { const u32x4 g = ga[mm][bj], o = oa[mm][bj]; const f32x4 a0 = acc[ai][bj][m][0], a1 = acc[ai][bj][m][1]; u32x4 w;
                        w.x = pk2(keepw * bflo(o.x) + a0[0] * bflo(g.x), keepw * bfhi(o.x) + a0[1] * bfhi(g.x));
                        w.y = pk2(keepw * bflo(o.y) + a0[2] * bflo(g.y), keepw * bfhi(o.y) + a0[3] * bfhi(g.y));
                        w.z = pk2(keepw * bflo(o.z) + a1[0] * bflo(g.z), keepw * bfhi(o.z) + a1[1] * bfhi(g.z));
                        w.w = pk2(keepw * bflo(o.w) + a1[2] * bflo(g.w), keepw * bfhi(o.w) + a1[3] * bfhi(g.w));
                        *(u32x4*)(mq + 32 * bj) = w; } }
            }
    }
};
struct EpiOut {
    const float* X; float* Out; bf16_t* A2; const float* g2; float* ssq;
    __device__ __forceinline__ void operator()(const f32x4 (&acc)[2][2][4][2], const Unit& u, int wr, int wc, int fr, int fq) const {
        const int col0 = u.pn * 256 + wc * 64 + fq * 8;
        float gv[16]; load16_f32(g2 + col0, gv);
#pragma unroll
        for (int ai = 0; ai < 2; ++ai)
#pragma unroll
            for (int mp2 = 0; mp2 < 2; ++mp2) {
                float xv[2][16];
#pragma unroll
                for (int mm = 0; mm < 2; ++mm) load16_f32(X + (size_t)(u.pm * 256 + ai * 128 + wr * 64 + (2 * mp2 + mm) * 16 + fr) * D_MODEL + col0, xv[mm]);
#pragma unroll
                for (int mm = 0; mm < 2; ++mm) { const int m = 2 * mp2 + mm; const size_t row = (size_t)(u.pm * 256 + ai * 128 + wr * 64 + m * 16 + fr);
                    float v[16]; float ss = 0.f;
#pragma unroll
                    for (int bj = 0; bj < 2; ++bj)
#pragma unroll
                        for (int n = 0; n < 2; ++n)
#pragma unroll
                            for (int j = 0; j < 4; ++j) { const int e = 8 * bj + 4 * n + j; v[e] = acc[ai][bj][m][n][j] + xv[mm][e]; ss += v[e] * v[e]; }
                    store16_f32_nt(Out + row * D_MODEL + col0, v);
#pragma unroll
                    for (int e = 0; e < 16; ++e) v[e] *= gv[e];
                    store16_bf16_nt(A2 + row * D_MODEL + col0, v);
                    ss += __shfl_xor(ss, 16); ss += __shfl_xor(ss, 32);
                    if (fq == 0) (void)__hip_atomic_fetch_add(ssq + row, ss, __ATOMIC_RELAXED, __HIP_MEMORY_SCOPE_AGENT); }
            }
    }
};
struct EpiFfnIn {
    bf16_t* UG; const float* ssq;
    __device__ __forceinline__ void operator()(const f32x4 (&acc)[2][2][4][2], const Unit& u, int wr, int wc, int fr, int fq) const {
        const int col0 = u.pn * 256 + wc * 64 + fq * 8;
        EPI_ROWS_BEGIN
            const size_t row = (size_t)(u.pm * 256 + rloc);
            float sp[16]; load16c_f32(ssq + row * 16, sp);
            float ss = 0.f;
#pragma unroll
            for (int e = 0; e < 16; ++e) ss += sp[e];
            const float rs = rsqrtf(ss * (1.f / 1024.f) + NORM_EPS);
#pragma unroll
            for (int e = 0; e < 16; ++e) v[e] *= rs;
            store16_bf16(UG + row * FF2 + col0, v);
        EPI_ROWS_END
    }
};
__device__ __forceinline__ float gelu_exact(float v) {
    const float t = __builtin_amdgcn_rcpf(fabsf(v) * 0.2316418882f + 1.0f);
    float q = t * 0.5307027145f + (-0.7265760135f); q = q * t + 0.7107068705f; q = q * t + (-0.142248368f); q = q * t + 0.127414796f; q = q * t;
    const float e = __builtin_amdgcn_exp2f(v * v * (-0.72134752044f));
    const float m = v * (q * e);
    return v < 0.f ? m : v - m;
}
__device__ __forceinline__ f32x2 gelu_pk(f32x2 v) {
    const f32x2 av = __builtin_elementwise_abs(v), d = av * 0.2316418882f + 1.0f;
    f32x2 t; t.x = __builtin_amdgcn_rcpf(d.x); t.y = __builtin_amdgcn_rcpf(d.y);
    f32x2 q = t * 0.5307027145f + (-0.7265760135f); q = q * t + 0.7107068705f; q = q * t + (-0.142248368f); q = q * t + 0.127414796f; q = q * t;
    const f32x2 sq = (v * v) * (-0.72134752044f);
    f32x2 e; e.x = __builtin_amdgcn_exp2f(sq.x); e.y = __builtin_amdgcn_exp2f(sq.y);
    const f32x2 m = v * (q * e), r = v - m;
    f32x2 o; o.x = v.x < 0.f ? m.x : r.x; o.y = v.y < 0.f ? m.y : r.y; return o;
}
struct EpiFfnInConv {
    bf16_t* YF; bf16_t* HALO; const float* ssq; const float* cw; const float* cb;
    __device__ __forceinline__ void operator()(const f32x4 (&acc)[2][2][4][2], const Unit& u, int wr, int wc, int fr, int fq) const {
        const int lane = fq * 16 + fr, chb = u.pn * 128 + wc * 32 + fq * 8;
        (void)lane;
        float rsa[2][4]; f32x4 wv[2][4];
#pragma unroll
        for (int ai = 0; ai < 2; ++ai)
#pragma unroll
            for (int m = 0; m < 4; ++m) rsa[ai][m] = ssq[(unsigned)(u.pm * 256 + ai * 128 + wr * 64 + m * 16 + fr)];
#pragma unroll
        for (int n = 0; n < 2; ++n) { wv[n][0] = *(const f32x4*)(cw + chb + 4 * n); wv[n][1] = *(const f32x4*)(cw + D_FF + chb + 4 * n); wv[n][2] = *(const f32x4*)(cw + 2 * D_FF + chb + 4 * n); wv[n][3] = *(const f32x4*)(cb + chb + 4 * n); }
#pragma unroll
        for (int ai = 0; ai < 2; ++ai) {
            float rs[4];
#pragma unroll
            for (int m = 0; m < 4; ++m) rs[m] = rsqrtf(rsa[ai][m] * (1.f / 1024.f) + NORM_EPS);
            const int blk = u.pm * 4 + 2 * ai + wr;
            u32x2 keep[4];
#pragma unroll
            for (int n = 0; n < 2; ++n) {
                const f32x4 w0 = wv[n][0], w1 = wv[n][1], w2 = wv[n][2], bb = wv[n][3];
#pragma unroll
                for (int m = 0; m < 4; ++m) {
                    float yv[4], uc[4], gc[4];
#pragma unroll
                    for (int j = 0; j < 4; ++j) {
                        const float ucur = acc[ai][0][m][n][j] * rs[m];
                        const float um1 = m > 0 ? acc[ai][0][m > 0 ? m - 1 : 0][n][j] * rs[m > 0 ? m - 1 : 0] : 0.f;
                        const float up1 = m < 3 ? acc[ai][0][m < 3 ? m + 1 : 3][n][j] * rs[m < 3 ? m + 1 : 3] : 0.f;
                        const float uprev = __builtin_bit_cast(float, __builtin_amdgcn_update_dpp(0, __builtin_bit_cast(int, fr == 15 ? um1 : ucur), 0x121, 0xf, 0xf, false));
                        const float unext = __builtin_bit_cast(float, __builtin_amdgcn_update_dpp(0, __builtin_bit_cast(int, fr == 0 ? up1 : ucur), 0x12F, 0xf, 0xf, false));
                        yv[j] = bb[j] + w0[j] * uprev + w1[j] * ucur + w2[j] * unext;
                        uc[j] = ucur; gc[j] = acc[ai][1][m][n][j] * rs[m];
                    }
                    { const f32x2 g01 = gelu_pk((f32x2){yv[0], yv[1]}), g23 = gelu_pk((f32x2){yv[2], yv[3]});
                      yv[0] = g01.x * gc[0]; yv[1] = g01.y * gc[1]; yv[2] = g23.x * gc[2]; yv[3] = g23.y * gc[3]; }
                    const unsigned row = (unsigned)(u.pm * 256 + ai * 128 + wr * 64 + m * 16 + fr);
                    const bool e0 = (m == 0 && fr == 0), e63 = (m == 3 && fr == 15);
                    { u32x2 o; o.x = pk2(yv[0], yv[1]); o.y = pk2(yv[2], yv[3]);
                      if (n == 0) keep[m] = o;
                      else if (!(e0 || e63)) { u32x4 o4; o4.x = keep[m].x; o4.y = keep[m].y; o4.z = o.x; o4.w = o.y; __builtin_nontemporal_store(o4, (u32x4*)(YF + (row * (unsigned)D_FF + (unsigned)chb))); } }
                    if (m == 0 || m == 3) {
                        const int hs = m == 0 ? (fr == 0 ? 0 : (fr == 1 ? 1 : -1)) : (fr == 14 ? 2 : (fr == 15 ? 3 : -1));
                        if (hs >= 0) { u32x2 o; o.x = pk2(uc[0], uc[1]); o.y = pk2(uc[2], uc[3]); *(u32x2*)(HALO + ((unsigned)(blk * 6 + hs) * (unsigned)D_FF + (unsigned)(chb + 4 * n))) = o; }
                        if (e0 || e63) { u32x2 o; o.x = pk2(gc[0], gc[1]); o.y = pk2(gc[2], gc[3]); *(u32x2*)(HALO + ((unsigned)(blk * 6 + (e0 ? 4 : 5)) * (unsigned)D_FF + (unsigned)(chb + 4 * n))) = o; }
                    }
                    asm volatile("" ::: "memory");
                }
            }
        }
    }
};
struct EpiFfnOut {
    float* Out;
    __device__ __forceinline__ void operator()(const f32x4 (&acc)[2][2][4][2], const Unit& u, int wr, int wc, int fr, int fq) const {
        const int col0 = u.pn * 256 + wc * 64 + fq * 8;
#pragma unroll
        for (int ai = 0; ai < 2; ++ai)
#pragma unroll
            for (int mp2 = 0; mp2 < 2; ++mp2) {
                float xv[2][16];
#pragma unroll
                for (int mm = 0; mm < 2; ++mm) load16_f32(Out + (size_t)(u.pm * 256 + ai * 128 + wr * 64 + (2 * mp2 + mm) * 16 + fr) * D_MODEL + col0, xv[mm]);
#pragma unroll
                for (int mm = 0; mm < 2; ++mm) { const int m = 2 * mp2 + mm; float v[16];
#pragma unroll
                    for (int bj = 0; bj < 2; ++bj)
#pragma unroll
                        for (int n = 0; n < 2; ++n)
#pragma unroll
                            for (int j = 0; j < 4; ++j) { const int e = 8 * bj + 4 * n + j; v[e] = acc[ai][bj][m][n][j] + xv[mm][e]; }
                    store16_f32_nt(Out + (size_t)(u.pm * 256 + ai * 128 + wr * 64 + m * 16 + fr) * D_MODEL + col0, v); }
            }
    }
};

__device__ __forceinline__ int ffn_row_of(int ng) { const int gate = ng >= D_FF ? 1 : 0, ch = ng - gate * D_FF, c7 = ch & 127;
    return (ch >> 7) * 256 + 128 * gate + 32 * (c7 >> 5) + 16 * ((c7 >> 2) & 1) + 4 * ((c7 >> 3) & 3) + (c7 & 3); }
template <int PERMMODE>
__device__ __forceinline__ void p0_transpose_item(const float* W, int K, int N, bf16_t* WT, int row_off, LAS float* scr, int item, int lane) {
    const int nblk = N / 32, kb = item / nblk, nb = item % nblk, k0 = 64 * kb, n0 = 32 * nb;
#pragma unroll 8
    for (int i = 0; i < 32; ++i) { const int kk = 2 * i + (lane >> 5); scr[kk * 33 + (lane & 31)] = W[(size_t)(k0 + kk) * N + n0 + (lane & 31)]; }
    asm volatile("s_waitcnt lgkmcnt(0)" ::: "memory");
    const int c = lane & 7;
#pragma unroll
    for (int j = 0; j < 4; ++j) { const int n = (lane >> 3) + 8 * j; const LAS float* s = scr + (8 * c) * 33 + n;
        u32x4 o; o.x = pk2(s[0 * 33], s[1 * 33]); o.y = pk2(s[2 * 33], s[3 * 33]); o.z = pk2(s[4 * 33], s[5 * 33]); o.w = pk2(s[6 * 33], s[7 * 33]);
        const int ng = n0 + n, nrow = PERMMODE == 1 ? ffn_row_of(ng) : (ng & ~255) + slot_of(ng & 255);
        *(u32x4*)(WT + (size_t)(row_off + nrow) * K + k0 + 8 * c) = o; }
    asm volatile("s_waitcnt lgkmcnt(0)" ::: "memory");
}
__device__ __forceinline__ void rms_row_to_bf16(const float* xrow, const float* g, bf16_t* orow, int lane) {
    const f32x4* xr = (const f32x4*)xrow + lane; const f32x4* gr = (const f32x4*)g + lane;
    f32x4 v[4]; float s = 0.f;
#pragma unroll
    for (int j = 0; j < 4; ++j) { v[j] = xr[64 * j]; s += (v[j].x * v[j].x + v[j].y * v[j].y) + (v[j].z * v[j].z + v[j].w * v[j].w); }
    const float rs = rsqrtf(wave_sum(s) * (1.f / 1024.f) + NORM_EPS);
    u32x2* o8 = (u32x2*)orow + lane;
#pragma unroll
    for (int j = 0; j < 4; ++j) { const f32x4 gg = gr[64 * j]; u32x2 w; w.x = pk2(v[j].x * rs * gg.x, v[j].y * rs * gg.y); w.y = pk2(v[j].z * rs * gg.z, v[j].w * rs * gg.w); o8[64 * j] = w; }
}

__device__ __forceinline__ void rms_row2_to_bf16(const float* xa, const float* xb, const float* g, bf16_t* oa, bf16_t* ob, int lane) {
    const f32x4* ra = (const f32x4*)xa + lane; const f32x4* rb = (const f32x4*)xb + lane; const f32x4* gr = (const f32x4*)g + lane;
    f32x4 va[4], vb[4]; float sa = 0.f, sb = 0.f;
#pragma unroll
    for (int j = 0; j < 4; ++j) { va[j] = ra[64 * j]; vb[j] = rb[64 * j]; }
#pragma unroll
    for (int j = 0; j < 4; ++j) { sa += (va[j].x * va[j].x + va[j].y * va[j].y) + (va[j].z * va[j].z + va[j].w * va[j].w); sb += (vb[j].x * vb[j].x + vb[j].y * vb[j].y) + (vb[j].z * vb[j].z + vb[j].w * vb[j].w); }
#pragma unroll
    for (int o = 1; o < 64; o <<= 1) { sa += __shfl_xor(sa, o); sb += __shfl_xor(sb, o); }
    const float rsa = rsqrtf(sa * (1.f / 1024.f) + NORM_EPS), rsb = rsqrtf(sb * (1.f / 1024.f) + NORM_EPS);
    u32x2* o8a = (u32x2*)oa + lane; u32x2* o8b = (u32x2*)ob + lane;
#pragma unroll
    for (int j = 0; j < 4; ++j) { const f32x4 gg = gr[64 * j]; u32x2 w;
        w.x = pk2(va[j].x * rsa * gg.x, va[j].y * rsa * gg.y); w.y = pk2(va[j].z * rsa * gg.z, va[j].w * rsa * gg.w); o8a[64 * j] = w;
        w.x = pk2(vb[j].x * rsb * gg.x, vb[j].y * rsb * gg.y); w.y = pk2(vb[j].z * rsb * gg.z, vb[j].w * rsb * gg.w); o8b[64 * j] = w; }
}


__device__ __forceinline__ void dil_wave(const bf16_t* proj, bf16_t* odil, float* lse, const float* cconst, int item, LAS char* vl, int lane) {
    asm volatile("" : "+v"(lane));
    const int qb = item & 31; int t = item >> 5; const int g = t % 3; t /= 3; const int h = t & 7, b = t >> 3;
    const float cshift = cconst[g];
    const int lr = 2 * g, r = 1 << lr, nsub = SEQ >> lr, nblk = nsub >> 6;
    const int c = qb / nblk, nb = qb % nblk, i0 = nb * 64;
    const int rr = lane & 31, hh = lane >> 5;
    const int rowb = b * SEQ;
    const int qcol = g * 1536 + h * 64, kcol = qcol + 512, vcol = qcol + 1024;
    const int kt_lo = i0 == 0 ? 2 : 0, kt_hi = (i0 == nsub - 64) ? 4 : 6;
    bf16x8 kn[4];
#define DIL_ISSUE(KT) do { const int j0_ = i0 - 64 + 32 * (KT); \
        { int jr = j0_ + rr; jr = jr < 0 ? 0 : (jr >= nsub ? nsub - 1 : jr); const bf16_t* p = proj + pofs(rowb + jr * r + c, kcol + 32 * hh); \
          _Pragma("unroll") for (int ks = 0; ks < 4; ++ks) kn[ks] = *(const bf16x8*)(p + 8 * ks); } \
        _Pragma("unroll") for (int q = 0; q < 4; ++q) { int jv = j0_ + 8 * q + (lane >> 3); jv = jv < 0 ? 0 : (jv >= nsub ? nsub - 1 : jv); \
          __builtin_amdgcn_global_load_lds((const unsigned*)(proj + pofs(rowb + jv * r + c, vcol + 8 * (lane & 7))), (LAS unsigned*)(vl + 4096 * ((KT) & 1) + 1024 * q), 16, 0, 0); } } while (0)
    DIL_ISSUE(kt_lo);
    bf16x8 qf[2][4];
#pragma unroll
    for (int qt = 0; qt < 2; ++qt) { const int tok = (i0 + 32 * qt + rr) * r + c; const bf16_t* p = proj + pofs(rowb + tok, qcol + 32 * hh);
#pragma unroll
        for (int ks = 0; ks < 4; ++ks) qf[qt][ks] = *(const bf16x8*)(p + 8 * ks); }
    f32x16 o[2][2];
#pragma unroll
    for (int a = 0; a < 2; ++a)
#pragma unroll
        for (int q = 0; q < 2; ++q)
#pragma unroll
            for (int e = 0; e < 16; ++e) o[a][q][e] = 0.f;
    float lrun[2] = {0.f, 0.f};
    const float slope2 = exp2f(-(float)(h + 1)) * (float)r * LOG2E;
    const int blk = (lane >> 4) & 1, q4 = (lane & 15) >> 2, p4 = lane & 3;
    float fd[16];
#pragma unroll
    for (int e = 0; e < 16; ++e) fd[e] = (float)(rr - 4 * hh - ((e & 3) + 8 * (e >> 2)));
#ifdef PROBE_DILLOOP
    for (int rep = 0; rep < 2; ++rep) {
    if (rep) { DIL_ISSUE(kt_lo); lrun[0] = 0.f; lrun[1] = 0.f;
        _Pragma("unroll") for (int a = 0; a < 2; ++a) _Pragma("unroll") for (int q = 0; q < 2; ++q) _Pragma("unroll") for (int e = 0; e < 16; ++e) o[a][q][e] = 0.f; }
#endif
    for (int kt = kt_lo; kt < kt_hi; ++kt) {
        asm volatile("s_waitcnt vmcnt(0)" ::: "memory");
        bf16x8 kf[4];
#pragma unroll
        for (int ks = 0; ks < 4; ++ks) kf[ks] = kn[ks];
        if (kt + 1 < kt_hi) DIL_ISSUE(kt + 1);
        asm volatile("" ::: "memory");
        LAS char* vb = vl + 4096 * (kt & 1);
        bf16x8 pf[2][2];
        bool act[2];
#pragma unroll
        for (int qt = 0; qt < 2; ++qt) {
            const int mrel = kt - qt;
            act[qt] = !(mrel == 5 || mrel == -1);
            if (!act[qt]) continue;
            f32x16 s;
#pragma unroll
            for (int e = 0; e < 16; ++e) s[e] = -cshift;
#pragma unroll
            for (int ks = 0; ks < 4; ++ks) s = MFMA32(kf[ks], qf[qt][ks], s);
            const float Df = 64.f - 32.f * (float)mrel;
            const bool edge = (mrel == 0) || (mrel == 4);
            float rs = 0.f;
#pragma unroll
            for (int e = 0; e < 16; ++e) { const float tt = Df + fd[e]; float sv = fmaf(-slope2, fabsf(tt), s[e]);
                if (edge) sv = fabsf(tt) <= 64.f ? sv : -INFINITY;
                const float p = __builtin_amdgcn_exp2f(sv); s[e] = p; rs += p; }
            lrun[qt] += rs;
#pragma unroll
            for (int s2 = 0; s2 < 2; ++s2) pf[qt][s2] = pack8(s[8 * s2], s[8 * s2 + 1], s[8 * s2 + 2], s[8 * s2 + 3], s[8 * s2 + 4], s[8 * s2 + 5], s[8 * s2 + 6], s[8 * s2 + 7]);
        }
#pragma unroll
        for (int dt = 0; dt < 2; ++dt)
#pragma unroll
            for (int s2 = 0; s2 < 2; ++s2) {
                LAS char* a = vb + (16 * s2 + 4 * hh + q4) * 128 + (32 * dt + 16 * blk + 4 * p4) * 2;
                const bf16x8 vf = cat4(tr_read(a), tr_read(a + 8 * 128));
#pragma unroll
                for (int qt = 0; qt < 2; ++qt) if (act[qt]) o[dt][qt] = MFMA32(vf, pf[qt][s2], o[dt][qt]);
            }
        asm volatile("" ::: "memory");
    }
#ifdef PROBE_DILLOOP
    }
#endif
#undef DIL_ISSUE
#pragma unroll
    for (int qt = 0; qt < 2; ++qt) {
        const float lt = lrun[qt] + __shfl_xor(lrun[qt], 32);
        const int row = 32 * qt + rr; const float inv = __builtin_amdgcn_rcpf(lt);
#pragma unroll
        for (int dt = 0; dt < 2; ++dt)
#pragma unroll
            for (int gq = 0; gq < 4; ++gq) { u32x2 w; w.x = pk2(o[dt][qt][4 * gq] * inv, o[dt][qt][4 * gq + 1] * inv); w.y = pk2(o[dt][qt][4 * gq + 2] * inv, o[dt][qt][4 * gq + 3] * inv);
                *(LAS u32x2*)(vl + row * 128 + 16 * ((4 * dt + gq) ^ (row & 7)) + 8 * hh) = w; }
        if (hh == 0) lse[((size_t)g * HTOK + (size_t)b * SEQ + (i0 + row) * r + c) * 8 + h] = log2f(lt) + cshift;
    }
    asm volatile("" ::: "memory");
    { bf16_t* ob = odil + ((size_t)g * HTOK + (size_t)b * SEQ) * 512 + h * 64;
#pragma unroll
        for (int q = 0; q < 8; ++q) { const int row = 8 * q + (lane >> 3), pos = lane & 7, ch = pos ^ (row & 7);
            const u32x4 v = *(const LAS u32x4*)(vl + row * 128 + 16 * pos);
            *(u32x4*)(ob + (size_t)((i0 + row) * r + c) * 512 + 8 * ch) = v; } }
    asm volatile("" ::: "memory");
}

__device__ __forceinline__ void ret_u_item(const bf16_t* proj, bf16_t* U, const float* decay_logit, int item, LAS char* L, int tid) {
    asm volatile("" : "+v"(tid));
    const int n = item & 15, h = (item >> 4) & 3, b = item >> 6;
    const int lane = tid & 63, wave = tid >> 6, rr = lane & 31, hh = lane >> 5, blk = (lane >> 4) & 1, q4 = (lane & 15) >> 2, p4 = lane & 3;
    const float Lf = -log1pf(expf(-decay_logit[h])) * LOG2E, Lb = -log1pf(expf(-decay_logit[4 + h])) * LOG2E;
    const int rowb = b * SEQ + 128 * n;
    { const int row = tid >> 2, pc = tid & 3; const bf16_t* p = proj + pofs(rowb + row, RET_OFF + 256 + h * 64 + 16 * pc);
        const u32x4 a = *(const u32x4*)p, c = *(const u32x4*)(p + 8);
        const float wf = exp2f(Lf * (float)(127 - row)), wb = exp2f(Lb * (float)row);
        u32x4 o;
        o.x = pk2(bflo(a.x) * wf, bfhi(a.x) * wf); o.y = pk2(bflo(a.y) * wf, bfhi(a.y) * wf); o.z = pk2(bflo(a.z) * wf, bfhi(a.z) * wf); o.w = pk2(bflo(a.w) * wf, bfhi(a.w) * wf);
        *(LAS u32x4*)(L + row * 128 + 32 * pc) = o;
        o.x = pk2(bflo(c.x) * wf, bfhi(c.x) * wf); o.y = pk2(bflo(c.y) * wf, bfhi(c.y) * wf); o.z = pk2(bflo(c.z) * wf, bfhi(c.z) * wf); o.w = pk2(bflo(c.w) * wf, bfhi(c.w) * wf);
        *(LAS u32x4*)(L + row * 128 + 32 * pc + 16) = o;
        o.x = pk2(bflo(a.x) * wb, bfhi(a.x) * wb); o.y = pk2(bflo(a.y) * wb, bfhi(a.y) * wb); o.z = pk2(bflo(a.z) * wb, bfhi(a.z) * wb); o.w = pk2(bflo(a.w) * wb, bfhi(a.w) * wb);
        *(LAS u32x4*)(L + 16384 + row * 128 + 32 * pc) = o;
        o.x = pk2(bflo(c.x) * wb, bfhi(c.x) * wb); o.y = pk2(bflo(c.y) * wb, bfhi(c.y) * wb); o.z = pk2(bflo(c.z) * wb, bfhi(c.z) * wb); o.w = pk2(bflo(c.w) * wb, bfhi(c.w) * wb);
        *(LAS u32x4*)(L + 16384 + row * 128 + 32 * pc + 16) = o; }
#pragma unroll
    for (int q = 0; q < 4; ++q) { const int idx = tid + 512 * q, row = idx >> 4, pc = idx & 15;
        *(LAS u32x4*)(L + 32768 + row * 256 + 16 * pc) = *(const u32x4*)(proj + pofs(rowb + row, RET_OFF + 512 + h * 128 + 8 * pc)); }
    __syncthreads();
    const int dir = wave >> 2, vt = wave & 3;
    f32x16 acc[2];
#pragma unroll
    for (int a = 0; a < 2; ++a)
#pragma unroll
        for (int e = 0; e < 16; ++e) acc[a][e] = 0.f;
    LAS char* KI = L + 16384 * dir; LAS char* VI = L + 32768;
#pragma unroll
    for (int ks = 0; ks < 8; ++ks) {
        const int jrow = 16 * ks + 8 * hh + q4;
        LAS char* vb = VI + jrow * 256 + (32 * vt + 16 * blk + 4 * p4) * 2;
        const bf16x8 bfr = cat4(tr_read(vb), tr_read(vb + 4 * 256));
#pragma unroll
        for (int dt = 0; dt < 2; ++dt) { LAS char* ka = KI + jrow * 128 + (32 * dt + 16 * blk + 4 * p4) * 2;
            const bf16x8 afr = cat4(tr_read(ka), tr_read(ka + 4 * 128));
            acc[dt] = MFMA32(afr, bfr, acc[dt]); }
    }
    bf16_t* up = U + ((size_t)((b * 4 + h) * 16 + n) * 2 + dir) * 8192;
#pragma unroll
    for (int dt = 0; dt < 2; ++dt)
#pragma unroll
        for (int e = 0; e < 16; ++e) up[(32 * dt + (e & 3) + 8 * (e >> 2) + 4 * hh) * 128 + 32 * vt + rr] = (bf16_t)(pk2(acc[dt][e], 0.f) & 0xffffu);
    __syncthreads();
}
__device__ __forceinline__ bf16x8 scale_frag(bf16x8 f, float sc) {
    const u32x4 w = __builtin_bit_cast(u32x4, f);
    return pack8(bflo(w.x) * sc, bfhi(w.x) * sc, bflo(w.y) * sc, bfhi(w.y) * sc, bflo(w.z) * sc, bfhi(w.z) * sc, bflo(w.w) * sc, bfhi(w.w) * sc);
}
__device__ __forceinline__ void st16_lds_bf16(LAS char* p, const float (&v)[16]) {
    u32x4 a, b; a.x = pk2(v[0], v[1]); a.y = pk2(v[2], v[3]); a.z = pk2(v[4], v[5]); a.w = pk2(v[6], v[7]);
    b.x = pk2(v[8], v[9]); b.y = pk2(v[10], v[11]); b.z = pk2(v[12], v[13]); b.w = pk2(v[14], v[15]);
    *(LAS u32x4*)p = a; *(LAS u32x4*)(p + 16) = b;
}
__device__ __forceinline__ void ret_chunk_item(const bf16_t* proj, const bf16_t* U, bf16_t* yret, const float* decay_logit, const float* gn_g, int item, LAS char* L, int tid) {
    asm volatile("" : "+v"(tid));
    const int pr = item & 7, h = (item >> 3) & 3, b = item >> 5, n = 2 * pr;
    const int lane = tid & 63, wave = tid >> 6, rr = lane & 31, hh = lane >> 5, blk = (lane >> 4) & 1, q4 = (lane & 15) >> 2, p4 = lane & 3;
    const float Lf = -log1pf(expf(-decay_logit[h])) * LOG2E, Lb = -log1pf(expf(-decay_logit[4 + h])) * LOG2E;
    const int rowb = b * SEQ + 128 * n;
#pragma unroll
    for (int q = 0; q < 8; ++q) { const int idx = tid + 512 * q, row = idx >> 4, pc = idx & 15;
        *(LAS u32x4*)(L + row * 256 + 16 * pc) = *(const u32x4*)(proj + pofs(rowb + row, RET_OFF + 512 + h * 128 + 8 * pc)); }
    { const bf16_t* Ub = U + (size_t)((b * 4 + h) * 16) * 2 * 8192 + tid * 16;
        const float wf = exp2f(128.f * Lf), wb = exp2f(128.f * Lb);
        const int d = tid >> 3, v0 = (tid & 7) * 16;
        LAS char* S = L + 65536 + d * 256 + v0 * 2;
        float acc[16], t[16];
#pragma unroll
        for (int e = 0; e < 16; ++e) acc[e] = 0.f;
        for (int m0 = n - 4 * ((n + 3) >> 2); m0 < n; m0 += 4) {
            float t4[4][16];
#pragma unroll
            for (int u4 = 0; u4 < 4; ++u4) { const int m = m0 + u4; load16c_bf16(Ub + (size_t)((m < 0 ? 0 : m) * 2) * 8192, t4[u4]); }
#pragma unroll
            for (int u4 = 0; u4 < 4; ++u4) { const float msk = (m0 + u4) < 0 ? 0.f : 1.f;
#pragma unroll
                for (int e = 0; e < 16; ++e) acc[e] = acc[e] * wf + t4[u4][e] * msk; } }
        st16_lds_bf16(S, acc);
        load16c_bf16(Ub + (size_t)(n * 2) * 8192, t);
#pragma unroll
        for (int e = 0; e < 16; ++e) acc[e] = acc[e] * wf + t[e];
        st16_lds_bf16(S + 2 * 16384, acc);
#pragma unroll
        for (int e = 0; e < 16; ++e) acc[e] = 0.f;
        { const int cnt = 14 - n;
          for (int m0 = 15 + 4 * ((cnt + 3) >> 2) - cnt; m0 > 15 - cnt; m0 -= 4) {
            float t4[4][16];
#pragma unroll
            for (int u4 = 0; u4 < 4; ++u4) { const int m = m0 - u4; load16c_bf16(Ub + (size_t)((m > 15 ? 15 : m) * 2 + 1) * 8192, t4[u4]); }
#pragma unroll
            for (int u4 = 0; u4 < 4; ++u4) { const float msk = (m0 - u4) > 15 ? 0.f : 1.f;
#pragma unroll
                for (int e = 0; e < 16; ++e) acc[e] = acc[e] * wb + t4[u4][e] * msk; } } }
        st16_lds_bf16(S + 3 * 16384, acc);
        load16c_bf16(Ub + (size_t)((n + 1) * 2 + 1) * 8192, t);
#pragma unroll
        for (int e = 0; e < 16; ++e) acc[e] = acc[e] * wb + t[e];
        st16_lds_bf16(S + 1 * 16384, acc);
    }
    __syncthreads();
    const int cw = wave >> 2, i = 32 * (wave & 3) + rr;
    const int crow = rowb + 128 * cw;
    bf16x8 qf[4];
    { const bf16_t* p = proj + pofs(crow + i, RET_OFF + h * 64 + 32 * hh);
#pragma unroll
        for (int ks = 0; ks < 4; ++ks) qf[ks] = *(const bf16x8*)(p + 8 * ks); }
    f32x16 y[4];
#pragma unroll
    for (int a = 0; a < 4; ++a)
#pragma unroll
        for (int e = 0; e < 16; ++e) y[a][e] = 0.f;
    LAS char* VI = L + cw * 32768;
#pragma unroll
    for (int kt = 0; kt < 4; ++kt) {
        const int j0 = 32 * kt;
        bf16x8 kf[4];
        { const bf16_t* p = proj + pofs(crow + j0 + rr, RET_OFF + 256 + h * 64 + 32 * hh);
#pragma unroll
            for (int ks = 0; ks < 4; ++ks) kf[ks] = *(const bf16x8*)(p + 8 * ks); }
        f32x16 s;
#pragma unroll
        for (int e = 0; e < 16; ++e) s[e] = 0.f;
#pragma unroll
        for (int ks = 0; ks < 4; ++ks) s = MFMA32(kf[ks], qf[ks], s);
#pragma unroll
        for (int e = 0; e < 16; ++e) { const int j = j0 + (e & 3) + 8 * (e >> 2) + 4 * hh; const int dd = i - j;
            const float w = dd >= 0 ? exp2f(Lf * (float)dd) : exp2f(Lb * (float)(-dd)); s[e] *= w; }
        bf16x8 pf[2];
#pragma unroll
        for (int s2 = 0; s2 < 2; ++s2) pf[s2] = pack8(s[8 * s2], s[8 * s2 + 1], s[8 * s2 + 2], s[8 * s2 + 3], s[8 * s2 + 4], s[8 * s2 + 5], s[8 * s2 + 6], s[8 * s2 + 7]);
#pragma unroll
        for (int vt = 0; vt < 4; ++vt)
#pragma unroll
            for (int s2 = 0; s2 < 2; ++s2) {
                LAS char* a = VI + (j0 + 16 * s2 + 4 * hh + q4) * 256 + (32 * vt + 16 * blk + 4 * p4) * 2;
                const bf16x8 vf = cat4(tr_read(a), tr_read(a + 8 * 256));
                y[vt] = MFMA32(vf, pf[s2], y[vt]);
            }
    }
#pragma unroll
    for (int dir = 0; dir < 2; ++dir) {
        const float sc = dir == 0 ? exp2f(Lf * (float)(i + 1)) : exp2f(Lb * (float)(128 - i));
        LAS char* SI = L + 65536 + (cw * 2 + dir) * 16384;
#pragma unroll
        for (int ks = 0; ks < 4; ++ks) {
            const bf16x8 qs = scale_frag(qf[ks], sc);
#pragma unroll
            for (int vt = 0; vt < 4; ++vt) {
                LAS char* a = SI + (32 * hh + 8 * ks + q4) * 256 + (32 * vt + 16 * blk + 4 * p4) * 2;
                const bf16x8 af = cat4(tr_read(a), tr_read(a + 4 * 256));
                y[vt] = MFMA32(af, qs, y[vt]);
            }
        }
    }
    float sm = 0.f;
#pragma unroll
    for (int vt = 0; vt < 4; ++vt)
#pragma unroll
        for (int e = 0; e < 16; ++e) sm += y[vt][e];
    sm += __shfl_xor(sm, 32);
    const float mu = sm * (1.f / 128.f);
    float sq = 0.f;
#pragma unroll
    for (int vt = 0; vt < 4; ++vt)
#pragma unroll
        for (int e = 0; e < 16; ++e) { const float dlt = y[vt][e] - mu; sq += dlt * dlt; }
    sq += __shfl_xor(sq, 32);
    const float rs = rsqrtf(sq * (1.f / 128.f) + NORM_EPS);
    const bf16_t* gp = proj + pofs(crow + i, RET_OFF + 1024 + h * 128);
    bf16_t* op = yret + ((size_t)b * SEQ + 128 * (n + cw) + i) * 512 + h * 128;
    const float* gg = gn_g + h * 128;
#pragma unroll
    for (int vt = 0; vt < 4; ++vt)
#pragma unroll
        for (int gq = 0; gq < 4; ++gq) { const int vi = 32 * vt + 8 * gq + 4 * hh;
            const u32x2 gw = *(const u32x2*)(gp + vi); const f32x4 g4 = *(const f32x4*)(gg + vi);
            u32x2 w; w.x = pk2((y[vt][4 * gq] - mu) * rs * g4.x * bflo(gw.x), (y[vt][4 * gq + 1] - mu) * rs * g4.y * bfhi(gw.x));
            w.y = pk2((y[vt][4 * gq + 2] - mu) * rs * g4.z * bflo(gw.y), (y[vt][4 * gq + 3] - mu) * rs * g4.w * bfhi(gw.y));
            *(u32x2*)(op + vi) = w; }
    __syncthreads();
}

__device__ __forceinline__ bf16x8 scale8(u32x4 w, float rs, const float* g) {
    const f32x4 g0 = *(const f32x4*)g, g1 = *(const f32x4*)(g + 4);
    return pack8(bflo(w.x) * rs * g0.x, bfhi(w.x) * rs * g0.y, bflo(w.y) * rs * g0.z, bfhi(w.y) * rs * g0.w, bflo(w.z) * rs * g1.x, bfhi(w.z) * rs * g1.y, bflo(w.w) * rs * g1.z, bfhi(w.w) * rs * g1.w);
}
__device__ __forceinline__ float ssq8(u32x4 w) {
    const float a = bflo(w.x), b = bfhi(w.x), c = bflo(w.y), d = bfhi(w.y), e = bflo(w.z), f = bfhi(w.z), g = bflo(w.w), h = bfhi(w.w);
    return ((a * a + b * b) + (c * c + d * d)) + ((e * e + f * f) + (g * g + h * h));
}
constexpr int MEM_PITCH = 272;
__device__ __forceinline__ void mem_item(const bf16_t* proj, const bf16_t* memkv  , bf16_t* ymem, const float* gqn, const float* gkn, const float* cconst, int item, LAS char* L, int tid) {
    asm volatile("" : "+v"(tid));
    const float cshift = cconst[3];
    const int qr = item & 3, hd = (item >> 2) & 3, b = item >> 4;
    const int lane = tid & 63, wave = tid >> 6, rr = lane & 31, hh = lane >> 5, blk = (lane >> 4) & 1, q4 = (lane & 15) >> 2, p4 = lane & 3;
    const bf16_t* kvb = memkv + (size_t)b * N_MEM * 1024 + hd * 128;
    LAS char* KI = L; LAS char* VI = L + 256 * MEM_PITCH;
#pragma unroll
    for (int q = 0; q < 8; ++q) {
        const int idx = tid + 512 * q, row = idx >> 4, pc = idx & 15;
        const u32x4 kw = *(const u32x4*)(kvb + (size_t)row * 1024 + 8 * pc), vw = *(const u32x4*)(kvb + (size_t)row * 1024 + 512 + 8 * pc);
        float ss = ssq8(kw);
        ss += __shfl_xor(ss, 1); ss += __shfl_xor(ss, 2); ss += __shfl_xor(ss, 4); ss += __shfl_xor(ss, 8);
        const float rs = rsqrtf(ss * (1.f / 128.f) + NORM_EPS);
        *(LAS bf16x8*)(KI + row * MEM_PITCH + 16 * pc) = scale8(kw, rs, gkn + 8 * pc);
        *(LAS u32x4*)(VI + row * MEM_PITCH + 16 * pc) = vw;
    }
    __syncthreads();
#pragma unroll 1
    for (int tq = 0; tq < 2; ++tq) {
        const int i = 512 * qr + 32 * (wave * 2 + tq) + rr;
        bf16x8 qf[8];
        { const bf16_t* p = proj + pofs(b * SEQ + i, MEMQ_OFF + hd * 128 + 64 * hh);
            u32x4 raw[8]; float ss = 0.f;
#pragma unroll
            for (int ks = 0; ks < 8; ++ks) { raw[ks] = *(const u32x4*)(p + 8 * ks); ss += ssq8(raw[ks]); }
            ss += __shfl_xor(ss, 32);
            const float rs = rsqrtf(ss * (1.f / 128.f) + NORM_EPS) * (0.08838834764831845f * LOG2E);
#pragma unroll
            for (int ks = 0; ks < 8; ++ks) qf[ks] = scale8(raw[ks], rs, gqn + 64 * hh + 8 * ks); }
        f32x16 o[4];
#pragma unroll
        for (int a = 0; a < 4; ++a)
#pragma unroll
            for (int e = 0; e < 16; ++e) o[a][e] = 0.f;
        float lrun = 0.f;
#pragma unroll 2
        for (int kt = 0; kt < 8; ++kt) {
            const int j0 = 32 * kt;
            f32x16 s;
#pragma unroll
            for (int e = 0; e < 16; ++e) s[e] = -cshift;
#pragma unroll
            for (int ks = 0; ks < 8; ++ks) { const bf16x8 kf = *(const LAS bf16x8*)(KI + (j0 + rr) * MEM_PITCH + (64 * hh + 8 * ks) * 2); s = MFMA32(kf, qf[ks], s); }
#pragma unroll
            for (int e = 0; e < 16; ++e) { const float p = __builtin_amdgcn_exp2f(s[e]); s[e] = p; lrun += p; }
            bf16x8 pf[2];
#pragma unroll
            for (int s2 = 0; s2 < 2; ++s2) pf[s2] = pack8(s[8 * s2], s[8 * s2 + 1], s[8 * s2 + 2], s[8 * s2 + 3], s[8 * s2 + 4], s[8 * s2 + 5], s[8 * s2 + 6], s[8 * s2 + 7]);
#pragma unroll
            for (int vt = 0; vt < 4; ++vt)
#pragma unroll
                for (int s2 = 0; s2 < 2; ++s2) {
                    LAS char* a = VI + (j0 + 16 * s2 + 4 * hh + q4) * MEM_PITCH + (32 * vt + 16 * blk + 4 * p4) * 2;
                    const bf16x8 vf = cat4(tr_read(a), tr_read(a + 8 * MEM_PITCH));
                    o[vt] = MFMA32(vf, pf[s2], o[vt]);
                }
        }
        const float inv = __builtin_amdgcn_rcpf(lrun + __shfl_xor(lrun, 32));
        bf16_t* op = ymem + ((size_t)b * SEQ + i) * 512 + hd * 128;
#pragma unroll
        for (int vt = 0; vt < 4; ++vt)
#pragma unroll
            for (int gq = 0; gq < 4; ++gq) { u32x2 w; w.x = pk2(o[vt][4 * gq] * inv, o[vt][4 * gq + 1] * inv); w.y = pk2(o[vt][4 * gq + 2] * inv, o[vt][4 * gq + 3] * inv);
                *(u32x2*)(op + 32 * vt + 8 * gq + 4 * hh) = w; }
    }
    __syncthreads();
}

#define XB_TMO      128
#define XB_XCNT(j)  (256  + 64 * (j))
#define XB_XSUB(j)  (1280 + 64 * (j))
#define XB_XGEN(j)  (2304 + 64 * (j))
#define XB_TOP      3328
#define XB_TOPGEN   3392
#define XCD_BAR_WORDS 3456
#define XB_SPIN_CAP (1u << 22)
__device__ __forceinline__ unsigned xb_ld(unsigned* p)              { return __hip_atomic_load(p, __ATOMIC_RELAXED, __HIP_MEMORY_SCOPE_AGENT); }
__device__ __forceinline__ unsigned xb_add(unsigned* p, unsigned v) { return __hip_atomic_fetch_add(p, v, __ATOMIC_RELAXED, __HIP_MEMORY_SCOPE_AGENT); }
__device__ __forceinline__ unsigned xb_xcc_id() { return (unsigned)__builtin_amdgcn_s_getreg((3 << 11) | 20) & 0xFu; }
#define XB_SPIN(cond, bar) do { unsigned _sp = 0; while (cond) { __builtin_amdgcn_s_sleep(1); \
    if ((++_sp & 255u) == 0u) { if (xb_ld(&(bar)[XB_TMO])) break; if (_sp > XB_SPIN_CAP) { atomicAdd(&(bar)[XB_TMO], 1u); break; } } } } while (0)
struct XcdBarrier { unsigned* bar; unsigned x; volatile LAS unsigned* st; };
__device__ __forceinline__ XcdBarrier xcd_barrier_post(unsigned* bar, volatile LAS unsigned* st) {
    XcdBarrier b; b.bar = bar; b.x = xb_xcc_id(); b.st = st;
    if (threadIdx.x == 0) (void)xb_add(&bar[XB_XCNT(b.x)], 1u);
    return b;
}
__device__ __forceinline__ void xcd_barrier_complete(unsigned* bar, unsigned x, unsigned& nloc, unsigned& nx) {
    const unsigned G = gridDim.x * gridDim.y * gridDim.z;
    unsigned sum, cnt, mine, sp = 0u;
    for (;;) {
        sum = 0u; cnt = 0u; mine = 0u;
#pragma unroll
        for (unsigned j = 0; j < 16; ++j) { const unsigned c = xb_ld(&bar[XB_XCNT(j)]); sum += c; cnt += (c > 0u) ? 1u : 0u; mine = (j == x) ? c : mine; }
        if (sum == G) break;
        __builtin_amdgcn_s_sleep(1);
        if ((++sp & 255u) == 0u) { if (xb_ld(&bar[XB_TMO])) break; if (sp > XB_SPIN_CAP) { atomicAdd(&bar[XB_TMO], 1u); break; } }
    }
    nloc = mine > 0u ? mine : 1u; nx = cnt > 0u ? cnt : 1u;
}
__device__ __forceinline__ void xcd_barrier(const XcdBarrier& b) {
    asm volatile("s_waitcnt vmcnt(0)" ::: "memory");
    __syncthreads();
    if (threadIdx.x == 0) {
        unsigned* bar = b.bar;
        __builtin_amdgcn_s_waitcnt(0);
        unsigned nloc = b.st[0], nx = b.st[1];
        if (nloc == 0u) { xcd_barrier_complete(bar, b.x, nloc, nx); b.st[0] = nloc; b.st[1] = nx; }
        const unsigned old = xb_add(&bar[XB_XSUB(b.x)], 1u);
        const unsigned gen = old / nloc;
        if (old + 1u == (gen + 1u) * nloc) {
            __builtin_amdgcn_fence(__ATOMIC_RELEASE, "agent");
            asm volatile("s_waitcnt vmcnt(0)" ::: "memory");
            const unsigned og = xb_add(&bar[XB_TOP], 1u);
            const unsigned tg = og / nx;
            if (og + 1u == (tg + 1u) * nx) xb_add(&bar[XB_TOPGEN], 1u);
            else XB_SPIN(xb_ld(&bar[XB_TOPGEN]) == tg, bar);
            __builtin_amdgcn_fence(__ATOMIC_ACQUIRE, "agent");
            xb_add(&bar[XB_XGEN(b.x)], 1u);
            asm volatile("s_waitcnt vmcnt(0)" ::: "memory");
        } else {
            XB_SPIN(xb_ld(&bar[XB_XGEN(b.x)]) == gen, bar);
            __builtin_amdgcn_fence(__ATOMIC_ACQUIRE, "agent");
            asm volatile("s_waitcnt vmcnt(0)" ::: "memory");
        }
    }
    __syncthreads();
}

struct Args { const float* in[21]; float* out; unsigned char* ws; int ph_lo, ph_hi; };

__global__ void __launch_bounds__(512, 2) mk_fwd(Args args) {
    extern __shared__ __attribute__((aligned(16))) unsigned char lds_raw[];
    LAS unsigned char* lds = (LAS unsigned char*)lds_raw;
    cg::grid_group grid = cg::this_grid();
    const int tid = threadIdx.x, lane = tid & 63, wave = __builtin_amdgcn_readfirstlane(tid >> 6);
    const int G = gridDim.x, bx = blockIdx.x;
    const int gw = bx * 8 + wave, NGW = G * 8;
    const int NGT = G * 512;
    unsigned char* ws = args.ws;
    const int lo = args.ph_lo, hi = args.ph_hi;
    volatile LAS unsigned* xst = (volatile LAS unsigned*)(lds + LDS_BYTES - 64);
    if (tid < 2) xst[tid] = 0u;
    __syncthreads();
    XcdBarrier xbar; xbar.bar = (unsigned*)(ws + WS_CTL); xbar.x = 0; xbar.st = xst;
    if (!MK_MULTI_LAUNCH) xbar = xcd_barrier_post((unsigned*)(ws + WS_CTL), xst);
#ifndef PH_EN
#define PH_EN 0x3ff
#endif
#ifndef PROBE_REP
#define PROBE_REP 0
#endif
#define REP(b) for (int rep_ = 0; rep_ < 1 + (((PROBE_REP) >> (b)) & 1); ++rep_)
#define IN(k) (lo <= (k) && (k) < hi)
#define EN(b) (((PH_EN) >> (b)) & 1)
#define SEAM(k) do { if (IN(k) && IN((k) + 1)) { if ((k) == 0 || MK_MULTI_LAUNCH) grid.sync(); else xcd_barrier(xbar); } } while (0)

#define WinT ((bf16_t*)(ws_ + WS_WIN))
#define WkvT ((bf16_t*)(ws_ + WS_WKV))
#define WbrT ((bf16_t*)(ws_ + WS_WBR))
#define WoutT ((bf16_t*)(ws_ + WS_WOUT))
#define WfiT ((bf16_t*)(ws_ + WS_WFI))
#define WfoT ((bf16_t*)(ws_ + WS_WFO))
#define MEMKV ((bf16_t*)(ws_ + WS_MEMKV))
#define XB ((bf16_t*)(ws_ + WS_XB))
#define MEMB ((bf16_t*)(ws_ + WS_MEMB))
#define ODIL ((bf16_t*)(ws_ + WS_ODIL))
#define LSE ((float*)(ws_ + WS_LSE))
#define MERGED ((bf16_t*)(ws_ + WS_MERGED))
#define A2 ((bf16_t*)(ws_ + WS_A2))
#define Y3 ((bf16_t*)(ws_ + WS_Y3))
#define SSQ ((float*)(ws_ + WS_SSQ))
#define PROJ ((bf16_t*)(ws_ + WS_PROJ))
#define YF ((bf16_t*)(ws_ + WS_YF))
#define HALO ((bf16_t*)(ws_ + WS_HALO))
#define CCONST ((float*)(ws_ + WS_CTL + 15360))
#define PHASE_LOCALS const Args* ap = &args; size_t zoff_ = 0; asm volatile("" : "+s"(zoff_)); unsigned char* ws_ = ws + zoff_;     int bxl = bx; asm volatile("" : "+s"(bxl)); int tidl = threadIdx.x; asm volatile("" : "+v"(tidl)); const int gtidl = bxl * 512 + tidl; (void)bxl; (void)ws_; (void)ap; (void)gtidl;
    if (EN(0) && IN(0)) REP(0) {
            PHASE_LOCALS
        LAS float* scr = (LAS float*)(lds + wave * 16384);
        constexpr int I_IN = 16 * 304, I_KV = 16 * 32, I_BR = 8 * 32, I_OUT = 16 * 32, I_FI = 16 * 176, I_FO = 44 * 32;
        constexpr int NITEMS = I_IN + I_KV + 3 * I_BR + I_OUT + I_FI + I_FO;
        for (int it = gw; it < NITEMS; it += NGW) {
            int r = it;
            if (r < I_IN) { p0_transpose_item<0>(ap->in[3], 1024, IN_COLS, WinT, 0, scr, r, lane); continue; } r -= I_IN;
            if (r < I_KV) { p0_transpose_item<0>(ap->in[9], 1024, 1024, WkvT, 0, scr, r, lane); continue; } r -= I_KV;
            if (r < I_BR) { p0_transpose_item<0>(ap->in[12], 512, 1024, WbrT, 0, scr, r, lane); continue; } r -= I_BR;
            if (r < I_BR) { p0_transpose_item<0>(ap->in[13], 512, 1024, WbrT, 1024, scr, r, lane); continue; } r -= I_BR;
            if (r < I_BR) { p0_transpose_item<0>(ap->in[14], 512, 1024, WbrT, 2048, scr, r, lane); continue; } r -= I_BR;
            if (r < I_OUT) { p0_transpose_item<0>(ap->in[15], 1024, 1024, WoutT, 0, scr, r, lane); continue; } r -= I_OUT;
            if (r < I_FI) { p0_transpose_item<1>(ap->in[17], 1024, FF2, WfiT, 0, scr, r, lane); continue; } r -= I_FI;
            p0_transpose_item<0>(ap->in[20], D_FF, 1024, WfoT, 0, scr, r, lane);
        }
        for (int i = bx * 512 + tid; i < BATCH * SEQ; i += NGT) SSQ[i] = 0.f;
        if (gw == 0) {
            float cv = 0.f;
            for (int g = 0; g < 3; ++g) { float a = fabsf(args.in[4][g * 64 + lane]), b = fabsf(args.in[5][g * 64 + lane]);
#pragma unroll
                for (int o = 1; o < 64; o <<= 1) { a = fmaxf(a, __shfl_xor(a, o)); b = fmaxf(b, __shfl_xor(b, o)); }
                if (lane == g) cv = 8.f * a * b * LOG2E; }
            { float a = fmaxf(fabsf(args.in[10][lane]), fabsf(args.in[10][64 + lane])), b = fmaxf(fabsf(args.in[11][lane]), fabsf(args.in[11][64 + lane]));
#pragma unroll
                for (int o = 1; o < 64; o <<= 1) { a = fmaxf(a, __shfl_xor(a, o)); b = fmaxf(b, __shfl_xor(b, o)); }
                if (lane == 3) cv = 11.313708499f * a * b * LOG2E; }
            if (lane < 4) CCONST[lane] = cv;
        }
        for (int m = gw; m < BATCH * SEQ; m += 2 * NGW) rms_row2_to_bf16(ap->in[0] + (size_t)m * 1024, ap->in[0] + (size_t)(m + NGW) * 1024, ap->in[2], XB + (size_t)m * 1024, XB + (size_t)(m + NGW) * 1024, lane);
        for (int m = gw; m < BATCH * N_MEM; m += NGW) rms_row_to_bf16(ap->in[1] + (size_t)m * 1024, ap->in[8], MEMB + (size_t)m * 1024, lane);
        __syncthreads();
    }
    SEAM(0);
    if (EN(1) && IN(1)) REP(1) {
            PHASE_LOCALS
        pg8::Gemm g{MEMB, WkvT, BATCH * N_MEM, 1024, 1024}; pg8::StaticOrder S; S.init(g.M, g.N, G, bxl);
        EpiPlainBf16 E{MEMKV, 1024};
        pg8::gemm_phase(lds, g, S, E);
    }
    SEAM(1);
    for (int hf = 0; hf < 2; ++hf) {
        const int P = 2 + 4 * hf;
        if (EN(2) && IN(P + 0)) REP(2) {
            PHASE_LOCALS
            pg8::Gemm g{XB + (size_t)hf * HTOK * 1024, WinT, HTOK, IN_COLS, 1024}; pg8::StaticOrder S; S.init(g.M, g.N, G, bxl);
            { LAS float* lg = (LAS float*)(lds + 131072);
              if (tidl < 384) lg[tidl] = tidl < 192 ? ap->in[4][tidl] : ap->in[5][tidl - 192];
              __syncthreads(); }
            EpiProj E{PROJ, (const LAS float*)(lds + 131072)};
            pg8::gemm_phase(lds, g, S, E);
        }
        SEAM(P + 0);
        if (EN(3) && IN(P + 1)) REP(3) {
            PHASE_LOCALS
            LAS char* vl = (LAS char*)(lds + wave * 8192);
#ifndef ATT_EN
#define ATT_EN 7
#endif
            if (ATT_EN & 1) for (int it = bxl; it < HB * 4 * 16; it += G) ret_u_item(PROJ, XB + (size_t)hf * HTOK * 1024, ap->in[6], it, (LAS char*)lds, tid);
            if (ATT_EN & 2) REP(10) for (int it = gw; it < HB * 8 * 3 * 32; it += NGW) dil_wave(PROJ, ODIL, LSE, CCONST, it, vl, lane);
            __syncthreads();
            if (ATT_EN & 4) REP(11) for (int it = bxl; it < HB * 4 * 4; it += G) mem_item(PROJ, MEMKV + (size_t)hf * HB * N_MEM * 1024, Y3 + (size_t)2 * HTOK * 512, args.in[10], args.in[11], CCONST, it, (LAS char*)lds, tid);
            __syncthreads();
        }
        SEAM(P + 1);
        if (EN(4) && IN(P + 2)) REP(4) {
            PHASE_LOCALS
            for (int it = bxl; it < HB * 4 * 8; it += G) ret_chunk_item(PROJ, XB + (size_t)hf * HTOK * 1024, Y3 + (size_t)1 * HTOK * 512, ap->in[6], ap->in[7], it, (LAS char*)lds, tid);
            for (int idx = gtidl; idx < HTOK * 64; idx += NGT) {
                const int dp = idx & 7, h = (idx >> 3) & 7, tok = idx >> 6;
                const float l0 = LSE[((size_t)0 * HTOK + tok) * 8 + h], l1 = LSE[((size_t)1 * HTOK + tok) * 8 + h], l2 = LSE[((size_t)2 * HTOK + tok) * 8 + h];
                const float mx = fmaxf(l0, fmaxf(l1, l2));
                float w0 = exp2f(l0 - mx), w1 = exp2f(l1 - mx), w2 = exp2f(l2 - mx); const float inv = 1.f / (w0 + w1 + w2); w0 *= inv; w1 *= inv; w2 *= inv;
                const size_t off = (size_t)tok * 512 + h * 64 + dp * 8;
                const u32x4 a = *(const u32x4*)(ODIL + off), b = *(const u32x4*)(ODIL + (size_t)HTOK * 512 + off), c = *(const u32x4*)(ODIL + (size_t)2 * HTOK * 512 + off);
                u32x4 o;
                o.x = pk2(w0 * bflo(a.x) + w1 * bflo(b.x) + w2 * bflo(c.x), w0 * bfhi(a.x) + w1 * bfhi(b.x) + w2 * bfhi(c.x));
                o.y = pk2(w0 * bflo(a.y) + w1 * bflo(b.y) + w2 * bflo(c.y), w0 * bfhi(a.y) + w1 * bfhi(b.y) + w2 * bfhi(c.y));
                o.z = pk2(w0 * bflo(a.z) + w1 * bflo(b.z) + w2 * bflo(c.z), w0 * bfhi(a.z) + w1 * bfhi(b.z) + w2 * bfhi(c.z));
                o.w = pk2(w0 * bflo(a.w) + w1 * bflo(b.w) + w2 * bflo(c.w), w0 * bfhi(a.w) + w1 * bfhi(b.w) + w2 * bfhi(c.w));
                *(u32x4*)(Y3 + off) = o;
            }
        }
        SEAM(P + 2);
        if (EN(5) && IN(P + 3)) REP(5) {
            PHASE_LOCALS
            pg8::Gemm g{Y3, WbrT, 3 * HTOK, 3 * 1024, 512}; pg8::BranchOrder S; S.init(HTOK, 1024, G, bxl);
            EpiBranch E{MERGED + (size_t)hf * HTOK * 1024, PROJ};
            pg8::gemm_phase(lds, g, S, E);
        }
        SEAM(P + 3);
    }
    {
        constexpr int P = 6, NTOK = BATCH * SEQ;
        if (EN(6) && IN(P + 4)) REP(6) {
            PHASE_LOCALS
            pg8::Gemm g{MERGED, WoutT, NTOK, 1024, 1024}; pg8::StaticOrder S; S.init(g.M, g.N, G, bxl);
            EpiOut E{ap->in[0], ap->out, A2, ap->in[16], SSQ};
            pg8::gemm_phase(lds, g, S, E);
        }
        SEAM(P + 4);
        if (EN(7) && IN(P + 5)) REP(7) {
            PHASE_LOCALS
            pg8::Gemm g{A2, WfiT, NTOK, FF2, 1024}; pg8::StaticOrder S; S.init(g.M, g.N, G, bxl);
            EpiFfnInConv E{YF, HALO, SSQ, ap->in[18], ap->in[19]};
            pg8::gemm_phase(lds, g, S, E);
        }
        SEAM(P + 5);
        if (EN(8) && IN(P + 6)) REP(8) {
            PHASE_LOCALS
            const float* cw = ap->in[18]; const float* cb = ap->in[19];
            for (int idx = gtidl; idx < (NTOK / 64) * 2 * 352; idx += NGT) {
                const int cgp = idx % 352, rest = idx / 352, side = rest & 1, blk = rest >> 1, ch = cgp * 8;
                const int row = blk * 64 + (side ? 63 : 0), t = row & (SEQ - 1);
                const bf16_t* hb = HALO + (size_t)blk * 6 * D_FF + ch;
                u32x4 um = {0u, 0u, 0u, 0u}, un = {0u, 0u, 0u, 0u}, uc, gt;
                if (side == 0) { uc = *(const u32x4*)hb; un = *(const u32x4*)(hb + D_FF); gt = *(const u32x4*)(hb + 4 * D_FF); if (t > 0) um = *(const u32x4*)(hb - 6 * D_FF + 3 * D_FF); }
                else { um = *(const u32x4*)(hb + 2 * D_FF); uc = *(const u32x4*)(hb + 3 * D_FF); gt = *(const u32x4*)(hb + 5 * D_FF); if (t < SEQ - 1) un = *(const u32x4*)(hb + 6 * D_FF); }
                float uu[3][8], gg[8];
                const unsigned umw[4] = {um.x, um.y, um.z, um.w}, ucw[4] = {uc.x, uc.y, uc.z, uc.w}, unw[4] = {un.x, un.y, un.z, un.w}, gtw[4] = {gt.x, gt.y, gt.z, gt.w};
#pragma unroll
                for (int q = 0; q < 4; ++q) { uu[0][2 * q] = bflo(umw[q]); uu[0][2 * q + 1] = bfhi(umw[q]); uu[1][2 * q] = bflo(ucw[q]); uu[1][2 * q + 1] = bfhi(ucw[q]);
                    uu[2][2 * q] = bflo(unw[q]); uu[2][2 * q + 1] = bfhi(unw[q]); gg[2 * q] = bflo(gtw[q]); gg[2 * q + 1] = bfhi(gtw[q]); }
                float yv[8];
#pragma unroll
                for (int q2 = 0; q2 < 2; ++q2) {
                    const f32x4 w0 = *(const f32x4*)(cw + ch + 4 * q2), w1 = *(const f32x4*)(cw + D_FF + ch + 4 * q2), w2 = *(const f32x4*)(cw + 2 * D_FF + ch + 4 * q2), bb = *(const f32x4*)(cb + ch + 4 * q2);
#pragma unroll
                    for (int e = 0; e < 4; ++e) { const int k = 4 * q2 + e; const float c = bb[e] + uu[0][k] * w0[e] + uu[1][k] * w1[e] + uu[2][k] * w2[e];
                        yv[k] = gelu_exact(c) * gg[k]; }
                }
                u32x4 o; o.x = pk2(yv[0], yv[1]); o.y = pk2(yv[2], yv[3]); o.z = pk2(yv[4], yv[5]); o.w = pk2(yv[6], yv[7]);
                *(u32x4*)(YF + (size_t)row * D_FF + ch) = o;
            }
        }
        SEAM(P + 6);
        if (EN(9) && IN(P + 7)) REP(9) {
            PHASE_LOCALS
            pg8::Gemm g{YF, WfoT, NTOK, 1024, D_FF}; pg8::StaticOrder S; S.init(g.M, g.N, G, bxl);
            EpiFfnOut E{ap->out};
            pg8::gemm_phase(lds, g, S, E);
        }
    }
#undef IN
#undef SEAM
}

extern "C" void kernel_launch(void* const* d_in, const int* in_sizes, int n_in, void* d_out, int out_size, void* d_ws, size_t ws_size, hipStream_t stream) {
    static int grid = 0;
    if (grid == 0) {
        if (n_in != 21 || out_size != BATCH * SEQ * D_MODEL || ws_size < WS_END) { fprintf(stderr, "kernel_launch: unexpected shapes (n_in %d out %d ws %zu)\n", n_in, out_size, ws_size); grid = -1; return; }
        int dev = 0, cus = 0, per_cu = 0;
        hipGetDevice(&dev); hipDeviceGetAttribute(&cus, hipDeviceAttributeMultiprocessorCount, dev);
        if (hipFuncSetAttribute((const void*)mk_fwd, hipFuncAttributeMaxDynamicSharedMemorySize, LDS_BYTES) != hipSuccess) { fprintf(stderr, "kernel_launch: hipFuncSetAttribute failed\n"); grid = -1; return; }
        if (hipOccupancyMaxActiveBlocksPerMultiprocessor(&per_cu, (const void*)mk_fwd, 512, LDS_BYTES) != hipSuccess || per_cu < 1) { fprintf(stderr, "kernel_launch: occupancy query says %d\n", per_cu); per_cu = 1; }
        (void)hipGetLastError();
        grid = cus * per_cu;
    }
    if (grid < 0) return;
    Args a{};
    for (int i = 0; i < 21; ++i) a.in[i] = (const float*)d_in[i];
    a.out = (float*)d_out; a.ws = (unsigned char*)d_ws;
#if MK_MULTI_LAUNCH
    for (int ph = 0; ph < NPHASE; ++ph) {
        a.ph_lo = ph; a.ph_hi = ph + 1;
        hipLaunchKernelGGL(mk_fwd, dim3(grid), dim3(512), LDS_BYTES, stream, a);
    }
#else
    a.ph_lo = 0; a.ph_hi = NPHASE;
    if (hipMemsetAsync((char*)d_ws + WS_CTL, 0, CTL_BYTES, stream) != hipSuccess) { fprintf(stderr, "kernel_launch: memset of the barrier words failed\n"); return; }
    void* kargs[] = {&a};
    hipError_t e = hipLaunchCooperativeKernel((const void*)mk_fwd, dim3(grid), dim3(512), kargs, LDS_BYTES, stream);
    if (e != hipSuccess) fprintf(stderr, "kernel_launch: cooperative launch failed: %s (grid %d)\n", hipGetErrorString(e), grid);
#endif
}
```
